# Optimizing an MI355X kernel written in HIP

```python
import jax, jax.numpy as jnp
from jax import lax
import numpy as np

D_MODEL = 1024
BATCH = 32
SEQ = 2048
DEPTH = 2

D_MIX = D_MODEL
DN_HEADS = 6
DN_DK = 64
DN_DV = 64
DN_CONV = 4
DN_CHUNK = 64
CF_CH = 256
CF_KERNEL = 31
NSA_HEADS = 6
NSA_KV = 2
NSA_HPG = NSA_HEADS // NSA_KV
NSA_DH = 64
CMP_LEN = 32
CMP_STRIDE = 16
CMP_HID = 2 * NSA_DH
SEL_BLOCK = 64
N_SEL = 8
WINDOW = 512
Q_BLOCK = 64
D_FF = -(-8 * D_MODEL // (3 * 256)) * 256

EPS = 1e-6
NEG = -1e30
SEL_BIG = 1e4

DN_QKV = 2 * DN_HEADS * DN_DK + DN_HEADS * DN_DV
IN_SPLITS = (DN_QKV, DN_HEADS * DN_DV, DN_HEADS, DN_HEADS, 2 * CF_CH,
             NSA_HEADS * NSA_DH,
             NSA_KV * NSA_DH, NSA_KV * NSA_DH, NSA_KV * NSA_DH,
             NSA_KV * NSA_DH, NSA_KV * NSA_DH, NSA_KV * NSA_DH,
             3 * NSA_HEADS)
N_IN = DN_QKV + DN_HEADS * DN_DV + 2 * DN_HEADS + 2 * CF_CH + NSA_HEADS * NSA_DH + 6 * NSA_KV * NSA_DH + 3 * NSA_HEADS

kernel_name = "hybrid_deltanet_conformer_nsa_block"


def rms_norm(x, w):
    xf = x.astype(jnp.float32)
    y = xf * lax.rsqrt(jnp.mean(xf * xf, axis=-1, keepdims=True) + EPS)
    return (y * w.astype(jnp.float32)).astype(x.dtype)


def layer_norm(x, w, b):
    xf = x.astype(jnp.float32)
    mu = jnp.mean(xf, axis=-1, keepdims=True)
    var = jnp.mean(jnp.square(xf - mu), axis=-1, keepdims=True)
    y = (xf - mu) * lax.rsqrt(var + EPS) * w.astype(jnp.float32) + b.astype(jnp.float32)
    return y.astype(x.dtype)


def l2norm(t):
    return t * lax.rsqrt(jnp.sum(t * t, axis=-1, keepdims=True) + EPS)


def masked_softmax(s, mask):
    return jax.nn.softmax(jnp.where(mask, s.astype(jnp.float32), NEG), axis=-1)


def split_cols(t, sizes):
    out, start = [], 0
    for s in sizes:
        out.append(t[..., start:start + s])
        start += s
    return out


def causal_depthwise_conv(x, w):
    k, c = w.shape
    return lax.conv_general_dilated(
        x, w[:, None, :].astype(x.dtype), window_strides=(1,), padding=[(k - 1, 0)],
        dimension_numbers=("NWC", "WIO", "NWC"), feature_group_count=c)


def chunked_gated_delta(q, k, v, g, beta):
    bsz, nh, s, dk = q.shape
    dv = v.shape[-1]
    c = DN_CHUNK
    n = s // c
    f32 = jnp.float32
    q = q.reshape(bsz, nh, n, c, dk)
    k = k.reshape(bsz, nh, n, c, dk)
    v = v.reshape(bsz, nh, n, c, dv)
    g = g.reshape(bsz, nh, n, c)
    beta = beta.reshape(bsz, nh, n, c)
    gam = jnp.cumsum(g, axis=-1)
    idx = jnp.arange(c)
    causal = idx[:, None] >= idx[None, :]
    strict = idx[:, None] > idx[None, :]
    decay = jnp.exp(jnp.where(causal, gam[..., :, None] - gam[..., None, :], NEG))
    kk = jnp.einsum("bhnid,bhnjd->bhnij", k, k)
    a_mat = jnp.where(strict, kk * beta[..., :, None] * decay, 0.0) + jnp.eye(c, dtype=f32)
    u = lax.linalg.triangular_solve(a_mat, v * beta[..., None], left_side=True, lower=True, unit_diagonal=True)
    w = lax.linalg.triangular_solve(a_mat, k * (beta * jnp.exp(gam))[..., None], left_side=True, lower=True, unit_diagonal=True)
    qk = jnp.einsum("bhnid,bhnjd->bhnij", q, k) * decay
    q_dec = q * jnp.exp(gam)[..., None]
    k_dec = k * jnp.exp(gam[..., -1:] - gam)[..., None]
    g_tot = jnp.exp(gam[..., -1])
    xs = tuple(jnp.moveaxis(t, 2, 0) for t in (u, w, qk, q_dec, k_dec, g_tot))

    def step(state, inp):
        u_c, w_c, qk_c, qd_c, kd_c, gt_c = inp
        v_new = u_c - jnp.einsum("bhck,bhkv->bhcv", w_c, state)
        o_c = jnp.einsum("bhck,bhkv->bhcv", qd_c, state) + jnp.einsum("bhcs,bhsv->bhcv", qk_c, v_new)
        state = state * gt_c[..., None, None] + jnp.einsum("bhck,bhcv->bhkv", kd_c, v_new)
        return state, o_c

    s0 = jnp.zeros((bsz, nh, dk, dv), f32)
    _, o = lax.scan(step, s0, xs)
    return jnp.moveaxis(o, 0, 2).reshape(bsz, nh, s, dv)


def gated_deltanet(qkv, z, b_raw, a_raw, conv_w, a_log, dt_bias, norm_w):
    bsz, s, _ = qkv.shape
    f32 = jnp.float32
    qkv_c = jax.nn.silu(causal_depthwise_conv(qkv, conv_w))
    q, k, v = split_cols(qkv_c, (DN_HEADS * DN_DK, DN_HEADS * DN_DK, DN_HEADS * DN_DV))

    def heads(t, d):
        return t.reshape(bsz, s, DN_HEADS, d).transpose(0, 2, 1, 3).astype(f32)

    q = l2norm(heads(q, DN_DK)) * DN_DK ** -0.5
    k = l2norm(heads(k, DN_DK))
    v = heads(v, DN_DV)
    beta = jax.nn.sigmoid(b_raw.astype(f32)).transpose(0, 2, 1)
    g = (-jnp.exp(a_log.astype(f32)) * jax.nn.softplus(a_raw.astype(f32) + dt_bias.astype(f32))).transpose(0, 2, 1)
    o = chunked_gated_delta(q, k, v, g, beta).transpose(0, 2, 1, 3)
    o = o * lax.rsqrt(jnp.mean(o * o, axis=-1, keepdims=True) + EPS) * norm_w.astype(f32)
    o = o * jax.nn.silu(z.reshape(bsz, s, DN_HEADS, DN_DV).astype(f32))
    return o.reshape(bsz, s, DN_HEADS * DN_DV).astype(qkv.dtype)


def conformer_conv(u, dw_w, dw_b, ln_w, ln_b):
    val, gate = jnp.split(u, 2, axis=-1)
    h = val * jax.nn.sigmoid(gate)
    h = causal_depthwise_conv(h, dw_w) + dw_b
    h = layer_norm(h, ln_w, ln_b)
    return jax.nn.silu(h)


def nsa_mixer(q, k_cmp, v_cmp, k_slc, v_slc, k_win, v_win, gate_raw,
              k_pos, v_pos, k_w1, k_w2, v_w1, v_w2):
    bsz, s, _ = q.shape
    dt = q.dtype

    def kv_heads(t):
        return t.reshape(bsz, s, NSA_KV, NSA_DH).transpose(0, 2, 1, 3)

    qh = q.reshape(bsz, s, NSA_KV, NSA_HPG, NSA_DH).transpose(0, 2, 3, 1, 4) * NSA_DH ** -0.5
    gates = jax.nn.sigmoid(gate_raw.astype(jnp.float32)).astype(dt)
    gates = gates.reshape(bsz, s, 3, NSA_KV, NSA_HPG).transpose(2, 0, 3, 4, 1)

    n_cmp = (s - CMP_LEN) // CMP_STRIDE + 1
    win_idx = np.arange(n_cmp)[:, None] * CMP_STRIDE + np.arange(CMP_LEN)[None, :]

    def compress(t, pos, w1, w2):
        blocks = kv_heads(t)[:, :, win_idx] + pos
        blocks = blocks.reshape(bsz, NSA_KV, n_cmp, CMP_LEN * NSA_DH)
        return jax.nn.silu(blocks @ w1) @ w2

    kc = compress(k_cmp, k_pos, k_w1, k_w2)
    vc = compress(v_cmp, v_pos, v_w1, v_w2)
    cmp_start = np.arange(n_cmp) * CMP_STRIDE
    cmp_end = jnp.asarray(cmp_start + CMP_LEN - 1)

    n_blk = s // SEL_BLOCK
    n_sel = min(N_SEL, n_blk)
    blk_start = np.arange(n_blk) * SEL_BLOCK
    overlap = jnp.asarray(((cmp_start[:, None] < blk_start[None, :] + SEL_BLOCK)
                           & (cmp_start[:, None] + CMP_LEN > blk_start[None, :])).astype(np.float32))
    ks = kv_heads(k_slc).reshape(bsz, NSA_KV, n_blk, SEL_BLOCK, NSA_DH)
    vs = kv_heads(v_slc).reshape(bsz, NSA_KV, n_blk, SEL_BLOCK, NSA_DH)

    kw = jnp.pad(kv_heads(k_win), ((0, 0), (0, 0), (WINDOW, 0), (0, 0)))
    vw = jnp.pad(kv_heads(v_win), ((0, 0), (0, 0), (WINDOW, 0), (0, 0)))

    bi = jnp.arange(bsz)[:, None, None, None]
    gi = jnp.arange(NSA_KV)[None, :, None, None]
    blk_ids = jnp.arange(n_blk)

    def block_fn(c):
        start = c * Q_BLOCK
        t = start + jnp.arange(Q_BLOCK)
        qc = lax.dynamic_slice_in_dim(qh, start, Q_BLOCK, axis=3)
        gc = lax.dynamic_slice_in_dim(gates, start, Q_BLOCK, axis=4)
        m_c = cmp_end[None, :] <= t[:, None]
        p_c = masked_softmax(jnp.einsum("bghqd,bgnd->bghqn", qc, kc), m_c) * m_c
        o_c = jnp.einsum("bghqn,bgnd->bghqd", p_c.astype(dt), vc)
        imp = jnp.einsum("bghqn,nj->bgqj", p_c, overlap)
        cur = t[:, None] // SEL_BLOCK
        elig = blk_ids[None, :] <= cur
        forced = (blk_ids[None, :] == 0) | (blk_ids[None, :] == cur) | (blk_ids[None, :] == cur - 1)
        score = jnp.where(elig, imp + jnp.where(forced, SEL_BIG, 0.0), -SEL_BIG)
        _, sel = lax.top_k(score, n_sel)
        k_sel = ks[bi, gi, sel]
        v_sel = vs[bi, gi, sel].reshape(bsz, NSA_KV, Q_BLOCK, n_sel * SEL_BLOCK, NSA_DH)
        kpos = (sel[..., None] * SEL_BLOCK + jnp.arange(SEL_BLOCK)).reshape(bsz, NSA_KV, 1, Q_BLOCK, n_sel * SEL_BLOCK)
        m_s = kpos <= t[:, None]
        s_s = jnp.einsum("bghqd,bgqnld->bghqnl", qc, k_sel).reshape(bsz, NSA_KV, NSA_HPG, Q_BLOCK, n_sel * SEL_BLOCK)
        p_s = masked_softmax(s_s, m_s)
        o_s = jnp.einsum("bghqk,bgqkd->bghqd", p_s.astype(dt), v_sel)
        kwc = lax.dynamic_slice_in_dim(kw, start, WINDOW + Q_BLOCK, axis=2)
        vwc = lax.dynamic_slice_in_dim(vw, start, WINDOW + Q_BLOCK, axis=2)
        kpos_w = start - WINDOW + jnp.arange(WINDOW + Q_BLOCK)
        m_w = (kpos_w[None, :] <= t[:, None]) & (kpos_w[None, :] > t[:, None] - WINDOW) & (kpos_w[None, :] >= 0)
        p_w = masked_softmax(jnp.einsum("bghqd,bgkd->bghqk", qc, kwc), m_w)
        o_w = jnp.einsum("bghqk,bgkd->bghqd", p_w.astype(dt), vwc)
        return gc[0][..., None] * o_c + gc[1][..., None] * o_s + gc[2][..., None] * o_w

    out = lax.map(block_fn, jnp.arange(s // Q_BLOCK))
    return out.transpose(1, 0, 4, 2, 3, 5).reshape(bsz, s, NSA_HEADS * NSA_DH)


def setup_inputs(seed: int = 0) -> dict:
    key = jax.random.key(seed)
    ks = jax.random.split(key, 24)
    f32 = jnp.float32
    nrm = lambda k, shape, scale: scale * jax.random.normal(k, shape, f32)
    dt_init = jnp.exp(jax.random.uniform(ks[5], (DEPTH, DN_HEADS), f32, np.log(1e-3), np.log(1e-1)))
    return {
        "x": nrm(ks[0], (BATCH, SEQ, D_MODEL), 1.0),
        "norm_w": 1.0 + nrm(ks[1], (DEPTH, 4, D_MODEL), 0.05),
        "w_in": nrm(ks[2], (DEPTH, D_MODEL, N_IN), D_MODEL ** -0.5),
        "dn_conv_w": nrm(ks[3], (DEPTH, DN_CONV, DN_QKV), DN_CONV ** -0.5),
        "dn_a_log": jnp.log(jax.random.uniform(ks[4], (DEPTH, DN_HEADS), f32, 1.0, 16.0)),
        "dn_dt_bias": dt_init + jnp.log(-jnp.expm1(-dt_init)),
        "dn_norm_w": 1.0 + nrm(ks[6], (DEPTH, DN_DV), 0.05),
        "cf_dw_w": nrm(ks[7], (DEPTH, CF_KERNEL, CF_CH), CF_KERNEL ** -0.5),
        "cf_dw_b": nrm(ks[8], (DEPTH, CF_CH), 0.02),
        "cf_ln_w": 1.0 + nrm(ks[9], (DEPTH, CF_CH), 0.05),
        "cf_ln_b": nrm(ks[10], (DEPTH, CF_CH), 0.02),
        "nsa_k_pos": nrm(ks[11], (DEPTH, CMP_LEN, NSA_DH), 0.1),
        "nsa_v_pos": nrm(ks[12], (DEPTH, CMP_LEN, NSA_DH), 0.1),
        "nsa_k_w1": nrm(ks[13], (DEPTH, CMP_LEN * NSA_DH, CMP_HID), (CMP_LEN * NSA_DH) ** -0.5),
        "nsa_k_w2": nrm(ks[14], (DEPTH, CMP_HID, NSA_DH), CMP_HID ** -0.5),
        "nsa_v_w1": nrm(ks[15], (DEPTH, CMP_LEN * NSA_DH, CMP_HID), (CMP_LEN * NSA_DH) ** -0.5),
        "nsa_v_w2": nrm(ks[16], (DEPTH, CMP_HID, NSA_DH), CMP_HID ** -0.5),
        "w_out": nrm(ks[17], (DEPTH, D_MIX, D_MODEL), D_MIX ** -0.5),
        "ffn_w_gate": nrm(ks[18], (DEPTH, D_MODEL, D_FF), D_MODEL ** -0.5),
        "ffn_w_up": nrm(ks[19], (DEPTH, D_MODEL, D_FF), D_MODEL ** -0.5),
        "ffn_w_down": nrm(ks[20], (DEPTH, D_FF, D_MODEL), D_FF ** -0.5),
    }


def reference(x, norm_w, w_in, dn_conv_w, dn_a_log, dn_dt_bias, dn_norm_w,
              cf_dw_w, cf_dw_b, cf_ln_w, cf_ln_b,
              nsa_k_pos, nsa_v_pos, nsa_k_w1, nsa_k_w2, nsa_v_w1, nsa_v_w2,
              w_out, ffn_w_gate, ffn_w_up, ffn_w_down):
    for l in range(DEPTH):
        h = rms_norm(x, norm_w[l, 0])
        proj = h @ w_in[l]
        (dn_qkv, dn_z, dn_b, dn_a, cf_u, n_q, n_kc, n_vc, n_ks, n_vs,
         n_kw, n_vw, n_gate) = split_cols(proj, IN_SPLITS)
        o_dn = gated_deltanet(dn_qkv, dn_z, dn_b, dn_a, dn_conv_w[l], dn_a_log[l], dn_dt_bias[l], dn_norm_w[l])
        o_cf = conformer_conv(cf_u, cf_dw_w[l], cf_dw_b[l], cf_ln_w[l], cf_ln_b[l])
        o_nsa = nsa_mixer(n_q, n_kc, n_vc, n_ks, n_vs, n_kw, n_vw, n_gate,
                          nsa_k_pos[l], nsa_v_pos[l], nsa_k_w1[l], nsa_k_w2[l], nsa_v_w1[l], nsa_v_w2[l])
        mix = jnp.concatenate([o_dn, o_cf, o_nsa], axis=-1) @ w_out[l]
        x = x + rms_norm(mix, norm_w[l, 1])
        h = rms_norm(x, norm_w[l, 2])
        f = (jax.nn.silu(h @ ffn_w_gate[l]) * (h @ ffn_w_up[l])) @ ffn_w_down[l]
        x = x + rms_norm(f, norm_w[l, 3])
    return x
```

```cpp
#include <hip/hip_runtime.h>
#include <cstdio>
#include <cstdint>

#ifndef MK_ONE_LAUNCH
#define MK_ONE_LAUNCH 0
#endif

namespace pg8 {
#define PG8_LAS __attribute__((address_space(3)))
typedef unsigned short bf16_t;
typedef short bf16x8 __attribute__((ext_vector_type(8)));
typedef float f32x4 __attribute__((ext_vector_type(4)));
typedef unsigned u32x4 __attribute__((ext_vector_type(4)));
constexpr int BM = 256, BK = 64, HALF = 128, HTB = HALF * BK * 2  , STAGE_BYTES = 8 * HTB, NXCD = 8, WGM = 8;

__host__ __device__ __forceinline__ int lds_byte(int r, int c) { const int st = (r >> 4) * 2 + (c >> 5), rr = r & 15, cc = c & 31, ob = rr * 64 + cc * 2; return st * 1024 + (ob ^ (((ob >> 9) & 1) << 5)); }
__host__ __device__ __forceinline__ void stage_rc(int b, int& R, int& C) { const int st = b / 1024, sb = b % 1024, swz = sb ^ (((sb >> 9) & 1) << 5); R = (st >> 1) * 16 + swz / 64; C = (st & 1) * 32 + (swz % 64) / 2; }
__host__ __device__ __forceinline__ int perm32(int rho) { const int n = rho >> 4, i = rho & 15; return 8 * (i >> 2) + 4 * n + (i & 3); }

struct Unit { int pm, pn; };
struct Gemm { const bf16_t* A; const bf16_t* Bt; int M, N, K; };

struct StaticOrder {
    int nM, nN, nwg, G, c;
    __host__ __device__ void init(int M, int N, int G_, int c_) { nM = M / BM; nN = N / BM; nwg = nM * nN; G = G_; c = c_; }
    __host__ __device__ bool next(int i, Unit& u) const {
        const long L = (long)i * G + c; if (L >= nwg) return false;
        int wgid = (int)L; { const int q = nwg / NXCD, r = nwg % NXCD, xcd = wgid % NXCD, off = wgid / NXCD; wgid = (xcd < r ? xcd * (q + 1) : r * (q + 1) + (xcd - r) * q) + off; }
        const int nig = WGM * nN, gid = wgid / nig, fm = gid * WGM, gsz = (nM - fm) < WGM ? (nM - fm) : WGM;
        u.pm = fm + ((wgid % nig) % gsz); u.pn = (wgid % nig) / gsz; return true;
    }
    __device__ __forceinline__ void a_ready(const Unit&) const {}
    __device__ __forceinline__ void done(const Unit&) const {}
};

__device__ __forceinline__ unsigned cvt_pk_bf16(float lo, float hi) { unsigned r; asm volatile("v_cvt_pk_bf16_f32 %0, %1, %2" : "=v"(r) : "v"(lo), "v"(hi)); return r; }
typedef float f32x2 __attribute__((ext_vector_type(2)));
__device__ __forceinline__ float silu_f(float v) { return v / (1.0f + __expf(-v)); }
template <int ACT> struct EpiBf16 {
    static constexpr bool PERM = true, AFTER_DRAIN = false;
    bf16_t* O; int ldc;
    __device__ __forceinline__ void operator()(const f32x4 (&acc)[2][2][4][2], const Unit& u, int wr, int wc, int fr, int fq) const {
        const int row0 = u.pm * BM + wr * 64 + fr; const int col0 = u.pn * BM + wc * 32 + 8 * fq;
#pragma unroll
        for (int ai = 0; ai < 2; ++ai)
#pragma unroll
            for (int m = 0; m < 4; ++m) { bf16_t* rowp = O + (size_t)(row0 + ai * HALF + m * 16) * ldc + col0;
#pragma unroll
                for (int bj = 0; bj < 2; ++bj) { f32x4 v0 = acc[ai][bj][m][0], v1 = acc[ai][bj][m][1];
                    if (ACT == 1) {
#pragma unroll
                        for (int j = 0; j < 4; ++j) { v0[j] = silu_f(v0[j]); v1[j] = silu_f(v1[j]); } }
                    u32x4 w; w.x = cvt_pk_bf16(v0[0], v0[1]); w.y = cvt_pk_bf16(v0[2], v0[3]); w.z = cvt_pk_bf16(v1[0], v1[1]); w.w = cvt_pk_bf16(v1[2], v1[3]);
                    *(u32x4*)(rowp + bj * HALF) = w; } }
    }
};
struct EpiSwiGLU {
    static constexpr bool PERM = true, AFTER_DRAIN = false;
    bf16_t* O; int ldc;
    __device__ __forceinline__ void operator()(const f32x4 (&acc)[2][2][4][2], const Unit& u, int wr, int wc, int fr, int fq) const {
        const int row0 = u.pm * BM + wr * 64 + fr; const int col0 = u.pn * HALF + wc * 32 + 8 * fq;
#pragma unroll
        for (int ai = 0; ai < 2; ++ai)
#pragma unroll
            for (int m = 0; m < 4; ++m) { bf16_t* rowp = O + (size_t)(row0 + ai * HALF + m * 16) * ldc + col0;
                f32x4 g0 = acc[ai][0][m][0], g1 = acc[ai][0][m][1]; const f32x4 u0 = acc[ai][1][m][0], u1 = acc[ai][1][m][1];
#pragma unroll
                for (int j = 0; j < 4; ++j) { g0[j] = silu_f(g0[j]) * u0[j]; g1[j] = silu_f(g1[j]) * u1[j]; }
                u32x4 w; w.x = cvt_pk_bf16(g0[0], g0[1]); w.y = cvt_pk_bf16(g0[2], g0[3]); w.z = cvt_pk_bf16(g1[0], g1[1]); w.w = cvt_pk_bf16(g1[2], g1[3]);
                *(u32x4*)rowp = w; }
    }
};

template <class Epi, class Sched, bool ALIGN_EPI = false, bool SP2 = false>
__device__ __forceinline__ void gemm_phase(PG8_LAS unsigned char* lds, const Gemm g, const Sched& S, const Epi& E) {
    const int tid = threadIdx.x, wid = __builtin_amdgcn_readfirstlane(tid >> 6), lane = tid & 63, wr = wid >> 2, wc = wid & 3, fr = lane & 15, fq = lane >> 4;
    const int K = g.K, nt = K / BK;
    unsigned voffA[2], voffB[2];
#pragma unroll
    for (int i = 0; i < 2; ++i) { int R, C; stage_rc(tid * 16 + i * 8192, R, C); const int Rb = Epi::PERM ? ((R & ~31) + perm32(R & 31)) : R;
        voffA[i] = (unsigned)(R * K + C) * 2u; voffB[i] = (unsigned)(Rb * K + C) * 2u; }
    const size_t kstep = (size_t)(BK * 2);
    const size_t hstep = (size_t)HALF * K * 2;
    const size_t tstep = 2 * hstep;
    const unsigned ldsw = (unsigned)wid * 1024u;
    const int aoff = lds_byte(wr * 64 + fr, fq * 8), boff = lds_byte(wc * 32 + fr, fq * 8);
#define PG8_SA(b, h) (((b) * 2 + (h)) * HTB)
#define PG8_SB(b, h) ((4 + (b) * 2 + (h)) * HTB)
#define PG8_STAGE(bufoff, gbase, voff) do { _Pragma("unroll") for (int _i = 0; _i < 2; ++_i) \
        __builtin_amdgcn_global_load_lds((const unsigned*)((const char*)(gbase) + (voff)[_i]), (PG8_LAS unsigned*)(lds + (bufoff) + ldsw + _i * 8192), 16, 0, 0); } while (0)
#define PG8_LDA(dst, b, h) do { _Pragma("unroll") for (int m = 0; m < 4; ++m) _Pragma("unroll") for (int k = 0; k < 2; ++k) dst[m][k] = *(const PG8_LAS bf16x8*)(lds + PG8_SA(b, h) + aoff + m * 2048 + k * 1024); } while (0)
#define PG8_LDB(dst, b, h) do { _Pragma("unroll") for (int n = 0; n < 2; ++n) _Pragma("unroll") for (int k = 0; k < 2; ++k) dst[n][k] = *(const PG8_LAS bf16x8*)(lds + PG8_SB(b, h) + boff + n * 2048 + k * 1024); } while (0)
#define PG8_MMA(ai, bj, At, Bt) do { __builtin_amdgcn_s_setprio(1); _Pragma("unroll") for (int m = 0; m < 4; ++m) _Pragma("unroll") for (int n = 0; n < 2; ++n) _Pragma("unroll") for (int k = 0; k < 2; ++k) \
        acc[ai][bj][m][n] = __builtin_amdgcn_mfma_f32_16x16x32_bf16(Bt[n][k], At[m][k], acc[ai][bj][m][n], 0, 0, 0); __builtin_amdgcn_s_setprio(0); } while (0)
#define PG8_WAIT_V(n) asm volatile("s_waitcnt vmcnt(" #n ")" ::: "memory")
#define PG8_WAIT_L(n) asm volatile("s_waitcnt lgkmcnt(" #n ")" ::: "memory")
#define PG8_BAR __builtin_amdgcn_s_barrier()
#define PG8_SCHED __builtin_amdgcn_sched_barrier(0)
    Unit cur, nxt; int ui = 0;
    if (!S.next(0, cur)) return;
    f32x4 acc[2][2][4][2];
#pragma unroll
    for (int a = 0; a < 2; ++a)
#pragma unroll
        for (int b = 0; b < 2; ++b)
#pragma unroll
            for (int m = 0; m < 4; ++m)
#pragma unroll
                for (int n = 0; n < 2; ++n) acc[a][b][m][n] = (f32x4){0.f, 0.f, 0.f, 0.f};
    bf16x8 At[4][2], B0[2][2], B1[2][2];
    const char* cA = (const char*)g.A + (size_t)cur.pm * tstep; const char* cB = (const char*)g.Bt + (size_t)cur.pn * tstep;
    S.a_ready(cur);
    if constexpr (SP2) {
        PG8_STAGE(PG8_SB(0, 0), cB, voffB); PG8_STAGE(PG8_SB(0, 1), cB + hstep, voffB); PG8_STAGE(PG8_SA(0, 0), cA, voffA); PG8_STAGE(PG8_SA(0, 1), cA + hstep, voffA);
        if (wr == 1) PG8_BAR;
        PG8_WAIT_V(2); PG8_BAR;
        PG8_STAGE(PG8_SB(1, 0), cB + kstep, voffB); PG8_STAGE(PG8_SA(1, 0), cA + kstep, voffA); PG8_STAGE(PG8_SB(1, 1), cB + hstep + kstep, voffB);
        PG8_WAIT_V(6); PG8_BAR;
    } else {
        PG8_STAGE(PG8_SB(0, 0), cB, voffB); PG8_STAGE(PG8_SA(0, 0), cA, voffA); PG8_STAGE(PG8_SB(0, 1), cB + hstep, voffB); PG8_STAGE(PG8_SA(0, 1), cA + hstep, voffA);
        if (wr == 1) PG8_BAR;
        PG8_WAIT_V(4); PG8_BAR;
        PG8_STAGE(PG8_SB(1, 0), cB + kstep, voffB); PG8_STAGE(PG8_SA(1, 0), cA + kstep, voffA); PG8_STAGE(PG8_SB(1, 1), cB + hstep + kstep, voffB);
        PG8_WAIT_V(6); PG8_BAR;
    }
    for (;;) {
        const bool has_next = S.next(ui + 1, nxt);
        const char* nA = has_next ? (const char*)g.A + (size_t)nxt.pm * tstep : cA; const char* nB = has_next ? (const char*)g.Bt + (size_t)nxt.pn * tstep : cB;
        for (int t = 0; t < nt; t += 2) {
            const bool last = (t == nt - 2);
            const char* a1 = cA + (size_t)(t + 1) * kstep;
            const char* a2 = last ? nA : cA + (size_t)(t + 2) * kstep; const char* b2 = last ? nB : cB + (size_t)(t + 2) * kstep;
            const char* a3 = a2 + kstep; const char* b3 = b2 + kstep;
            if (last && has_next) S.a_ready(nxt);
            if constexpr (SP2) {
            PG8_LDB(B0, 0, 0); PG8_LDB(B1, 0, 1); PG8_SCHED; PG8_LDA(At, 0, 0); PG8_STAGE(PG8_SA(1, 1), a1 + hstep, voffA);
            PG8_WAIT_V(8); PG8_WAIT_L(0); PG8_BAR; PG8_MMA(0, 0, At, B0); PG8_MMA(0, 1, At, B1); PG8_BAR; PG8_SCHED;
            PG8_LDA(At, 0, 1); PG8_STAGE(PG8_SB(0, 0), b2, voffB); PG8_STAGE(PG8_SB(0, 1), b2 + hstep, voffB); PG8_STAGE(PG8_SA(0, 0), a2, voffA);
            PG8_WAIT_V(8); PG8_WAIT_L(0); PG8_BAR; PG8_MMA(1, 0, At, B0); PG8_MMA(1, 1, At, B1); PG8_BAR; PG8_SCHED;
            PG8_LDB(B0, 1, 0); PG8_LDB(B1, 1, 1); PG8_SCHED; PG8_LDA(At, 1, 0); PG8_STAGE(PG8_SA(0, 1), a2 + hstep, voffA);
            PG8_WAIT_V(8); PG8_WAIT_L(0); PG8_BAR; PG8_MMA(0, 0, At, B0); PG8_MMA(0, 1, At, B1); PG8_BAR; PG8_SCHED;
            PG8_LDA(At, 1, 1); PG8_STAGE(PG8_SB(1, 0), b3, voffB); PG8_STAGE(PG8_SB(1, 1), b3 + hstep, voffB); PG8_STAGE(PG8_SA(1, 0), a3, voffA);
            PG8_WAIT_V(8); PG8_WAIT_L(0); PG8_BAR; PG8_MMA(1, 0, At, B0); PG8_MMA(1, 1, At, B1); PG8_BAR; PG8_SCHED;
            } else {
            PG8_LDB(B0, 0, 0); PG8_SCHED; PG8_LDA(At, 0, 0); PG8_STAGE(PG8_SA(1, 1), a1 + hstep, voffA);
            PG8_WAIT_L(8); PG8_BAR; PG8_WAIT_L(0); PG8_MMA(0, 0, At, B0); PG8_BAR; PG8_SCHED;
            PG8_LDB(B1, 0, 1); PG8_STAGE(PG8_SB(0, 0), b2, voffB);
            PG8_BAR; PG8_WAIT_L(0); PG8_MMA(0, 1, At, B1); PG8_BAR;
            PG8_LDA(At, 0, 1); PG8_STAGE(PG8_SA(0, 0), a2, voffA);
            PG8_BAR; PG8_WAIT_L(0); PG8_MMA(1, 0, At, B0); PG8_BAR; PG8_SCHED;
            PG8_STAGE(PG8_SB(0, 1), b2 + hstep, voffB);
            PG8_WAIT_V(6); PG8_BAR; PG8_MMA(1, 1, At, B1); PG8_BAR;
            PG8_LDB(B0, 1, 0); PG8_SCHED; PG8_LDA(At, 1, 0); PG8_STAGE(PG8_SA(0, 1), a2 + hstep, voffA);
            PG8_WAIT_L(8); PG8_BAR; PG8_WAIT_L(0); PG8_MMA(0, 0, At, B0); PG8_BAR; PG8_SCHED;
            PG8_LDB(B1, 1, 1); PG8_STAGE(PG8_SB(1, 0), b3, voffB);
            PG8_BAR; PG8_WAIT_L(0); PG8_MMA(0, 1, At, B1); PG8_BAR;
            PG8_LDA(At, 1, 1); PG8_STAGE(PG8_SA(1, 0), a3, voffA);
            PG8_BAR; PG8_WAIT_L(0); PG8_MMA(1, 0, At, B0); PG8_BAR; PG8_SCHED;
            PG8_STAGE(PG8_SB(1, 1), b3 + hstep, voffB);
            PG8_WAIT_V(6); PG8_BAR; PG8_MMA(1, 1, At, B1); PG8_BAR;
            }
        }
        if constexpr (ALIGN_EPI) { if (wr == 0) PG8_BAR; }
        if constexpr (!Epi::AFTER_DRAIN) { E(acc, cur, wr, wc, fr, fq); S.done(cur); }
        if (!has_next) break;
#pragma unroll
        for (int a = 0; a < 2; ++a)
#pragma unroll
            for (int b = 0; b < 2; ++b)
#pragma unroll
                for (int m = 0; m < 4; ++m)
#pragma unroll
                    for (int n = 0; n < 2; ++n) acc[a][b][m][n] = (f32x4){0.f, 0.f, 0.f, 0.f};
        cur = nxt; cA = nA; cB = nB; ++ui;
        if constexpr (ALIGN_EPI) { if (wr == 1) PG8_BAR; }
    }
    PG8_WAIT_V(0);
    if constexpr (!ALIGN_EPI) { if (wr == 0) PG8_BAR; }
    PG8_BAR;
    if constexpr (Epi::AFTER_DRAIN) { E.fused(acc, cur, wr, wc, fr, fq, lds, wid, lane); S.done(cur); }
#undef PG8_SA
#undef PG8_SB
#undef PG8_STAGE
#undef PG8_LDA
#undef PG8_LDB
#undef PG8_MMA
#undef PG8_WAIT_V
#undef PG8_WAIT_L
#undef PG8_BAR
#undef PG8_SCHED
}
}

constexpr int NWAVES = 8, NTHR = 512;
constexpr int BATCH = 32, SEQ = 2048, DM = 1024, DEPTH = 2, MTOK = BATCH * SEQ;
constexpr int NIN = 3230, NINP = 3328, DFF = 2816, NGU = 2 * DFF;
constexpr int PC_QKV = 0, PC_Z = 1152, PC_CF = 1536, PC_NQ = 2048, PC_KC = 2432, PC_VC = 2560, PC_KS = 2688, PC_VS = 2816, PC_KW = 2944, PC_VW = 3072, PC_B = 3200, PC_A = 3206, PC_GATE = 3212;
constexpr float EPS = 1e-6f;
constexpr int CMP_ROWS = 16384, CMP_K = 2048;
constexpr int NPH = 10;

constexpr size_t MiB = 1u << 20;
constexpr size_t WS_CTL = 0, CTL_ZERO_BYTES = 1 * MiB;
constexpr size_t WS_WIN = 2 * MiB;
constexpr size_t WS_WOUT = 16 * MiB;
constexpr size_t WS_WGU = 20 * MiB;
constexpr size_t WS_WD = 42 * MiB;
constexpr size_t WS_WC1 = 53 * MiB;
constexpr size_t WS_KC = 56 * MiB;
constexpr size_t WS_VCT = 57 * MiB;
constexpr size_t WS_PROJ = 64 * MiB;
constexpr size_t WS_MIX = 480 * MiB;
constexpr size_t WS_MBUF = 608 * MiB;
constexpr size_t WS_XB = 736 * MiB;
constexpr size_t WS_ACMP = 864 * MiB;
constexpr size_t WS_HID = 928 * MiB;
constexpr size_t WS_KS = 936 * MiB, WS_KW = 952 * MiB, WS_VST = 968 * MiB, WS_VWT = 984 * MiB;
constexpr size_t WS_END = 1000 * MiB;
constexpr int CW_TMO = 0, CW_BAR = 4096;

constexpr int RING_OFF = 0, RING_BYTES = 131072;
constexpr int LDSCTL_OFF = RING_BYTES, MISC_OFF = LDSCTL_OFF + 320;
constexpr int LDS_BYTES = 147456;

#define GAS __attribute__((address_space(1)))
#define LAS __attribute__((address_space(3)))
typedef unsigned short bf16;
typedef unsigned v4u __attribute__((ext_vector_type(4)));
typedef unsigned v2u __attribute__((ext_vector_type(2)));
typedef float f32x4 __attribute__((ext_vector_type(4)));
typedef float f32x2 __attribute__((ext_vector_type(2)));
typedef short bf16x8 __attribute__((ext_vector_type(8)));
typedef __bf16 bf16x2_t __attribute__((ext_vector_type(2)));
#define LDS_WAIT() asm volatile("s_waitcnt lgkmcnt(0)" ::: "memory")
#define VM_WAIT() asm volatile("s_waitcnt vmcnt(0)" ::: "memory")
__device__ __forceinline__ unsigned cvtpk(float lo, float hi) { f32x2 v = {lo, hi}; bf16x2_t b = __builtin_convertvector(v, bf16x2_t); return __builtin_bit_cast(unsigned, b); }
__device__ __forceinline__ bf16 f2bf(float f) { return (bf16)(cvtpk(f, 0.f) & 0xffffu); }
__device__ __forceinline__ float bf2f(bf16 v) { return __uint_as_float(((unsigned)v) << 16); }
__device__ __forceinline__ float bflo(unsigned w) { return __uint_as_float(w << 16); }
__device__ __forceinline__ float bfhi(unsigned w) { return __uint_as_float(w & 0xffff0000u); }
__device__ __forceinline__ float sigmoid_f(float v) { return 1.0f / (1.0f + __expf(-v)); }
__device__ __forceinline__ float silu_f(float v) { return v / (1.0f + __expf(-v)); }
__device__ __forceinline__ float wave_sum(float v) {
#pragma unroll
    for (int o = 1; o < 64; o <<= 1) v += __shfl_xor(v, o);
    return v;
}

#define XB_TMO      128
#define XB_XCNT(j)  (256  + 64 * (j))
#define XB_XSUB(j)  (1280 + 64 * (j))
#define XB_XGEN(j)  (2304 + 64 * (j))
#define XB_TOP      3328
#define XB_TOPGEN   3392
#define XCD_BAR_WORDS 3456
#define XB_SPIN_CAP (1u << 18)
__device__ __forceinline__ unsigned xb_ld(unsigned* p)              { return __hip_atomic_load(p, __ATOMIC_RELAXED, __HIP_MEMORY_SCOPE_AGENT); }
__device__ __forceinline__ unsigned xb_add(unsigned* p, unsigned v) { return __hip_atomic_fetch_add(p, v, __ATOMIC_RELAXED, __HIP_MEMORY_SCOPE_AGENT); }
__device__ __forceinline__ unsigned xb_xcc_id() { return (unsigned)__builtin_amdgcn_s_getreg((3 << 11) | 20) & 0xFu; }
#define XB_SPIN(cond, bar) do { unsigned _sp = 0; while (cond) { __builtin_amdgcn_s_sleep(1); \
    if ((++_sp & 255u) == 0u) { if (xb_ld(&(bar)[XB_TMO])) break; if (_sp > XB_SPIN_CAP) { atomicAdd(&(bar)[XB_TMO], 1u); break; } } } } while (0)
struct XcdBarrier { unsigned* bar; unsigned x; volatile LAS unsigned* st; };
__device__ __forceinline__ XcdBarrier xcd_barrier_post(unsigned* bar, volatile LAS unsigned* st) {
    XcdBarrier b; b.bar = bar; b.x = xb_xcc_id(); b.st = st;
    if (threadIdx.x == 0) (void)xb_add(&bar[XB_XCNT(b.x)], 1u);
    return b;
}
__device__ __forceinline__ void xcd_barrier_complete(unsigned* bar, unsigned x, unsigned& nloc, unsigned& nx) {
    const unsigned G = gridDim.x * gridDim.y * gridDim.z;
    unsigned sum, cnt, mine, sp = 0u;
    for (;;) {
        sum = 0u; cnt = 0u; mine = 0u;
#pragma unroll
        for (unsigned j = 0; j < 16; ++j) { const unsigned c = xb_ld(&bar[XB_XCNT(j)]); sum += c; cnt += (c > 0u) ? 1u : 0u; mine = (j == x) ? c : mine; }
        if (sum == G) break;
        __builtin_amdgcn_s_sleep(1);
        if ((++sp & 255u) == 0u) { if (xb_ld(&bar[XB_TMO])) break; if (sp > XB_SPIN_CAP) { atomicAdd(&bar[XB_TMO], 1u); break; } }
    }
    nloc = mine > 0u ? mine : 1u; nx = cnt > 0u ? cnt : 1u;
}
__device__ __forceinline__ void xcd_barrier(const XcdBarrier& b) {
    asm volatile("s_waitcnt vmcnt(0)" ::: "memory");
    __syncthreads();
    if (threadIdx.x == 0) {
        unsigned* bar = b.bar;
        __builtin_amdgcn_s_waitcnt(0);
        unsigned nloc = b.st[0], nx = b.st[1];
        if (nloc == 0u) { xcd_barrier_complete(bar, b.x, nloc, nx); b.st[0] = nloc; b.st[1] = nx; }
        const unsigned old = xb_add(&bar[XB_XSUB(b.x)], 1u);
        const unsigned gen = old / nloc;
        if (old + 1u == (gen + 1u) * nloc) {
            __builtin_amdgcn_fence(__ATOMIC_RELEASE, "agent");
            asm volatile("s_waitcnt vmcnt(0)" ::: "memory");
            const unsigned og = xb_add(&bar[XB_TOP], 1u);
            const unsigned tg = og / nx;
            if (og + 1u == (tg + 1u) * nx) xb_add(&bar[XB_TOPGEN], 1u);
            else XB_SPIN(xb_ld(&bar[XB_TOPGEN]) == tg, bar);
            __builtin_amdgcn_fence(__ATOMIC_ACQUIRE, "agent");
            xb_add(&bar[XB_XGEN(b.x)], 1u);
            asm volatile("s_waitcnt vmcnt(0)" ::: "memory");
        } else {
            XB_SPIN(xb_ld(&bar[XB_XGEN(b.x)]) == gen, bar);
            __builtin_amdgcn_fence(__ATOMIC_ACQUIRE, "agent");
            asm volatile("s_waitcnt vmcnt(0)" ::: "memory");
        }
    }
    __syncthreads();
}

template <class SrcFn>
__device__ __forceinline__ void wprep_item(const SrcFn& src, int K, bf16* WT, LAS float* scr, int item, int nblk, int lane) {
    const int kb = item / nblk, nb = item % nblk, k0 = 64 * kb, n0 = 32 * nb;
#pragma unroll 8
    for (int i = 0; i < 32; ++i) { const int kk = 2 * i + (lane >> 5); scr[kk * 33 + (lane & 31)] = src(k0 + kk, n0 + (lane & 31)); }
    LDS_WAIT(); asm volatile("" ::: "memory");
    const int c = lane & 7;
#pragma unroll
    for (int j = 0; j < 4; ++j) { const int n = (lane >> 3) + 8 * j; const LAS float* s = scr + (8 * c) * 33 + n;
        v4u o; o.x = cvtpk(s[0 * 33], s[1 * 33]); o.y = cvtpk(s[2 * 33], s[3 * 33]); o.z = cvtpk(s[4 * 33], s[5 * 33]); o.w = cvtpk(s[6 * 33], s[7 * 33]);
        *(v4u*)(WT + (size_t)(n0 + n) * K + k0 + 8 * c) = o; }
    LDS_WAIT(); asm volatile("" ::: "memory");
}
__device__ __forceinline__ int win_src_col(int n) {
    return n < 1536 ? n : (n < 3200 ? n + 12 : (n < 3212 ? n - 3200 + 1536 : (n < NIN ? n : -1)));
}
__device__ __forceinline__ void norm_row_to_bf16(const float* xrow, bf16* orow, int lane) {
    const f32x4* xr = (const f32x4*)xrow + lane;
    f32x4 v[4]; float s = 0.f;
#pragma unroll
    for (int j = 0; j < 4; ++j) { v[j] = xr[64 * j]; s += (v[j].x * v[j].x + v[j].y * v[j].y) + (v[j].z * v[j].z + v[j].w * v[j].w); }
    const float r = rsqrtf(wave_sum(s) * (1.f / DM) + EPS);
    v2u* o8 = (v2u*)orow + lane;
#pragma unroll
    for (int j = 0; j < 4; ++j) { v2u w; w.x = cvtpk(v[j].x * r, v[j].y * r); w.y = cvtpk(v[j].z * r, v[j].w * r); o8[64 * j] = w; }
}
__device__ __forceinline__ void resid_row(const float* xrow, const bf16* mrow, const float* wpost, float* orow, bf16* xbrow, int lane) {
    const f32x4* xr = (const f32x4*)xrow + lane; const v2u* mr = (const v2u*)mrow + lane; const f32x4* wr = (const f32x4*)wpost + lane;
    f32x4 xv[4], mv[4]; float ss = 0.f;
#pragma unroll
    for (int j = 0; j < 4; ++j) { xv[j] = xr[64 * j]; const v2u w = mr[64 * j]; mv[j] = (f32x4){bflo(w.x), bfhi(w.x), bflo(w.y), bfhi(w.y)};
        ss += (mv[j].x * mv[j].x + mv[j].y * mv[j].y) + (mv[j].z * mv[j].z + mv[j].w * mv[j].w); }
    const float r = rsqrtf(wave_sum(ss) * (1.f / DM) + EPS);
    float s2 = 0.f;
#pragma unroll
    for (int j = 0; j < 4; ++j) { const f32x4 w = wr[64 * j]; xv[j] = xv[j] + mv[j] * r * w;
        s2 += (xv[j].x * xv[j].x + xv[j].y * xv[j].y) + (xv[j].z * xv[j].z + xv[j].w * xv[j].w); }
    const float r2 = rsqrtf(wave_sum(s2) * (1.f / DM) + EPS);
    f32x4* orw = (f32x4*)orow + lane; v2u* o8 = (v2u*)xbrow + lane;
#pragma unroll
    for (int j = 0; j < 4; ++j) { orw[64 * j] = xv[j]; v2u w; w.x = cvtpk(xv[j].x * r2, xv[j].y * r2); w.y = cvtpk(xv[j].z * r2, xv[j].w * r2); o8[64 * j] = w; }
}

#define MFMA16(a, b, c) __builtin_amdgcn_mfma_f32_16x16x32_bf16((a), (b), (c), 0, 0, 0)
__device__ __forceinline__ bf16x8 pack8(const f32x4& a, const f32x4& b) {
    v4u w; w.x = cvtpk(a[0], a[1]); w.y = cvtpk(a[2], a[3]); w.z = cvtpk(b[0], b[1]); w.w = cvtpk(b[2], b[3]); return __builtin_bit_cast(bf16x8, w);
}
constexpr float NSA_SC = 0.125f * 1.4426950408889634f;
template <int MODE>
__device__ __forceinline__ void nsa_step(const bf16* __restrict__ kbase, const bf16* __restrict__ vtbase, int vt_ld, int key0, int tq, bool selbit,
                                         const bf16x8 (&qf)[3][2], float (&mrun)[3], float (&lrun)[3], f32x4 (&O)[3][4], int c, int gq) {
    bf16x8 ka[2][2], va[4];
#pragma unroll
    for (int sub = 0; sub < 2; ++sub)
#pragma unroll
        for (int s = 0; s < 2; ++s) ka[sub][s] = *(const bf16x8*)(kbase + (size_t)(key0 + 16 * sub + c) * 64 + 32 * s + 8 * gq);
#pragma unroll
    for (int dt = 0; dt < 4; ++dt) va[dt] = *(const bf16x8*)(vtbase + (size_t)(16 * dt + c) * vt_ld + key0 + 8 * gq);
    const int kA = key0 + 4 * gq;
#pragma unroll
    for (int h = 0; h < 3; ++h) {
        f32x4 sA = {0.f, 0.f, 0.f, 0.f}, sB = {0.f, 0.f, 0.f, 0.f};
        sA = MFMA16(ka[0][0], qf[h][0], sA); sA = MFMA16(ka[0][1], qf[h][1], sA);
        sB = MFMA16(ka[1][0], qf[h][0], sB); sB = MFMA16(ka[1][1], qf[h][1], sB);
        float v[8];
#pragma unroll
        for (int r = 0; r < 4; ++r) { const int k1 = kA + r, k2 = kA + 16 + r;
            const bool ok1 = (MODE == 0) ? (k1 <= tq && k1 > tq - 512) : (selbit && k1 <= tq);
            const bool ok2 = (MODE == 0) ? (k2 <= tq && k2 > tq - 512) : (selbit && k2 <= tq);
            v[r] = ok1 ? sA[r] * NSA_SC : -1e30f; v[4 + r] = ok2 ? sB[r] * NSA_SC : -1e30f; }
        float mx = fmaxf(fmaxf(fmaxf(v[0], v[1]), fmaxf(v[2], v[3])), fmaxf(fmaxf(v[4], v[5]), fmaxf(v[6], v[7])));
        mx = fmaxf(mx, __shfl_xor(mx, 16)); mx = fmaxf(mx, __shfl_xor(mx, 32));
        const float mnew = fmaxf(mrun[h], mx); const float alpha = __builtin_amdgcn_exp2f(mrun[h] - mnew); mrun[h] = mnew;
        float p[8]; float ps = 0.f;
#pragma unroll
        for (int i = 0; i < 8; ++i) { p[i] = __builtin_amdgcn_exp2f(v[i] - mnew); ps += p[i]; }
        lrun[h] = lrun[h] * alpha + ps;
        const bf16x8 pf = pack8((f32x4){p[0], p[1], p[2], p[3]}, (f32x4){p[4], p[5], p[6], p[7]});
#pragma unroll
        for (int dt = 0; dt < 4; ++dt) { O[h][dt] = O[h][dt] * alpha; O[h][dt] = MFMA16(va[dt], pf, O[h][dt]); }
    }
}
struct NsaPtrs { const bf16* proj; const bf16* kc; const bf16* vct; const bf16* ks; const bf16* vst; const bf16* kw; const bf16* vwt; bf16* mix; };
__device__ __forceinline__ void nsa_item(const NsaPtrs& P, LAS f32x4* outl, int b, int g, int t0, int lane) {
    const int c = lane & 15, gq = lane >> 4;
    const int tq = t0 + c, cur = t0 >> 6;
    const bf16* prow = P.proj + ((size_t)b * SEQ + tq) * NINP;
#define NSA_GATE(br, h) sigmoid_f(bf2f(prow[PC_GATE + (br) * 6 + g * 3 + (h)]))
    const bf16* kc = P.kc + (size_t)(b * 2 + g) * 128 * 64;
    const bf16* vct = P.vct + (size_t)(b * 2 + g) * 64 * 128;
    float imp[8];
#pragma unroll
    for (int st = 0; st < 8; ++st) imp[st] = 0.f;
#pragma unroll 1
    for (int h = 0; h < 3; ++h) {
        asm volatile("" ::: "memory");
        const bf16x8 qh0 = *(const bf16x8*)(prow + PC_NQ + (g * 3 + h) * 64 + 8 * gq), qh1 = *(const bf16x8*)(prow + PC_NQ + (g * 3 + h) * 64 + 32 + 8 * gq);
        f32x4 s[8];
#pragma unroll
        for (int st = 0; st < 8; ++st) { const bf16x8 a0 = *(const bf16x8*)(kc + (16 * st + c) * 64 + 8 * gq), a1 = *(const bf16x8*)(kc + (16 * st + c) * 64 + 32 + 8 * gq);
            f32x4 z = {0.f, 0.f, 0.f, 0.f}; z = MFMA16(a0, qh0, z); z = MFMA16(a1, qh1, z); s[st] = z; }
        float mx = -1e30f;
#pragma unroll
        for (int st = 0; st < 8; ++st)
#pragma unroll
            for (int r = 0; r < 4; ++r) { const int i = 16 * st + 4 * gq + r; const bool ok = (16 * i + 31 <= tq) && (i < 127);
                const float v = ok ? s[st][r] * NSA_SC : -1e30f; s[st][r] = v; mx = fmaxf(mx, v); }
        mx = fmaxf(mx, __shfl_xor(mx, 16)); mx = fmaxf(mx, __shfl_xor(mx, 32)); mx = fmaxf(mx, -1e20f);
        float sum = 0.f;
#pragma unroll
        for (int st = 0; st < 8; ++st)
#pragma unroll
            for (int r = 0; r < 4; ++r) { const float p = __builtin_amdgcn_exp2f(s[st][r] - mx); s[st][r] = p; sum += p; }
        sum += __shfl_xor(sum, 16); sum += __shfl_xor(sum, 32);
        const float inv = sum > 0.f ? 1.0f / sum : 0.f;
#pragma unroll
        for (int st = 0; st < 8; ++st) s[st] = s[st] * inv;
        float sh[8];
#pragma unroll
        for (int st = 0; st < 8; ++st) sh[st] = __shfl(s[st][3], (lane + 48) & 63);
#pragma unroll
        for (int st = 0; st < 8; ++st) { const float prev = gq > 0 ? sh[st] : (st > 0 ? sh[st > 0 ? st - 1 : 0] : 0.f);
            imp[st] += (s[st][0] + s[st][1]) + (s[st][2] + s[st][3]) + prev; }
        f32x4 Oc[4];
#pragma unroll
        for (int dt = 0; dt < 4; ++dt) Oc[dt] = (f32x4){0.f, 0.f, 0.f, 0.f};
#pragma unroll
        for (int ks = 0; ks < 4; ++ks) { const bf16x8 pf = pack8(s[2 * ks], s[2 * ks + 1]);
#pragma unroll
            for (int dt = 0; dt < 4; ++dt) { const bf16x8 vf = *(const bf16x8*)(vct + (16 * dt + c) * 128 + 32 * ks + 8 * gq); Oc[dt] = MFMA16(vf, pf, Oc[dt]); } }
        { const float gt = NSA_GATE(0, h);
#pragma unroll
        for (int dt = 0; dt < 4; ++dt) outl[(h * 4 + dt) * 64 + lane] = Oc[dt] * gt; }
    }
    unsigned selmask = 0u;
    {
        float sc[8];
#pragma unroll
        for (int st = 0; st < 8; ++st) { const int j = 4 * st + gq; const bool elig = j <= cur, forced = (j == 0) || (j == cur) || (j == cur - 1);
            sc[st] = elig ? (imp[st] + (forced ? 1e4f : 0.f)) : -1e4f; }
#pragma unroll
        for (int it = 0; it < 8; ++it) {
            float bv = sc[0]; int bj = gq;
#pragma unroll
            for (int st = 1; st < 8; ++st) if (sc[st] > bv) { bv = sc[st]; bj = 4 * st + gq; }
#pragma unroll
            for (int off = 16; off <= 32; off <<= 1) { const float ov = __shfl_xor(bv, off); const int oj = __shfl_xor(bj, off);
                if (ov > bv || (ov == bv && oj < bj)) { bv = ov; bj = oj; } }
            selmask |= 1u << bj;
#pragma unroll
            for (int st = 0; st < 8; ++st) if (4 * st + gq == bj) sc[st] = -3e38f;
        }
    }
    bf16x8 qf[3][2];
#pragma unroll
    for (int h = 0; h < 3; ++h)
#pragma unroll
        for (int s = 0; s < 2; ++s) qf[h][s] = *(const bf16x8*)(prow + PC_NQ + (g * 3 + h) * 64 + 32 * s + 8 * gq);
    float mrun[3], lrun[3]; f32x4 O[3][4];
    {
        const bf16* kw = P.kw + (size_t)(b * 2 + g) * SEQ * 64; const bf16* vwt = P.vwt + (size_t)(b * 2 + g) * 64 * SEQ;
#pragma unroll
        for (int h = 0; h < 3; ++h) { mrun[h] = -1e20f; lrun[h] = 0.f;
#pragma unroll
            for (int dt = 0; dt < 4; ++dt) O[h][dt] = (f32x4){0.f, 0.f, 0.f, 0.f}; }
        asm volatile("" ::: "memory");
        int klo = t0 - 511; klo = klo < 0 ? 0 : klo; klo &= ~31;
        for (int key0 = klo; key0 <= t0 + 15; key0 += 32) nsa_step<0>(kw, vwt, SEQ, key0, tq, true, qf, mrun, lrun, O, c, gq);
#pragma unroll
        for (int h = 0; h < 3; ++h) { float lt = lrun[h]; lt += __shfl_xor(lt, 16); lt += __shfl_xor(lt, 32); const float inv = lt > 0.f ? NSA_GATE(2, h) / lt : 0.f;
#pragma unroll
            for (int dt = 0; dt < 4; ++dt) outl[(h * 4 + dt) * 64 + lane] = outl[(h * 4 + dt) * 64 + lane] + O[h][dt] * inv; }
        asm volatile("" ::: "memory");
    }
    {
        const bf16* ks = P.ks + (size_t)(b * 2 + g) * SEQ * 64; const bf16* vst = P.vst + (size_t)(b * 2 + g) * 64 * SEQ;
#pragma unroll
        for (int h = 0; h < 3; ++h) { mrun[h] = -1e20f; lrun[h] = 0.f;
#pragma unroll
            for (int dt = 0; dt < 4; ++dt) O[h][dt] = (f32x4){0.f, 0.f, 0.f, 0.f}; }
        for (int jb = 0; jb <= cur; ++jb) {
            const bool selbit = (selmask >> jb) & 1u;
            if (!__any(selbit)) continue;
            nsa_step<1>(ks, vst, SEQ, 64 * jb, tq, selbit, qf, mrun, lrun, O, c, gq);
            if (64 * jb + 32 <= t0 + 15) nsa_step<1>(ks, vst, SEQ, 64 * jb + 32, tq, selbit, qf, mrun, lrun, O, c, gq);
        }
        asm volatile("" ::: "memory");
#pragma unroll
        for (int h = 0; h < 3; ++h) { float lt = lrun[h]; lt += __shfl_xor(lt, 16); lt += __shfl_xor(lt, 32); const float inv = lt > 0.f ? NSA_GATE(1, h) / lt : 0.f;
            bf16* orow = P.mix + ((size_t)b * SEQ + tq) * DM + 640 + g * 192 + h * 64;
#pragma unroll
            for (int dt = 0; dt < 4; ++dt) { const f32x4 o = outl[(h * 4 + dt) * 64 + lane] + O[h][dt] * inv;
                v2u w; w.x = cvtpk(o[0], o[1]); w.y = cvtpk(o[2], o[3]); *(v2u*)(orow + 16 * dt + 4 * gq) = w; } }
    }
#undef NSA_GATE
}

struct Args { const float* in[21]; float* out; unsigned char* ws; int pre, ph_lo, ph_hi, l_lo, l_hi, pad; };
enum { I_X = 0, I_NORMW, I_WIN, I_DNCONV, I_DNALOG, I_DNDT, I_DNNORM, I_CFW, I_CFB, I_CFLNW, I_CFLNB, I_KPOS, I_VPOS, I_KW1, I_KW2, I_VW1, I_VW2, I_WOUT, I_WG, I_WU, I_WD };

template <unsigned PHM> __global__ void __launch_bounds__(NTHR, 2) fwd(Args args) {
    extern __shared__ __attribute__((aligned(16))) unsigned char lds_raw[];
    LAS unsigned char* lds = (LAS unsigned char*)lds_raw;
    volatile LAS unsigned* MISC = (volatile LAS unsigned*)(lds + MISC_OFF);
    const int tid = threadIdx.x, lane = tid & 63, wave = __builtin_amdgcn_readfirstlane(tid >> 6);
    const int G = gridDim.x, blk = blockIdx.x;
    unsigned char* ws = args.ws;
    unsigned* ctl = (unsigned*)(ws + WS_CTL);
    bf16* const Win_t = (bf16*)(ws + WS_WIN); bf16* const Wout_t = (bf16*)(ws + WS_WOUT); bf16* const Wgu_t = (bf16*)(ws + WS_WGU); bf16* const Wd_t = (bf16*)(ws + WS_WD); bf16* const Wc1_t = (bf16*)(ws + WS_WC1);
    bf16* const KC = (bf16*)(ws + WS_KC); bf16* const VCT = (bf16*)(ws + WS_VCT);
    bf16* const PROJ = (bf16*)(ws + WS_PROJ); bf16* const HFF = (bf16*)(ws + WS_PROJ); bf16* const MIX = (bf16*)(ws + WS_MIX); bf16* const MBUF = (bf16*)(ws + WS_MBUF); bf16* const XB = (bf16*)(ws + WS_XB);
    bf16* const ACMP = (bf16*)(ws + WS_ACMP); bf16* const HID = (bf16*)(ws + WS_HID);
    bf16* const KS = (bf16*)(ws + WS_KS); bf16* const KW = (bf16*)(ws + WS_KW); bf16* const VST = (bf16*)(ws + WS_VST); bf16* const VWT = (bf16*)(ws + WS_VWT);
    const float* const x_in = args.in[I_X]; float* const xres = args.out;

    for (int u = tid; u < (LDS_BYTES - LDSCTL_OFF) / 4; u += NTHR) ((LAS unsigned*)(lds + LDSCTL_OFF))[u] = 0u;
    __syncthreads();
#if MK_ONE_LAUNCH
    XcdBarrier bar = xcd_barrier_post(ctl + CW_BAR, MISC + 8);
#define GRID_BAR() xcd_barrier(bar)
#else
#define GRID_BAR() do { } while (0)
#endif
    const int gw = blk * NWAVES + wave, NGW = G * NWAVES;

    if ((PHM & 1u) && args.pre) {
        LAS float* scr = (LAS float*)(lds + RING_OFF + wave * 16384);
        constexpr int IT_IN = 16 * 104, IT_OUT = 16 * 32, IT_GU = 16 * 176, IT_D = 44 * 32, IT_C1 = 32 * 8, IT_L = IT_IN + IT_OUT + IT_GU + IT_D + IT_C1;
        for (int it = gw; it < DEPTH * IT_L; it += NGW) {
            const int l = it / IT_L; int r = it % IT_L;
            const float* nw = args.in[I_NORMW] + (size_t)l * 4 * DM;
            if (r < IT_IN) { const float* W = args.in[I_WIN] + (size_t)l * DM * NIN; const float* sc = nw;
                wprep_item([=](int k, int n) { const int col = win_src_col(n); return col >= 0 ? W[(size_t)k * NIN + col] * sc[k] : 0.f; }, DM, Win_t + (size_t)l * NINP * DM, scr, r, 104, lane); continue; } r -= IT_IN;
            if (r < IT_OUT) { const float* W = args.in[I_WOUT] + (size_t)l * DM * DM;
                wprep_item([=](int k, int n) { return W[(size_t)k * DM + n]; }, DM, Wout_t + (size_t)l * DM * DM, scr, r, 32, lane); continue; } r -= IT_OUT;
            if (r < IT_GU) { const float* Wg = args.in[I_WG] + (size_t)l * DM * DFF; const float* Wu = args.in[I_WU] + (size_t)l * DM * DFF; const float* sc = nw + 2 * DM;
                wprep_item([=](int k, int n) { const int t = n >> 8, w = n & 255; const ptrdiff_t sel = w < 128 ? (ptrdiff_t)0 : (Wu - Wg); return Wg[sel + (ptrdiff_t)k * DFF + 128 * t + (w & 127)] * sc[k]; }, DM, Wgu_t + (size_t)l * NGU * DM, scr, r, 176, lane); continue; } r -= IT_GU;
            if (r < IT_D) { const float* W = args.in[I_WD] + (size_t)l * DFF * DM;
                wprep_item([=](int k, int n) { return W[(size_t)k * DM + n]; }, DFF, Wd_t + (size_t)l * DM * DFF, scr, r, 32, lane); continue; } r -= IT_D;
            { const float* Wk = args.in[I_KW1] + (size_t)l * CMP_K * 128; const float* Wv = args.in[I_VW1] + (size_t)l * CMP_K * 128;
                wprep_item([=](int k, int n) { const ptrdiff_t sel = n < 128 ? (ptrdiff_t)0 : (Wv - Wk); return Wk[sel + (ptrdiff_t)k * 128 + (n & 127)]; }, CMP_K, Wc1_t + (size_t)l * 256 * CMP_K, scr, r, 8, lane); }
        }
        for (int m = gw; m < MTOK; m += NGW) norm_row_to_bf16(x_in + (size_t)m * DM, XB + (size_t)m * DM, lane);
        GRID_BAR();
    }

    const int lo = args.ph_lo, hi = args.ph_hi;
#define IN(k) (((PHM >> (k)) & 1u) && lo <= (k) && (k) < hi)
    for (int l = args.l_lo; l < args.l_hi; ++l) {
        if (IN(1)) {
            pg8::Gemm g{XB, Win_t + (size_t)l * NINP * DM, MTOK, NINP, DM}; pg8::StaticOrder S; S.init(MTOK, NINP, G, blk);
            pg8::EpiBf16<0> E{PROJ, NINP};
            pg8::gemm_phase<pg8::EpiBf16<0>, pg8::StaticOrder, true, true>(lds + RING_OFF, g, S, E);
            GRID_BAR();
        }
        if (IN(2)) {
            {
                const float* kpos = args.in[I_KPOS] + (size_t)l * 32 * 64; const float* vpos = args.in[I_VPOS] + (size_t)l * 32 * 64;
                for (int row = gw; row < CMP_ROWS; row += NGW) {
                    const int i = row & 127, g = (row >> 7) & 1, b = (row >> 8) & 31, kv = row >> 13;
                    const float* pos = kv ? vpos : kpos; const int pc = (kv ? PC_VC : PC_KC) + g * 64;
#pragma unroll
                    for (int cch = 0; cch < 4; ++cch) { const int ch = lane + 64 * cch, tl = ch >> 3, d0 = (ch & 7) * 8;
                        v4u o = {0u, 0u, 0u, 0u};
                        if (i < 127) { const v4u s = *(const v4u*)(PROJ + ((size_t)b * SEQ + 16 * i + tl) * NINP + pc + d0);
                            const f32x4 p0 = *(const f32x4*)(pos + tl * 64 + d0), p1 = *(const f32x4*)(pos + tl * 64 + d0 + 4);
                            o.x = cvtpk(bflo(s.x) + p0.x, bfhi(s.x) + p0.y); o.y = cvtpk(bflo(s.y) + p0.z, bfhi(s.y) + p0.w);
                            o.z = cvtpk(bflo(s.z) + p1.x, bfhi(s.z) + p1.y); o.w = cvtpk(bflo(s.w) + p1.z, bfhi(s.w) + p1.w); }
                        *(v4u*)(ACMP + (size_t)row * CMP_K + tl * 64 + d0) = o; }
                }
            }
            for (size_t ch = (size_t)blk * NTHR + tid; ch < (size_t)MTOK * 32; ch += (size_t)G * NTHR) {
                const int cc = (int)(ch & 31), which = cc >> 4, g = (cc >> 3) & 1, d0 = (cc & 7) * 8; const size_t tok = ch >> 5; const int b = (int)(tok >> 11), t = (int)(tok & 2047);
                const v4u s = *(const v4u*)(PROJ + tok * NINP + (which ? PC_KW : PC_KS) + g * 64 + d0);
                *(v4u*)((which ? KW : KS) + ((size_t)(b * 2 + g) * SEQ + t) * 64 + d0) = s;
            }
            {
                LAS bf16* tile = (LAS bf16*)(lds + RING_OFF + wave * 16384);
                for (int it = gw; it < 2 * BATCH * 2 * 32; it += NGW) {
                    const int tt = it & 31, g = (it >> 5) & 1, b = (it >> 6) & 31, which = it >> 11; const int t0 = tt * 64;
                    const bf16* src = PROJ + ((size_t)b * SEQ + t0) * NINP + (which ? PC_VW : PC_VS) + g * 64;
#pragma unroll
                    for (int q = 0; q < 8; ++q) { const int t = (lane >> 3) + 8 * q, d0 = (lane & 7) * 8; const v4u s = *(const v4u*)(src + (size_t)t * NINP + d0);
                        LAS unsigned* dst = (LAS unsigned*)(tile + t * 66 + d0); dst[0] = s.x; dst[1] = s.y; dst[2] = s.z; dst[3] = s.w; }
                    LDS_WAIT(); asm volatile("" ::: "memory");
                    bf16* dstb = (which ? VWT : VST) + (size_t)(b * 2 + g) * 64 * SEQ + t0;
#pragma unroll
                    for (int q = 0; q < 8; ++q) { const int d = (lane >> 3) + 8 * q, ck = lane & 7, gI = ck >> 2, gqq = ck & 3;
                        unsigned short e[8];
#pragma unroll
                        for (int j = 0; j < 8; ++j) { const int key = 32 * gI + (j < 4 ? 4 * gqq + j : 16 + 4 * gqq + (j - 4)); e[j] = tile[key * 66 + d]; }
                        v4u o; o.x = e[0] | ((unsigned)e[1] << 16); o.y = e[2] | ((unsigned)e[3] << 16); o.z = e[4] | ((unsigned)e[5] << 16); o.w = e[6] | ((unsigned)e[7] << 16);
                        *(v4u*)(dstb + (size_t)d * SEQ + 8 * ck) = o; }
                    LDS_WAIT(); asm volatile("" ::: "memory");
                }
            }
            __syncthreads();
            {
                LAS float* hb = (LAS float*)(lds + RING_OFF); LAS float* yb = hb + 62 * 256;
                const float* dw = args.in[I_CFW] + (size_t)l * 31 * 256; const float* db = args.in[I_CFB] + (size_t)l * 256;
                const float* lw = args.in[I_CFLNW] + (size_t)l * 256; const float* lb = args.in[I_CFLNB] + (size_t)l * 256;
                for (int u = blk; u < BATCH * 64; u += G) {
                    const int b = u >> 6, t0 = (u & 63) * 32;
                    for (int e = tid; e < 62 * 256; e += NTHR) { const int rr = e >> 8, ch = e & 255, t = t0 - 30 + rr; float val = 0.f;
                        if (t >= 0) { const bf16* pr = PROJ + ((size_t)b * SEQ + t) * NINP + PC_CF; val = bf2f(pr[ch]) * sigmoid_f(bf2f(pr[256 + ch])); }
                        hb[e] = val; }
                    __syncthreads();
                    { const int ch = tid & 255, half = tid >> 8; float wv[31];
#pragma unroll
                        for (int j = 0; j < 31; ++j) wv[j] = dw[j * 256 + ch];
                        const float bias = db[ch];
                        for (int i = 16 * half; i < 16 * half + 16; ++i) { float acc = bias;
#pragma unroll
                            for (int j = 0; j < 31; ++j) acc += wv[j] * hb[(i + j) * 256 + ch];
                            yb[i * 256 + ch] = acc; } }
                    __syncthreads();
                    for (int i = wave * 4; i < wave * 4 + 4; ++i) { float y[4]; float s = 0.f;
#pragma unroll
                        for (int k = 0; k < 4; ++k) { y[k] = yb[i * 256 + lane + 64 * k]; s += y[k]; }
                        const float mean = wave_sum(s) * (1.f / 256.f); float q = 0.f;
#pragma unroll
                        for (int k = 0; k < 4; ++k) { y[k] -= mean; q += y[k] * y[k]; }
                        const float rs = rsqrtf(wave_sum(q) * (1.f / 256.f) + EPS);
                        bf16* orow = MIX + ((size_t)b * SEQ + t0 + i) * DM + 384;
#pragma unroll
                        for (int k = 0; k < 4; ++k) { const int ch = lane + 64 * k; orow[ch] = f2bf(silu_f(y[k] * rs * lw[ch] + lb[ch])); } }
                    __syncthreads();
                }
            }
            GRID_BAR();
        }
        if (IN(3)) {
            if (blk < 64) {
                pg8::Gemm g{ACMP, Wc1_t + (size_t)l * 256 * CMP_K, CMP_ROWS, 256, CMP_K}; pg8::StaticOrder S; S.init(CMP_ROWS, 256, 64, blk);
                pg8::EpiBf16<1> E{HID, 256};
                pg8::gemm_phase<pg8::EpiBf16<1>, pg8::StaticOrder, true, true>(lds + RING_OFF, g, S, E);
            }
        }
        if (IN(11)) {
            {
                LAS float* sq = (LAS float*)(lds + RING_OFF); LAS float* sk = sq + 64 * 65; LAS float* sv = sk + 64 * 65; LAS float* sw = sv + 64 * 65;
                LAS float* sa = sw + 64 * 65; LAS float* sS = sa + 4096; LAS float* sgam = sS + 4096; LAS float* sbeta = sgam + 64; LAS float* sg = sbeta + 64;
                const float* cw = args.in[I_DNCONV] + (size_t)l * 4 * 1152; const float* nrmw = args.in[I_DNNORM] + (size_t)l * 64;
                for (int u = blk; u < BATCH * 6; u += G) {
                    const int b = u / 6, h = u % 6;
                    const float Aexp = __expf(args.in[I_DNALOG][l * 6 + h]), dtb = args.in[I_DNDT][l * 6 + h];
                    __syncthreads();
                    for (int e = tid; e < 4096; e += NTHR) sS[e] = 0.f;
                    for (int n = 0; n < 32; ++n) {
                        __syncthreads();
                        for (int e = tid; e < 3 * 4096; e += NTHR) { const int which = e >> 12, r = e & 4095, i = r >> 6, d = r & 63, col = which * 384 + h * 64 + d, t = 64 * n + i; float acc = 0.f;
#pragma unroll
                            for (int j = 0; j < 4; ++j) { const int tt = t - 3 + j; if (tt >= 0) acc += cw[j * 1152 + col] * bf2f(PROJ[((size_t)b * SEQ + tt) * NINP + col]); }
                            (which == 0 ? sq : (which == 1 ? sk : sv))[i * 65 + d] = silu_f(acc); }
                        if (tid < 64) { const bf16* pr = PROJ + ((size_t)b * SEQ + 64 * n + tid) * NINP; sbeta[tid] = sigmoid_f(bf2f(pr[PC_B + h]));
                            const float z = bf2f(pr[PC_A + h]) + dtb; const float sp = z > 20.f ? z : log1pf(__expf(z)); sg[tid] = -Aexp * sp; }
                        __syncthreads();
                        for (int rr = wave; rr < 128; rr += NWAVES) { LAS float* buf = rr < 64 ? sq : sk; const int i = rr & 63; float v = buf[i * 65 + lane];
                            const float ss = wave_sum(v * v); v *= rsqrtf(ss + EPS) * (rr < 64 ? 0.125f : 1.0f); buf[i * 65 + lane] = v; }
                        if (tid == 0) { float acc = 0.f; for (int i = 0; i < 64; ++i) { acc += sg[i]; sgam[i] = acc; } }
                        __syncthreads();
                        for (int e = tid; e < 4096; e += NTHR) { const int i = e >> 6, j = e & 63; float val = 0.f;
                            if (i > j) { float dot = 0.f;
#pragma unroll 8
                                for (int d = 0; d < 64; ++d) dot += sk[i * 65 + d] * sk[j * 65 + d];
                                val = dot * sbeta[i] * __expf(sgam[i] - sgam[j]); }
                            sa[e] = val; }
                        __syncthreads();
                        for (int e = tid; e < 4096; e += NTHR) { const int i = e >> 6, d = e & 63; const float bi = sbeta[i]; sv[i * 65 + d] *= bi; sw[i * 65 + d] = sk[i * 65 + d] * bi * __expf(sgam[i]); }
                        __syncthreads();
                        if (tid < 128) { LAS float* buf = tid < 64 ? sv : sw; const int c = tid & 63;
                            for (int i = 1; i < 64; ++i) { float acc = buf[i * 65 + c]; for (int j = 0; j < i; ++j) acc -= sa[i * 64 + j] * buf[j * 65 + c]; buf[i * 65 + c] = acc; } }
                        __syncthreads();
                        for (int e = tid; e < 4096; e += NTHR) { const int i = e >> 6, j = e & 63; float val = 0.f;
                            if (i >= j) { float dot = 0.f;
#pragma unroll 8
                                for (int d = 0; d < 64; ++d) dot += sq[i * 65 + d] * sk[j * 65 + d];
                                val = dot * __expf(sgam[i] - sgam[j]); }
                            sa[e] = val; }
                        for (int e = tid; e < 4096; e += NTHR) { const int i = e >> 6, c = e & 63; float acc = 0.f;
#pragma unroll 8
                            for (int k = 0; k < 64; ++k) acc += sw[i * 65 + k] * sS[k * 64 + c];
                            sv[i * 65 + c] -= acc; }
                        __syncthreads();
                        for (int it8 = 0; it8 < 8; ++it8) { const int i = it8 * 8 + wave, c = lane; float a1 = 0.f, a2 = 0.f;
#pragma unroll 8
                            for (int k = 0; k < 64; ++k) { a1 += sq[i * 65 + k] * sS[k * 64 + c]; a2 += sa[i * 64 + k] * sv[k * 65 + c]; }
                            const float o = a1 * __expf(sgam[i]) + a2; const float ms = wave_sum(o * o) * (1.f / 64.f);
                            const size_t tok = (size_t)b * SEQ + 64 * n + i; const float z = bf2f(PROJ[tok * NINP + PC_Z + h * 64 + c]);
                            MIX[tok * DM + h * 64 + c] = f2bf(o * rsqrtf(ms + EPS) * nrmw[c] * silu_f(z)); }
                        __syncthreads();
                        { const float glast = sgam[63], gt = __expf(glast);
                            for (int e = tid; e < 4096; e += NTHR) { const int k = e >> 6, c = e & 63; float acc = 0.f;
#pragma unroll 8
                                for (int i = 0; i < 64; ++i) acc += sk[i * 65 + k] * __expf(glast - sgam[i]) * sv[i * 65 + c];
                                sS[e] = sS[e] * gt + acc; } }
                    }
                }
            }
            GRID_BAR();
        }
        if (IN(4)) {
            const float* kw2 = args.in[I_KW2] + (size_t)l * 128 * 64; const float* vw2 = args.in[I_VW2] + (size_t)l * 128 * 64;
            for (int row = gw; row < CMP_ROWS; row += NGW) {
                const int i = row & 127, g = (row >> 7) & 1, b = (row >> 8) & 31, kv = row >> 13;
                const float* w2 = kv ? vw2 : kw2; const bf16* hr = HID + (size_t)row * 256 + kv * 128; float acc = 0.f;
                if (i < 127) {
#pragma unroll 8
                    for (int n = 0; n < 128; ++n) acc += bf2f(hr[n]) * w2[n * 64 + lane]; }
                if (kv == 0) KC[((size_t)(b * 2 + g) * 128 + i) * 64 + lane] = f2bf(acc);
                else { const int gI = i >> 5, kk = i & 31, pos = 32 * gI + (kk < 16 ? 8 * (kk >> 2) + (kk & 3) : 8 * ((kk - 16) >> 2) + 4 + (kk & 3));
                    VCT[((size_t)(b * 2 + g) * 64 + lane) * 128 + pos] = f2bf(acc); }
            }
            GRID_BAR();
        }
        if (IN(5)) {
            NsaPtrs P{PROJ, KC, VCT, KS, VST, KW, VWT, MIX};
            for (int u = blk; u < 1024; u += G) {
                const int hi4 = u >> 8, lo8 = u & 255, b = lo8 >> 3, g = (lo8 >> 2) & 1, q4 = lo8 & 3;
                const int q8 = hi4 == 0 ? q4 : (hi4 == 1 ? 15 - q4 : (hi4 == 2 ? 4 + q4 : 11 - q4));
                nsa_item(P, (LAS f32x4*)(lds + RING_OFF + wave * 16384), b, g, (q8 * 8 + wave) * 16, lane);
            }
            GRID_BAR();
        }
        if (IN(6)) {
            pg8::Gemm g{MIX, Wout_t + (size_t)l * DM * DM, MTOK, DM, DM}; pg8::StaticOrder S; S.init(MTOK, DM, G, blk);
            pg8::EpiBf16<0> E{MBUF, DM};
            pg8::gemm_phase<pg8::EpiBf16<0>, pg8::StaticOrder, true, true>(lds + RING_OFF, g, S, E);
            GRID_BAR();
        }
        if (IN(7)) {
            const float* wp = args.in[I_NORMW] + ((size_t)l * 4 + 1) * DM; const float* xs = (l == 0) ? x_in : xres;
            for (int m = gw; m < MTOK; m += NGW) resid_row(xs + (size_t)m * DM, MBUF + (size_t)m * DM, wp, xres + (size_t)m * DM, XB + (size_t)m * DM, lane);
            GRID_BAR();
        }
        if (IN(8)) {
            pg8::Gemm g{XB, Wgu_t + (size_t)l * NGU * DM, MTOK, NGU, DM}; pg8::StaticOrder S; S.init(MTOK, NGU, G, blk);
            pg8::EpiSwiGLU E{HFF, DFF};
            pg8::gemm_phase<pg8::EpiSwiGLU, pg8::StaticOrder, true, true>(lds + RING_OFF, g, S, E);
            GRID_BAR();
        }
        if (IN(9)) {
            pg8::Gemm g{HFF, Wd_t + (size_t)l * DM * DFF, MTOK, DM, DFF}; pg8::StaticOrder S; S.init(MTOK, DM, G, blk);
            pg8::EpiBf16<0> E{MBUF, DM};
            pg8::gemm_phase<pg8::EpiBf16<0>, pg8::StaticOrder, true, true>(lds + RING_OFF, g, S, E);
            GRID_BAR();
        }
        if (IN(10)) {
            const float* wp = args.in[I_NORMW] + ((size_t)l * 4 + 3) * DM;
            for (int m = gw; m < MTOK; m += NGW) resid_row(xres + (size_t)m * DM, MBUF + (size_t)m * DM, wp, xres + (size_t)m * DM, XB + (size_t)m * DM, lane);
            if (l + 1 < args.l_hi) GRID_BAR();
        }
    }
#undef IN
}

template <unsigned PHM> static int setup_kernel() {
    if (hipFuncSetAttribute((const void*)fwd<PHM>, hipFuncAttributeMaxDynamicSharedMemorySize, LDS_BYTES) != hipSuccess) { fprintf(stderr, "kernel_launch: hipFuncSetAttribute failed (mask %x)\n", PHM); return -1; }
    int per_cu = 0;
    if (hipOccupancyMaxActiveBlocksPerMultiprocessor(&per_cu, (const void*)fwd<PHM>, NTHR, LDS_BYTES) != hipSuccess || per_cu < 1) fprintf(stderr, "kernel_launch: occupancy query reports %d (mask %x)\n", per_cu, PHM);
    (void)hipGetLastError();
    return 0;
}
template <unsigned PHM> static void launch_ph(int grid, hipStream_t stream, const Args& a) { hipLaunchKernelGGL(fwd<PHM>, dim3(grid), dim3(NTHR), LDS_BYTES, stream, a); }
constexpr unsigned PH_ALL = 0xfffu;
extern "C" void kernel_launch(void* const* d_in, const int* in_sizes, int n_in, void* d_out, int out_size, void* d_ws, size_t ws_size, hipStream_t stream) {
    static int grid = 0;
    if (grid == 0) {
        if (n_in != 21 || in_sizes[0] != MTOK * DM || out_size != MTOK * DM || ws_size < WS_END) { fprintf(stderr, "kernel_launch: unexpected shapes (n_in %d, in0 %d, out %d, ws %zu); nothing launched\n", n_in, n_in > 0 ? in_sizes[0] : -1, out_size, ws_size); grid = -1; return; }
        int dev = 0, cus = 0;
        if (hipGetDevice(&dev) != hipSuccess || hipDeviceGetAttribute(&cus, hipDeviceAttributeMultiprocessorCount, dev) != hipSuccess) { grid = -1; return; }
        int rc = 0;
#if MK_ONE_LAUNCH
        rc |= setup_kernel<PH_ALL>();
#else
        rc |= setup_kernel<1u << 0>(); rc |= setup_kernel<1u << 1>(); rc |= setup_kernel<1u << 2>(); rc |= setup_kernel<1u << 3>(); rc |= setup_kernel<1u << 4>(); rc |= setup_kernel<1u << 5>();
        rc |= setup_kernel<1u << 6>(); rc |= setup_kernel<1u << 7>(); rc |= setup_kernel<1u << 8>(); rc |= setup_kernel<1u << 9>(); rc |= setup_kernel<1u << 10>(); rc |= setup_kernel<1u << 11>();
#endif
        if (rc) { grid = -1; return; }
        grid = cus;
        if (grid < 128) { fprintf(stderr, "kernel_launch: needs >= 128 CUs\n"); grid = -1; return; }
    }
    if (grid < 0) return;
    if (hipMemsetAsync((char*)d_ws + WS_CTL, 0, CTL_ZERO_BYTES, stream) != hipSuccess) return;
    Args a{};
    for (int i = 0; i < 21; ++i) a.in[i] = (const float*)d_in[i];
    a.out = (float*)d_out; a.ws = (unsigned char*)d_ws;
#if MK_ONE_LAUNCH
    a.pre = 1; a.ph_lo = 1; a.ph_hi = 12; a.l_lo = 0; a.l_hi = DEPTH;
    launch_ph<PH_ALL>(grid, stream, a);
#else
    a.pre = 1; a.ph_lo = 0; a.ph_hi = 0; a.l_lo = 0; a.l_hi = 0;
    launch_ph<1u << 0>(grid, stream, a);
    for (int l = 0; l < DEPTH; ++l) {
        a.pre = 0; a.l_lo = l; a.l_hi = l + 1;
#define LP(p) do { a.ph_lo = (p); a.ph_hi = (p) + 1; launch_ph<1u << (p)>(grid, stream, a); } while (0)
        LP(1); LP(2); LP(3); LP(11); LP(4); LP(5); LP(6); LP(7); LP(8); LP(9); LP(10);
#undef LP
    }
#endif
}
```

```cpp
#include <hip/hip_runtime.h>
#include <cstdio>
#include <cstdint>

#ifndef PROBE_PH
#define PROBE_PH 0
#define PROBE_N 1
#endif
#define REP(k) for (int rep_ = 0; rep_ < ((k) == PROBE_PH ? PROBE_N : 1); ++rep_)
#ifndef MK_ONE_LAUNCH
#define MK_ONE_LAUNCH 1
#endif

namespace pg8 {
#define PG8_LAS __attribute__((address_space(3)))
typedef unsigned short bf16_t;
typedef short bf16x8 __attribute__((ext_vector_type(8)));
typedef float f32x4 __attribute__((ext_vector_type(4)));
typedef unsigned u32x4 __attribute__((ext_vector_type(4)));
constexpr int BM = 256, BK = 64, HALF = 128, HTB = HALF * BK * 2  , STAGE_BYTES = 8 * HTB, NXCD = 8, WGM = 8;

__host__ __device__ __forceinline__ int lds_byte(int r, int c) { const int st = (r >> 4) * 2 + (c >> 5), rr = r & 15, cc = c & 31, ob = rr * 64 + cc * 2; return st * 1024 + (ob ^ (((ob >> 9) & 1) << 5)); }
__host__ __device__ __forceinline__ void stage_rc(int b, int& R, int& C) { const int st = b / 1024, sb = b % 1024, swz = sb ^ (((sb >> 9) & 1) << 5); R = (st >> 1) * 16 + swz / 64; C = (st & 1) * 32 + (swz % 64) / 2; }
__host__ __device__ __forceinline__ int perm32(int rho) { const int n = rho >> 4, i = rho & 15; return 8 * (i >> 2) + 4 * n + (i & 3); }

struct Unit { int pm, pn; };
struct Gemm { const bf16_t* A; const bf16_t* Bt; int M, N, K; };

struct StaticOrder {
    int nM, nN, nwg, G, c;
    __host__ __device__ void init(int M, int N, int G_, int c_) { nM = M / BM; nN = N / BM; nwg = nM * nN; G = G_; c = c_; }
    __host__ __device__ bool next(int i, Unit& u) const {
        const long L = (long)i * G + c; if (L >= nwg) return false;
        int wgid = (int)L; { const int q = nwg / NXCD, r = nwg % NXCD, xcd = wgid % NXCD, off = wgid / NXCD; wgid = (xcd < r ? xcd * (q + 1) : r * (q + 1) + (xcd - r) * q) + off; }
        const int nig = WGM * nN, gid = wgid / nig, fm = gid * WGM, gsz = (nM - fm) < WGM ? (nM - fm) : WGM;
        u.pm = fm + ((wgid % nig) % gsz); u.pn = (wgid % nig) / gsz; return true;
    }
    __device__ __forceinline__ void a_ready(const Unit&) const {}
    __device__ __forceinline__ void done(const Unit&) const {}
};

__device__ __forceinline__ unsigned cvt_pk_bf16(float lo, float hi) { unsigned r; asm volatile("v_cvt_pk_bf16_f32 %0, %1, %2" : "=v"(r) : "v"(lo), "v"(hi)); return r; }
typedef float f32x2 __attribute__((ext_vector_type(2)));
__device__ __forceinline__ float silu_f(float v) { return v / (1.0f + __expf(-v)); }
template <int ACT> struct EpiBf16 {
    static constexpr bool PERM = true, AFTER_DRAIN = false;
    bf16_t* O; int ldc; const float* rs;
    __device__ __forceinline__ void operator()(const f32x4 (&acc)[2][2][4][2], const Unit& u, int wr, int wc, int fr, int fq) const {
        const int row0 = u.pm * BM + wr * 64 + fr; const int col0 = u.pn * BM + wc * 32 + 8 * fq;
#pragma unroll
        for (int ai = 0; ai < 2; ++ai)
#pragma unroll
            for (int m = 0; m < 4; ++m) { bf16_t* rowp = O + (size_t)(row0 + ai * HALF + m * 16) * ldc + col0; const float sc = rs ? rs[row0 + ai * HALF + m * 16] : 1.0f;
#pragma unroll
                for (int bj = 0; bj < 2; ++bj) { f32x4 v0 = acc[ai][bj][m][0] * sc, v1 = acc[ai][bj][m][1] * sc;
                    if (ACT == 1) {
#pragma unroll
                        for (int j = 0; j < 4; ++j) { v0[j] = silu_f(v0[j]); v1[j] = silu_f(v1[j]); } }
                    u32x4 w; w.x = cvt_pk_bf16(v0[0], v0[1]); w.y = cvt_pk_bf16(v0[2], v0[3]); w.z = cvt_pk_bf16(v1[0], v1[1]); w.w = cvt_pk_bf16(v1[2], v1[3]);
                    *(u32x4*)(rowp + bj * HALF) = w; } }
    }
};
struct EpiSwiGLU {
    static constexpr bool PERM = true, AFTER_DRAIN = false;
    bf16_t* O; int ldc; const float* rs;
    __device__ __forceinline__ void operator()(const f32x4 (&acc)[2][2][4][2], const Unit& u, int wr, int wc, int fr, int fq) const {
        const int row0 = u.pm * BM + wr * 64 + fr; const int col0 = u.pn * HALF + wc * 32 + 8 * fq;
#pragma unroll
        for (int ai = 0; ai < 2; ++ai)
#pragma unroll
            for (int m = 0; m < 4; ++m) { bf16_t* rowp = O + (size_t)(row0 + ai * HALF + m * 16) * ldc + col0; const float sc = rs[row0 + ai * HALF + m * 16];
                f32x4 g0 = acc[ai][0][m][0] * sc, g1 = acc[ai][0][m][1] * sc; const f32x4 u0 = acc[ai][1][m][0] * sc, u1 = acc[ai][1][m][1] * sc;
#pragma unroll
                for (int j = 0; j < 4; ++j) { g0[j] = silu_f(g0[j]) * u0[j]; g1[j] = silu_f(g1[j]) * u1[j]; }
                u32x4 w; w.x = cvt_pk_bf16(g0[0], g0[1]); w.y = cvt_pk_bf16(g0[2], g0[3]); w.z = cvt_pk_bf16(g1[0], g1[1]); w.w = cvt_pk_bf16(g1[2], g1[3]);
                *(u32x4*)rowp = w; }
    }
};

template <class Epi, class Sched, bool ALIGN_EPI = false, bool SP2 = false>
__device__ __forceinline__ void gemm_phase(PG8_LAS unsigned char* lds, const Gemm g, const Sched& S, const Epi& E) {
    int tid = threadIdx.x; asm volatile("" : "+v"(tid));
    const int wid = __builtin_amdgcn_readfirstlane(tid >> 6), lane = tid & 63, wr = wid >> 2, wc = wid & 3, fr = lane & 15, fq = lane >> 4;
    const int K = g.K, nt = K / BK;
    unsigned voffA[2], voffB[2];
#pragma unroll
    for (int i = 0; i < 2; ++i) { int R, C; stage_rc(tid * 16 + i * 8192, R, C); const int Rb = Epi::PERM ? ((R & ~31) + perm32(R & 31)) : R;
        voffA[i] = (unsigned)(R * K + C) * 2u; voffB[i] = (unsigned)(Rb * K + C) * 2u; }
    const size_t kstep = (size_t)(BK * 2);
    const size_t hstep = (size_t)HALF * K * 2;
    const size_t tstep = 2 * hstep;
    const unsigned ldsw = (unsigned)wid * 1024u;
    const int aoff = lds_byte(wr * 64 + fr, fq * 8), boff = lds_byte(wc * 32 + fr, fq * 8);
#define PG8_SA(b, h) (((b) * 2 + (h)) * HTB)
#define PG8_SB(b, h) ((4 + (b) * 2 + (h)) * HTB)
#define PG8_STAGE(bufoff, gbase, voff) do { _Pragma("unroll") for (int _i = 0; _i < 2; ++_i) \
        __builtin_amdgcn_global_load_lds((const unsigned*)((const char*)(gbase) + (voff)[_i]), (PG8_LAS unsigned*)(lds + (bufoff) + ldsw + _i * 8192), 16, 0, 0); } while (0)
#define PG8_LDA(dst, b, h) do { _Pragma("unroll") for (int m = 0; m < 4; ++m) _Pragma("unroll") for (int k = 0; k < 2; ++k) dst[m][k] = *(const PG8_LAS bf16x8*)(lds + PG8_SA(b, h) + aoff + m * 2048 + k * 1024); } while (0)
#define PG8_LDB(dst, b, h) do { _Pragma("unroll") for (int n = 0; n < 2; ++n) _Pragma("unroll") for (int k = 0; k < 2; ++k) dst[n][k] = *(const PG8_LAS bf16x8*)(lds + PG8_SB(b, h) + boff + n * 2048 + k * 1024); } while (0)
#define PG8_MMA(ai, bj, At, Bt) do { __builtin_amdgcn_s_setprio(1); _Pragma("unroll") for (int m = 0; m < 4; ++m) _Pragma("unroll") for (int n = 0; n < 2; ++n) _Pragma("unroll") for (int k = 0; k < 2; ++k) \
        acc[ai][bj][m][n] = __builtin_amdgcn_mfma_f32_16x16x32_bf16(Bt[n][k], At[m][k], acc[ai][bj][m][n], 0, 0, 0); __builtin_amdgcn_s_setprio(0); } while (0)
#define PG8_WAIT_V(n) asm volatile("s_waitcnt vmcnt(" #n ")" ::: "memory")
#define PG8_WAIT_L(n) asm volatile("s_waitcnt lgkmcnt(" #n ")" ::: "memory")
#define PG8_BAR __builtin_amdgcn_s_barrier()
#define PG8_SCHED __builtin_amdgcn_sched_barrier(0)
    Unit cur, nxt; int ui = 0;
    if (!S.next(0, cur)) return;
    f32x4 acc[2][2][4][2];
#pragma unroll
    for (int a = 0; a < 2; ++a)
#pragma unroll
        for (int b = 0; b < 2; ++b)
#pragma unroll
            for (int m = 0; m < 4; ++m)
#pragma unroll
                for (int n = 0; n < 2; ++n) acc[a][b][m][n] = (f32x4){0.f, 0.f, 0.f, 0.f};
    bf16x8 At[4][2], B0[2][2], B1[2][2];
    const char* cA = (const char*)g.A + (size_t)cur.pm * tstep; const char* cB = (const char*)g.Bt + (size_t)cur.pn * tstep;
    S.a_ready(cur);
    if constexpr (SP2) {
        PG8_STAGE(PG8_SB(0, 0), cB, voffB); PG8_STAGE(PG8_SB(0, 1), cB + hstep, voffB); PG8_STAGE(PG8_SA(0, 0), cA, voffA); PG8_STAGE(PG8_SA(0, 1), cA + hstep, voffA);
        if (wr == 1) PG8_BAR;
        PG8_WAIT_V(2); PG8_BAR;
        PG8_STAGE(PG8_SB(1, 0), cB + kstep, voffB); PG8_STAGE(PG8_SA(1, 0), cA + kstep, voffA); PG8_STAGE(PG8_SB(1, 1), cB + hstep + kstep, voffB);
        PG8_WAIT_V(6); PG8_BAR;
    } else {
        PG8_STAGE(PG8_SB(0, 0), cB, voffB); PG8_STAGE(PG8_SA(0, 0), cA, voffA); PG8_STAGE(PG8_SB(0, 1), cB + hstep, voffB); PG8_STAGE(PG8_SA(0, 1), cA + hstep, voffA);
        if (wr == 1) PG8_BAR;
        PG8_WAIT_V(4); PG8_BAR;
        PG8_STAGE(PG8_SB(1, 0), cB + kstep, voffB); PG8_STAGE(PG8_SA(1, 0), cA + kstep, voffA); PG8_STAGE(PG8_SB(1, 1), cB + hstep + kstep, voffB);
        PG8_WAIT_V(6); PG8_BAR;
    }
    for (;;) {
        const bool has_next = S.next(ui + 1, nxt);
        const char* nA = has_next ? (const char*)g.A + (size_t)nxt.pm * tstep : cA; const char* nB = has_next ? (const char*)g.Bt + (size_t)nxt.pn * tstep : cB;
        for (int t = 0; t < nt; t += 2) {
            const bool last = (t == nt - 2);
            const char* a1 = cA + (size_t)(t + 1) * kstep;
            const char* a2 = last ? nA : cA + (size_t)(t + 2) * kstep; const char* b2 = last ? nB : cB + (size_t)(t + 2) * kstep;
            const char* a3 = a2 + kstep; const char* b3 = b2 + kstep;
            if (last && has_next) S.a_ready(nxt);
            if constexpr (SP2) {
            PG8_LDB(B0, 0, 0); PG8_LDB(B1, 0, 1); PG8_SCHED; PG8_LDA(At, 0, 0); PG8_STAGE(PG8_SA(1, 1), a1 + hstep, voffA);
            PG8_WAIT_V(8); PG8_WAIT_L(0); PG8_BAR; PG8_MMA(0, 0, At, B0); PG8_MMA(0, 1, At, B1); PG8_BAR; PG8_SCHED;
            PG8_LDA(At, 0, 1); PG8_STAGE(PG8_SB(0, 0), b2, voffB); PG8_STAGE(PG8_SB(0, 1), b2 + hstep, voffB); PG8_STAGE(PG8_SA(0, 0), a2, voffA);
            PG8_WAIT_V(8); PG8_WAIT_L(0); PG8_BAR; PG8_MMA(1, 0, At, B0); PG8_MMA(1, 1, At, B1); PG8_BAR; PG8_SCHED;
            PG8_LDB(B0, 1, 0); PG8_LDB(B1, 1, 1); PG8_SCHED; PG8_LDA(At, 1, 0); PG8_STAGE(PG8_SA(0, 1), a2 + hstep, voffA);
            PG8_WAIT_V(8); PG8_WAIT_L(0); PG8_BAR; PG8_MMA(0, 0, At, B0); PG8_MMA(0, 1, At, B1); PG8_BAR; PG8_SCHED;
            PG8_LDA(At, 1, 1); PG8_STAGE(PG8_SB(1, 0), b3, voffB); PG8_STAGE(PG8_SB(1, 1), b3 + hstep, voffB); PG8_STAGE(PG8_SA(1, 0), a3, voffA);
            PG8_WAIT_V(8); PG8_WAIT_L(0); PG8_BAR; PG8_MMA(1, 0, At, B0); PG8_MMA(1, 1, At, B1); PG8_BAR; PG8_SCHED;
            } else {
            PG8_LDB(B0, 0, 0); PG8_SCHED; PG8_LDA(At, 0, 0); PG8_STAGE(PG8_SA(1, 1), a1 + hstep, voffA);
            PG8_WAIT_L(8); PG8_BAR; PG8_WAIT_L(0); PG8_MMA(0, 0, At, B0); PG8_BAR; PG8_SCHED;
            PG8_LDB(B1, 0, 1); PG8_STAGE(PG8_SB(0, 0), b2, voffB);
            PG8_BAR; PG8_WAIT_L(0); PG8_MMA(0, 1, At, B1); PG8_BAR;
            PG8_LDA(At, 0, 1); PG8_STAGE(PG8_SA(0, 0), a2, voffA);
            PG8_BAR; PG8_WAIT_L(0); PG8_MMA(1, 0, At, B0); PG8_BAR; PG8_SCHED;
            PG8_STAGE(PG8_SB(0, 1), b2 + hstep, voffB);
            PG8_WAIT_V(6); PG8_BAR; PG8_MMA(1, 1, At, B1); PG8_BAR;
            PG8_LDB(B0, 1, 0); PG8_SCHED; PG8_LDA(At, 1, 0); PG8_STAGE(PG8_SA(0, 1), a2 + hstep, voffA);
            PG8_WAIT_L(8); PG8_BAR; PG8_WAIT_L(0); PG8_MMA(0, 0, At, B0); PG8_BAR; PG8_SCHED;
            PG8_LDB(B1, 1, 1); PG8_STAGE(PG8_SB(1, 0), b3, voffB);
            PG8_BAR; PG8_WAIT_L(0); PG8_MMA(0, 1, At, B1); PG8_BAR;
            PG8_LDA(At, 1, 1); PG8_STAGE(PG8_SA(1, 0), a3, voffA);
            PG8_BAR; PG8_WAIT_L(0); PG8_MMA(1, 0, At, B0); PG8_BAR; PG8_SCHED;
            PG8_STAGE(PG8_SB(1, 1), b3 + hstep, voffB);
            PG8_WAIT_V(6); PG8_BAR; PG8_MMA(1, 1, At, B1); PG8_BAR;
            }
        }
        if constexpr (ALIGN_EPI) { if (wr == 0) PG8_BAR; }
        if constexpr (!Epi::AFTER_DRAIN) { E(acc, cur, wr, wc, fr, fq); S.done(cur); }
        if (!has_next) break;
#pragma unroll
        for (int a = 0; a < 2; ++a)
#pragma unroll
            for (int b = 0; b < 2; ++b)
#pragma unroll
                for (int m = 0; m < 4; ++m)
#pragma unroll
                    for (int n = 0; n < 2; ++n) acc[a][b][m][n] = (f32x4){0.f, 0.f, 0.f, 0.f};
        cur = nxt; cA = nA; cB = nB; ++ui;
        if constexpr (ALIGN_EPI) { if (wr == 1) PG8_BAR; }
    }
    PG8_WAIT_V(0);
    if constexpr (!ALIGN_EPI) { if (wr == 0) PG8_BAR; }
    PG8_BAR;
    if constexpr (Epi::AFTER_DRAIN) { E.fused(acc, cur, wr, wc, fr, fq, lds, wid, lane); S.done(cur); }
#undef PG8_SA
#undef PG8_SB
#undef PG8_STAGE
#undef PG8_LDA
#undef PG8_LDB
#undef PG8_MMA
#undef PG8_WAIT_V
#undef PG8_WAIT_L
#undef PG8_BAR
#undef PG8_SCHED
}
}

constexpr int NWAVES = 8, NTHR = 512;
constexpr int BATCH = 32, SEQ = 2048, DM = 1024, DEPTH = 2, MTOK = BATCH * SEQ;
constexpr int NIN = 3230, NINP = 3328, DFF = 2816, NGU = 2 * DFF;
constexpr int PC_QKV = 0, PC_Z = 1152, PC_CF = 1536, PC_NQ = 2048, PC_KC = 2432, PC_VC = 2560, PC_KS = 2688, PC_VS = 2816, PC_KW = 2944, PC_VW = 3072, PC_B = 3200, PC_A = 3206, PC_GATE = 3212;
constexpr float EPS = 1e-6f;
constexpr int CMP_ROWS = 16384, CMP_K = 2048;
constexpr int NPH = 10;

constexpr size_t MiB = 1u << 20;
constexpr size_t WS_CTL = 0, CTL_ZERO_BYTES = 1 * MiB;
constexpr size_t WS_WIN = 2 * MiB;
constexpr size_t WS_WOUT = 16 * MiB;
constexpr size_t WS_WGU = 20 * MiB;
constexpr size_t WS_WD = 42 * MiB;
constexpr size_t WS_WC1 = 53 * MiB;
constexpr size_t WS_W2T = 55 * MiB;
constexpr size_t WS_KC = 56 * MiB;
constexpr size_t WS_VCT = 57 * MiB;
constexpr size_t WS_PROJ = 64 * MiB;
constexpr size_t WS_MIX = 480 * MiB;
constexpr size_t WS_MBUF = 608 * MiB;
constexpr size_t WS_XB = 736 * MiB;
constexpr size_t WS_ACMP = 864 * MiB;
constexpr size_t WS_HID = 928 * MiB;
constexpr size_t WS_KS = 936 * MiB, WS_KW = 952 * MiB, WS_VST = 968 * MiB, WS_VWT = 984 * MiB;
constexpr size_t WS_DNF = WS_MBUF;
constexpr size_t WS_GT = 1000 * MiB;
constexpr size_t WS_RSTD = 1001 * MiB;
constexpr size_t WS_END = 1002 * MiB;
constexpr int CW_TMO = 0, CW_BAR = 4096;

constexpr int RING_OFF = 0, RING_BYTES = 131072, XTRA_OFF = 147456;
constexpr int LDSCTL_OFF = RING_BYTES, MISC_OFF = LDSCTL_OFF + 320;
constexpr int LDS_BYTES = 163840;

#define GAS __attribute__((address_space(1)))
#define LAS __attribute__((address_space(3)))
typedef unsigned short bf16;
typedef unsigned v4u __attribute__((ext_vector_type(4)));
typedef unsigned v2u __attribute__((ext_vector_type(2)));
typedef float f32x4 __attribute__((ext_vector_type(4)));
typedef float f32x2 __attribute__((ext_vector_type(2)));
typedef short bf16x8 __attribute__((ext_vector_type(8)));
struct Args;
typedef __bf16 bf16x2_t __attribute__((ext_vector_type(2)));
#define LDS_WAIT() asm volatile("s_waitcnt lgkmcnt(0)" ::: "memory")
#define VM_WAIT() asm volatile("s_waitcnt vmcnt(0)" ::: "memory")
__device__ __forceinline__ unsigned cvtpk(float lo, float hi) { f32x2 v = {lo, hi}; bf16x2_t b = __builtin_convertvector(v, bf16x2_t); return __builtin_bit_cast(unsigned, b); }
__device__ __forceinline__ bf16 f2bf(float f) { return (bf16)(cvtpk(f, 0.f) & 0xffffu); }
__device__ __forceinline__ float bf2f(bf16 v) { return __uint_as_float(((unsigned)v) << 16); }
__device__ __forceinline__ float bflo(unsigned w) { return __uint_as_float(w << 16); }
__device__ __forceinline__ float bfhi(unsigned w) { return __uint_as_float(w & 0xffff0000u); }
__device__ __forceinline__ float sigmoid_f(float v) { return __builtin_amdgcn_rcpf(1.0f + __builtin_amdgcn_exp2f(-1.4426950408889634f * v)); }
__device__ __forceinline__ float silu_f(float v) { return v * sigmoid_f(v); }
__device__ __forceinline__ float wave_sum(float v) {
#pragma unroll
    for (int o = 1; o < 64; o <<= 1) v += __shfl_xor(v, o);
    return v;
}

#define XB_TMO      128
#define XB_XCNT(j)  (256  + 64 * (j))
#define XB_XSUB(j)  (1280 + 64 * (j))
#define XB_XGEN(j)  (2304 + 64 * (j))
#define XB_TOP      3328
#define XB_TOPGEN   3392
#define XCD_BAR_WORDS 3456
#define XB_SPIN_CAP (1u << 18)
__device__ __forceinline__ unsigned xb_ld(unsigned* p)              { return __hip_atomic_load(p, __ATOMIC_RELAXED, __HIP_MEMORY_SCOPE_AGENT); }
__device__ __forceinline__ unsigned xb_add(unsigned* p, unsigned v) { return __hip_atomic_fetch_add(p, v, __ATOMIC_RELAXED, __HIP_MEMORY_SCOPE_AGENT); }
__device__ __forceinline__ unsigned xb_xcc_id() { return (unsigned)__builtin_amdgcn_s_getreg((3 << 11) | 20) & 0xFu; }
#define XB_SPIN(cond, bar) do { unsigned _sp = 0; while (cond) { __builtin_amdgcn_s_sleep(1); \
    if ((++_sp & 255u) == 0u) { if (xb_ld(&(bar)[XB_TMO])) break; if (_sp > XB_SPIN_CAP) { atomicAdd(&(bar)[XB_TMO], 1u); break; } } } } while (0)
struct XcdBarrier { unsigned* bar; unsigned x; volatile LAS unsigned* st; };
__device__ __forceinline__ XcdBarrier xcd_barrier_post(unsigned* bar, volatile LAS unsigned* st) {
    XcdBarrier b; b.bar = bar; b.x = xb_xcc_id(); b.st = st;
    if (threadIdx.x == 0) (void)xb_add(&bar[XB_XCNT(b.x)], 1u);
    return b;
}
__device__ __forceinline__ void xcd_barrier_complete(unsigned* bar, unsigned x, unsigned& nloc, unsigned& nx) {
    const unsigned G = gridDim.x * gridDim.y * gridDim.z;
    unsigned sum, cnt, mine, sp = 0u;
    for (;;) {
        sum = 0u; cnt = 0u; mine = 0u;
#pragma unroll
        for (unsigned j = 0; j < 16; ++j) { const unsigned c = xb_ld(&bar[XB_XCNT(j)]); sum += c; cnt += (c > 0u) ? 1u : 0u; mine = (j == x) ? c : mine; }
        if (sum == G) break;
        __builtin_amdgcn_s_sleep(1);
        if ((++sp & 255u) == 0u) { if (xb_ld(&bar[XB_TMO])) break; if (sp > XB_SPIN_CAP) { atomicAdd(&bar[XB_TMO], 1u); break; } }
    }
    nloc = mine > 0u ? mine : 1u; nx = cnt > 0u ? cnt : 1u;
}
__device__ __forceinline__ void xcd_barrier(const XcdBarrier& b) {
    asm volatile("s_waitcnt vmcnt(0)" ::: "memory");
    __syncthreads();
    if (threadIdx.x == 0) {
        unsigned* bar = b.bar;
        __builtin_amdgcn_s_waitcnt(0);
        unsigned nloc = b.st[0], nx = b.st[1];
        if (nloc == 0u) { xcd_barrier_complete(bar, b.x, nloc, nx); b.st[0] = nloc; b.st[1] = nx; }
        const unsigned old = xb_add(&bar[XB_XSUB(b.x)], 1u);
        const unsigned gen = old / nloc;
        if (old + 1u == (gen + 1u) * nloc) {
            __builtin_amdgcn_fence(__ATOMIC_RELEASE, "agent");
            asm volatile("s_waitcnt vmcnt(0)" ::: "memory");
            const unsigned og = xb_add(&bar[XB_TOP], 1u);
            const unsigned tg = og / nx;
            if (og + 1u == (tg + 1u) * nx) xb_add(&bar[XB_TOPGEN], 1u);
            else XB_SPIN(xb_ld(&bar[XB_TOPGEN]) == tg, bar);
            __builtin_amdgcn_fence(__ATOMIC_ACQUIRE, "agent");
            xb_add(&bar[XB_XGEN(b.x)], 1u);
            asm volatile("s_waitcnt vmcnt(0)" ::: "memory");
        } else {
            XB_SPIN(xb_ld(&bar[XB_XGEN(b.x)]) == gen, bar);
            __builtin_amdgcn_fence(__ATOMIC_ACQUIRE, "agent");
            asm volatile("s_waitcnt vmcnt(0)" ::: "memory");
        }
    }
    __syncthreads();
}

template <class SrcFn>
__device__ __forceinline__ void wprep_item(const SrcFn& src, int K, bf16* WT, LAS float* scr, int item, int nblk, int lane) {
    const int kb = item / nblk, nb = item % nblk, k0 = 64 * kb, n0 = 32 * nb;
#pragma unroll 8
    for (int i = 0; i < 32; ++i) { const int kk = 2 * i + (lane >> 5); scr[kk * 33 + (lane & 31)] = src(k0 + kk, n0 + (lane & 31)); }
    LDS_WAIT(); asm volatile("" ::: "memory");
    const int c = lane & 7;
#pragma unroll
    for (int j = 0; j < 4; ++j) { const int n = (lane >> 3) + 8 * j; const LAS float* s = scr + (8 * c) * 33 + n;
        v4u o; o.x = cvtpk(s[0 * 33], s[1 * 33]); o.y = cvtpk(s[2 * 33], s[3 * 33]); o.z = cvtpk(s[4 * 33], s[5 * 33]); o.w = cvtpk(s[6 * 33], s[7 * 33]);
        *(v4u*)(WT + (size_t)(n0 + n) * K + k0 + 8 * c) = o; }
    LDS_WAIT(); asm volatile("" ::: "memory");
}
__device__ __forceinline__ int win_src_col(int n) {
    return n < 1536 ? n : (n < 3200 ? n + 12 : (n < 3212 ? n - 3200 + 1536 : (n < NIN ? n : -1)));
}
__device__ __forceinline__ void x_row_to_bf16(const float* xrow, bf16* orow, float* rstd, int lane) {
    const f32x4* xr = (const f32x4*)xrow + lane;
    f32x4 v[4]; float s = 0.f;
#pragma unroll
    for (int j = 0; j < 4; ++j) { v[j] = xr[64 * j]; s += (v[j].x * v[j].x + v[j].y * v[j].y) + (v[j].z * v[j].z + v[j].w * v[j].w); }
    const float r = rsqrtf(wave_sum(s) * (1.f / DM) + EPS);
    if (lane == 0) *rstd = r;
    v2u* o8 = (v2u*)orow + lane;
#pragma unroll
    for (int j = 0; j < 4; ++j) { v2u w; w.x = cvtpk(v[j].x, v[j].y); w.y = cvtpk(v[j].z, v[j].w); o8[64 * j] = w; }
}
template <bool XIN_F32, bool FINAL>
__device__ __forceinline__ void resid_row2(const void* xrowA, const void* xrowB, const bf16* mrowA, const bf16* mrowB, const float* wpost, void* orowA, void* orowB, float* rstdA, float* rstdB, int lane) {
    const f32x4* wr = (const f32x4*)wpost + lane;
    f32x4 xa[4], xb[4], ma[4], mb[4]; float sa = 0.f, sb = 0.f;
#pragma unroll
    for (int j = 0; j < 4; ++j) {
        if (XIN_F32) { xa[j] = ((const f32x4*)xrowA + lane)[64 * j]; xb[j] = ((const f32x4*)xrowB + lane)[64 * j]; }
        else { const v2u wa = ((const v2u*)xrowA + lane)[64 * j], wb = ((const v2u*)xrowB + lane)[64 * j];
            xa[j] = (f32x4){bflo(wa.x), bfhi(wa.x), bflo(wa.y), bfhi(wa.y)}; xb[j] = (f32x4){bflo(wb.x), bfhi(wb.x), bflo(wb.y), bfhi(wb.y)}; }
        const v2u wa = ((const v2u*)mrowA + lane)[64 * j], wb = ((const v2u*)mrowB + lane)[64 * j];
        ma[j] = (f32x4){bflo(wa.x), bfhi(wa.x), bflo(wa.y), bfhi(wa.y)}; mb[j] = (f32x4){bflo(wb.x), bfhi(wb.x), bflo(wb.y), bfhi(wb.y)};
        sa += (ma[j].x * ma[j].x + ma[j].y * ma[j].y) + (ma[j].z * ma[j].z + ma[j].w * ma[j].w); sb += (mb[j].x * mb[j].x + mb[j].y * mb[j].y) + (mb[j].z * mb[j].z + mb[j].w * mb[j].w); }
#pragma unroll
    for (int o = 1; o < 64; o <<= 1) { sa += __shfl_xor(sa, o); sb += __shfl_xor(sb, o); }
    const float ra = rsqrtf(sa * (1.f / DM) + EPS), rb = rsqrtf(sb * (1.f / DM) + EPS);
    float s2a = 0.f, s2b = 0.f;
#pragma unroll
    for (int j = 0; j < 4; ++j) { const f32x4 w = wr[64 * j]; xa[j] = xa[j] + ma[j] * ra * w; xb[j] = xb[j] + mb[j] * rb * w;
        s2a += (xa[j].x * xa[j].x + xa[j].y * xa[j].y) + (xa[j].z * xa[j].z + xa[j].w * xa[j].w); s2b += (xb[j].x * xb[j].x + xb[j].y * xb[j].y) + (xb[j].z * xb[j].z + xb[j].w * xb[j].w); }
    if (FINAL) { f32x4* oa = (f32x4*)orowA + lane; f32x4* ob = (f32x4*)orowB + lane;
#pragma unroll
        for (int j = 0; j < 4; ++j) { oa[64 * j] = xa[j]; ob[64 * j] = xb[j]; }
    } else {
#pragma unroll
        for (int o = 1; o < 64; o <<= 1) { s2a += __shfl_xor(s2a, o); s2b += __shfl_xor(s2b, o); }
        if (lane == 0) { *rstdA = rsqrtf(s2a * (1.f / DM) + EPS); *rstdB = rsqrtf(s2b * (1.f / DM) + EPS); }
        v2u* oa = (v2u*)orowA + lane; v2u* ob = (v2u*)orowB + lane;
#pragma unroll
        for (int j = 0; j < 4; ++j) { v2u w; w.x = cvtpk(xa[j].x, xa[j].y); w.y = cvtpk(xa[j].z, xa[j].w); oa[64 * j] = w; w.x = cvtpk(xb[j].x, xb[j].y); w.y = cvtpk(xb[j].z, xb[j].w); ob[64 * j] = w; } }
}

#define MFMA16(a, b, c) __builtin_amdgcn_mfma_f32_16x16x32_bf16((a), (b), (c), 0, 0, 0)
__device__ __forceinline__ bf16x8 pack8(const f32x4& a, const f32x4& b) {
    v4u w; w.x = cvtpk(a[0], a[1]); w.y = cvtpk(a[2], a[3]); w.z = cvtpk(b[0], b[1]); w.w = cvtpk(b[2], b[3]); return __builtin_bit_cast(bf16x8, w);
}
constexpr float NSA_SC = 0.125f * 1.4426950408889634f;
__device__ __forceinline__ void nsa_load(const bf16* __restrict__ kbase, const bf16* __restrict__ vtbase, int vt_ld, int key0, bf16x8 (&ka)[2][2], bf16x8 (&va)[4], int c, int gq) {
#pragma unroll
    for (int sub = 0; sub < 2; ++sub)
#pragma unroll
        for (int s = 0; s < 2; ++s) ka[sub][s] = *(const bf16x8*)(kbase + (size_t)(key0 + 16 * sub + c) * 64 + 32 * s + 8 * gq);
#pragma unroll
    for (int dt = 0; dt < 4; ++dt) va[dt] = *(const bf16x8*)(vtbase + (size_t)(16 * dt + c) * vt_ld + key0 + 8 * gq);
}
template <int MODE>
__device__ __forceinline__ void nsa_step(const bf16x8 (&ka)[2][2], const bf16x8 (&va)[4], int key0, int tq, bool selbit, bool masked  ,
                                         const LAS bf16x8* ql, float (&mrun)[3], float (&lrun)[3], f32x4 (&O)[3][4], int gq) {
    const int kA = key0 + 4 * gq;
#pragma unroll
    for (int h = 0; h < 3; ++h) {
        const bf16x8 q0 = ql[64 * (2 * h)], q1 = ql[64 * (2 * h + 1)];
        f32x4 sA = {0.f, 0.f, 0.f, 0.f}, sB = {0.f, 0.f, 0.f, 0.f};
        sA = MFMA16(ka[0][0], q0, sA); sA = MFMA16(ka[0][1], q1, sA);
        sB = MFMA16(ka[1][0], q0, sB); sB = MFMA16(ka[1][1], q1, sB);
        float v[8];
#pragma unroll
        for (int r = 0; r < 4; ++r) { v[r] = sA[r]; v[4 + r] = sB[r]; }
        if (masked) {
#pragma unroll
            for (int r = 0; r < 4; ++r) { const int k1 = kA + r, k2 = kA + 16 + r;
                const bool ok1 = (MODE == 0) ? (k1 <= tq && k1 > tq - 512) : (selbit && k1 <= tq);
                const bool ok2 = (MODE == 0) ? (k2 <= tq && k2 > tq - 512) : (selbit && k2 <= tq);
                v[r] = ok1 ? v[r] : -1e30f; v[4 + r] = ok2 ? v[4 + r] : -1e30f; } }
        const float lm = fmaxf(fmaxf(fmaxf(v[0], v[1]), fmaxf(v[2], v[3])), fmaxf(fmaxf(v[4], v[5]), fmaxf(v[6], v[7])));
        if (__any(lm > mrun[h] + 8.0f)) {
            float mx = fmaxf(lm, __shfl_xor(lm, 16)); mx = fmaxf(mx, __shfl_xor(mx, 32));
            const float mnew = fmaxf(mrun[h], mx); const float alpha = __builtin_amdgcn_exp2f(mrun[h] - mnew); mrun[h] = mnew; lrun[h] *= alpha;
#pragma unroll
            for (int dt = 0; dt < 4; ++dt) O[h][dt] = O[h][dt] * alpha; }
        const float mh = mrun[h];
        float p[8]; float ps = 0.f;
#pragma unroll
        for (int i = 0; i < 8; ++i) { p[i] = __builtin_amdgcn_exp2f(v[i] - mh); ps += p[i]; }
        lrun[h] += ps;
        const bf16x8 pf = pack8((f32x4){p[0], p[1], p[2], p[3]}, (f32x4){p[4], p[5], p[6], p[7]});
#pragma unroll
        for (int dt = 0; dt < 4; ++dt) O[h][dt] = MFMA16(va[dt], pf, O[h][dt]);
    }
}
#define LDS_BAR() do { asm volatile("s_waitcnt lgkmcnt(0)" ::: "memory"); __builtin_amdgcn_s_barrier(); asm volatile("" ::: "memory"); } while (0)
constexpr int NSA_WSTRIDE = 12288, NSA_VCT = 98304, NSA_KC = 133120;
static_assert(8 * NSA_WSTRIDE <= NSA_VCT && NSA_VCT + 64 * 272 <= 131072 && NSA_KC >= LDSCTL_OFF + 2048 && NSA_KC + 128 * 144 <= LDS_BYTES, "NSA LDS map");
constexpr int NSA_SLOT0 = 115712, NSA_SLOT1 = 151552, NSA_HMX = LDSCTL_OFF + 1024;
static_assert(NSA_SLOT0 + 9728 <= 131072 && NSA_SLOT1 >= NSA_KC + 128 * 144 && NSA_SLOT1 + 9728 <= LDS_BYTES, "NSA tile ring");
template <int MODE>
__device__ __forceinline__ void nsa_coop_loop(LAS unsigned char* lds, const bf16* __restrict__ kbase, const bf16* __restrict__ vtbase, int klo, int ntile, unsigned long long hm_blk, unsigned long long hm_wave,
                                              int t0, int tq, unsigned selmask, const LAS bf16x8* ql, float (&mrun)[3], float (&lrun)[3], f32x4 (&O)[3][4], int tid, int c, int gq) {
    const bool isk = tid < 256; const int t2 = tid & 255;
    const bf16* tbase = isk ? kbase + (t2 >> 3) * 64 + (t2 & 7) * 8 : vtbase + (size_t)(t2 >> 2) * SEQ + (t2 & 3) * 8;
    const int kmul = isk ? 64 : 1;
    const int ldst = isk ? (t2 >> 3) * 144 + (t2 & 7) * 16 : 4608 + (t2 >> 2) * 80 + (t2 & 3) * 16;
    int keyP = klo; unsigned long long hmP = hm_blk, hmC = hm_blk;
#define NSA_NEXTP(dst) do { int k_; if (MODE == 0) { k_ = keyP; keyP += 32; } else { k_ = 32 * __builtin_ctzll(hmP); hmP &= hmP - 1ull; } dst = *(const v4u*)(tbase + (size_t)k_ * kmul); } while (0)
#define NSA_COMMIT(src, slot) (*(LAS v4u*)(lds + (slot) + ldst) = (src))
#define NSA_COMPUTE(slot, sidx) do { int key0_; if (MODE == 0) key0_ = klo + 32 * (sidx); else { key0_ = 32 * __builtin_ctzll(hmC); hmC &= hmC - 1ull; } \
        const bool rel_ = (MODE == 0) ? (key0_ <= t0 + 15 && key0_ + 31 >= t0 - 511) : (bool)((hm_wave >> (key0_ >> 5)) & 1ull); \
        if (rel_) { bf16x8 ka_[2][2], va_[4]; \
            _Pragma("unroll") for (int sub_ = 0; sub_ < 2; ++sub_) _Pragma("unroll") for (int s_ = 0; s_ < 2; ++s_) ka_[sub_][s_] = *(const LAS bf16x8*)(lds + (slot) + (16 * sub_ + c) * 144 + 64 * s_ + 16 * gq); \
            _Pragma("unroll") for (int dt_ = 0; dt_ < 4; ++dt_) va_[dt_] = *(const LAS bf16x8*)(lds + (slot) + 4608 + (16 * dt_ + c) * 80 + 16 * gq); \
            if (MODE == 0) nsa_step<0>(ka_, va_, key0_, tq, true, !(key0_ + 31 <= t0 && key0_ > t0 + 15 - 512), ql, mrun, lrun, O, gq); \
            else { const bool sb_ = (selmask >> (key0_ >> 6)) & 1u; nsa_step<1>(ka_, va_, key0_, tq, sb_, !(key0_ + 31 <= t0 && __all(sb_)), ql, mrun, lrun, O, gq); } } } while (0)
    v4u R0 = {0u, 0u, 0u, 0u}, R1 = R0;
    if (ntile > 0) { NSA_NEXTP(R0); NSA_COMMIT(R0, NSA_SLOT0); }
    if (ntile > 1) NSA_NEXTP(R0);
    if (ntile > 2) NSA_NEXTP(R1);
    LDS_BAR();
    for (int s = 0; s < ntile; s += 2) {
        if (s + 1 < ntile) NSA_COMMIT(R0, NSA_SLOT1);
        if (s + 3 < ntile) NSA_NEXTP(R0);
        NSA_COMPUTE(NSA_SLOT0, s);
        LDS_BAR();
        if (s + 1 >= ntile) break;
        if (s + 2 < ntile) NSA_COMMIT(R1, NSA_SLOT0);
        if (s + 4 < ntile) NSA_NEXTP(R1);
        NSA_COMPUTE(NSA_SLOT1, s + 1);
        LDS_BAR();
    }
#undef NSA_NEXTP
#undef NSA_COMMIT
#undef NSA_COMPUTE
}
struct NsaPtrs { const bf16* proj; const bf16* kc; const bf16* vct; const bf16* ks; const bf16* vst; const bf16* kw; const bf16* vwt; bf16* mix; };
__device__ __forceinline__ void nsa_stage_cmp(LAS unsigned char* lds, const NsaPtrs& P, int b, int g, int tid) {
    const bf16* kc = P.kc + (size_t)(b * 2 + g) * 128 * 64; const bf16* vct = P.vct + (size_t)(b * 2 + g) * 64 * 128;
#pragma unroll
    for (int q = 0; q < 2; ++q) { const int e = tid + NTHR * q;
        *(LAS v4u*)(lds + NSA_KC + (e >> 3) * 144 + (e & 7) * 16) = *(const v4u*)(kc + (e >> 3) * 64 + (e & 7) * 8);
        *(LAS v4u*)(lds + NSA_VCT + (e >> 4) * 272 + (e & 15) * 16) = *(const v4u*)(vct + (e >> 4) * 128 + (e & 15) * 8); }
}
__device__ __forceinline__ void nsa_item(const NsaPtrs& P, LAS unsigned char* lds, int wave, int b, int g, int t0, int tid, int lane) {
    asm volatile("" : "+v"(lane));
    const int c = lane & 15, gq = lane >> 4;
    const int tq = t0 + c, cur = t0 >> 6;
    const bf16* prow = P.proj + ((size_t)b * SEQ + tq) * NINP;
    LAS v2u* outl = (LAS v2u*)(lds + wave * NSA_WSTRIDE) + lane;
    LAS bf16x8* ql = (LAS bf16x8*)(lds + wave * NSA_WSTRIDE + 6144) + lane;
    unsigned graw[9];
    {
        v4u qr[6];
#pragma unroll
        for (int f = 0; f < 6; ++f) qr[f] = *(const v4u*)(prow + PC_NQ + (g * 3 + (f >> 1)) * 64 + 32 * (f & 1) + 8 * gq);
#pragma unroll
        for (int k = 0; k < 9; ++k) graw[k] = prow[PC_GATE + (k / 3) * 6 + g * 3 + (k % 3)];
#pragma unroll
        for (int f = 0; f < 6; ++f) { v4u qs; qs.x = cvtpk(bflo(qr[f].x) * NSA_SC, bfhi(qr[f].x) * NSA_SC); qs.y = cvtpk(bflo(qr[f].y) * NSA_SC, bfhi(qr[f].y) * NSA_SC);
            qs.z = cvtpk(bflo(qr[f].z) * NSA_SC, bfhi(qr[f].z) * NSA_SC); qs.w = cvtpk(bflo(qr[f].w) * NSA_SC, bfhi(qr[f].w) * NSA_SC);
            ql[64 * f] = __builtin_bit_cast(bf16x8, qs); }
    }
#define NSA_GATE(br, h) sigmoid_f(bf2f((bf16)graw[(br) * 3 + (h)]))
    asm volatile("" ::: "memory");
    float imp[8]; unsigned selmask = 0u;
    REP(31) {
#pragma unroll
    for (int st = 0; st < 8; ++st) imp[st] = 0.f;
    selmask = 0u;
    const int nvis = tq >= 31 ? ((tq - 31) >> 4) + 1 : 0;
#pragma unroll 1
    for (int h = 0; h < 3; ++h) {
        asm volatile("" ::: "memory");
        const bf16x8 qh0 = ql[64 * (2 * h)], qh1 = ql[64 * (2 * h + 1)];
        f32x4 s[8];
#pragma unroll
        for (int st = 0; st < 8; ++st) { const LAS unsigned char* kr = lds + NSA_KC + (16 * st + c) * 144 + 16 * gq;
            const bf16x8 a0 = *(const LAS bf16x8*)kr, a1 = *(const LAS bf16x8*)(kr + 64);
            f32x4 z = {0.f, 0.f, 0.f, 0.f}; z = MFMA16(a0, qh0, z); z = MFMA16(a1, qh1, z); s[st] = z; }
        float mx = -1e30f;
#pragma unroll
        for (int st = 0; st < 8; ++st)
#pragma unroll
            for (int r = 0; r < 4; ++r) { const int i = 16 * st + 4 * gq + r; const float v = (i < nvis) ? s[st][r] : -1e30f; s[st][r] = v; mx = fmaxf(mx, v); }
        mx = fmaxf(mx, __shfl_xor(mx, 16)); mx = fmaxf(mx, __shfl_xor(mx, 32)); mx = fmaxf(mx, -1e20f);
        float sum = 0.f;
#pragma unroll
        for (int st = 0; st < 8; ++st)
#pragma unroll
            for (int r = 0; r < 4; ++r) { const float p = __builtin_amdgcn_exp2f(s[st][r] - mx); s[st][r] = p; sum += p; }
        sum += __shfl_xor(sum, 16); sum += __shfl_xor(sum, 32);
        const float inv = sum > 0.f ? __builtin_amdgcn_rcpf(sum) : 0.f;
#pragma unroll
        for (int st = 0; st < 8; ++st) s[st] = s[st] * inv;
        float sh[8];
#pragma unroll
        for (int st = 0; st < 8; ++st) sh[st] = __shfl(s[st][3], (lane + 48) & 63);
#pragma unroll
        for (int st = 0; st < 8; ++st) { const float prev = gq > 0 ? sh[st] : (st > 0 ? sh[st > 0 ? st - 1 : 0] : 0.f);
            imp[st] += (s[st][0] + s[st][1]) + (s[st][2] + s[st][3]) + prev; }
        f32x4 Oc[4];
#pragma unroll
        for (int dt = 0; dt < 4; ++dt) Oc[dt] = (f32x4){0.f, 0.f, 0.f, 0.f};
#pragma unroll
        for (int ks = 0; ks < 4; ++ks) { const bf16x8 pf = pack8(s[2 * ks], s[2 * ks + 1]);
#pragma unroll
            for (int dt = 0; dt < 4; ++dt) { const bf16x8 vf = *(const LAS bf16x8*)(lds + NSA_VCT + (16 * dt + c) * 272 + 64 * ks + 16 * gq); Oc[dt] = MFMA16(vf, pf, Oc[dt]); } }
        { const float gt = sigmoid_f(bf2f((bf16)(h == 0 ? graw[0] : (h == 1 ? graw[1] : graw[2]))));
#pragma unroll
            for (int dt = 0; dt < 4; ++dt) { const f32x4 o = Oc[dt] * gt; v2u w; w.x = cvtpk(o[0], o[1]); w.y = cvtpk(o[2], o[3]); outl[64 * (4 * h + dt)] = w; } }
    }
    {
        unsigned key[8];
#pragma unroll
        for (int st = 0; st < 8; ++st) { const int j = 4 * st + gq; const bool elig = j <= cur, forced = (j == 0) || (j == cur) || (j == cur - 1);
            const float sc = elig ? (imp[st] + (forced ? 1e4f : 0.f)) : -1e4f; const unsigned u = __float_as_uint(sc);
            key[st] = (((u & 0x80000000u) ? ~u : (u | 0x80000000u)) & ~31u) | (unsigned)(31 - j); }
#pragma unroll
        for (int it = 0; it < 8; ++it) {
            unsigned bk = key[0];
#pragma unroll
            for (int st = 1; st < 8; ++st) bk = bk > key[st] ? bk : key[st];
            { const unsigned o = (unsigned)__shfl_xor((int)bk, 16); bk = bk > o ? bk : o; }
            { const unsigned o = (unsigned)__shfl_xor((int)bk, 32); bk = bk > o ? bk : o; }
            const int bj = 31 - (int)(bk & 31u);
            selmask |= 1u << bj;
#pragma unroll
            for (int st = 0; st < 8; ++st) if (4 * st + gq == bj) key[st] = 0u;
        }
    }
    }
    float mrun[3], lrun[3]; f32x4 O[3][4];
    {
        const bf16* kw = P.kw + (size_t)(b * 2 + g) * SEQ * 64; const bf16* vwt = P.vwt + (size_t)(b * 2 + g) * 64 * SEQ;
        REP(32) {
#pragma unroll
        for (int h = 0; h < 3; ++h) { mrun[h] = -1e20f; lrun[h] = 0.f;
#pragma unroll
            for (int dt = 0; dt < 4; ++dt) O[h][dt] = (f32x4){0.f, 0.f, 0.f, 0.f}; }
        asm volatile("" ::: "memory");
        { const int T0 = t0 - 16 * wave; int klo = T0 - 511; klo = klo < 0 ? 0 : klo; klo &= ~31; const int klast = (T0 + 127) & ~31;
            nsa_coop_loop<0>(lds, kw, vwt, klo, (klast - klo) / 32 + 1, 0ull, 0ull, t0, tq, selmask, ql, mrun, lrun, O, tid, c, gq); }
        }
#pragma unroll
        for (int h = 0; h < 3; ++h) { float lt = lrun[h]; lt += __shfl_xor(lt, 16); lt += __shfl_xor(lt, 32); const float inv = lt > 0.f ? NSA_GATE(2, h) * __builtin_amdgcn_rcpf(lt) : 0.f;
#pragma unroll
            for (int dt = 0; dt < 4; ++dt) { const v2u w0 = outl[64 * (4 * h + dt)]; const f32x4 o = (f32x4){bflo(w0.x), bfhi(w0.x), bflo(w0.y), bfhi(w0.y)} + O[h][dt] * inv;
                v2u w; w.x = cvtpk(o[0], o[1]); w.y = cvtpk(o[2], o[3]); outl[64 * (4 * h + dt)] = w; } }
        asm volatile("" ::: "memory");
    }
    {
        const bf16* ks = P.ks + (size_t)(b * 2 + g) * SEQ * 64; const bf16* vst = P.vst + (size_t)(b * 2 + g) * 64 * SEQ;
        REP(33) {
#pragma unroll
        for (int h = 0; h < 3; ++h) { mrun[h] = -1e20f; lrun[h] = 0.f;
#pragma unroll
            for (int dt = 0; dt < 4; ++dt) O[h][dt] = (f32x4){0.f, 0.f, 0.f, 0.f}; }
        {
            unsigned um = selmask;
#pragma unroll
            for (int off = 1; off < 64; off <<= 1) um |= (unsigned)__shfl_xor((int)um, off);
            um = (unsigned)__builtin_amdgcn_readfirstlane((int)um) & ((2u << cur) - 1u);
            unsigned long long x = um;
            x = (x | (x << 16)) & 0x0000FFFF0000FFFFull; x = (x | (x << 8)) & 0x00FF00FF00FF00FFull; x = (x | (x << 4)) & 0x0F0F0F0F0F0F0F0Full;
            x = (x | (x << 2)) & 0x3333333333333333ull; x = (x | (x << 1)) & 0x5555555555555555ull;
            unsigned long long hm = x | (x << 1);
            if (64 * cur + 32 > t0 + 15) hm &= ~(1ull << (2 * cur + 1));
            LAS unsigned* hmx = (LAS unsigned*)(lds + NSA_HMX);
            if (lane == 0) { hmx[2 * wave] = (unsigned)hm; hmx[2 * wave + 1] = (unsigned)(hm >> 32); }
            LDS_BAR();
            unsigned lo_ = 0u, hi_ = 0u;
#pragma unroll
            for (int w8 = 0; w8 < 8; ++w8) { lo_ |= hmx[2 * w8]; hi_ |= hmx[2 * w8 + 1]; }
            const unsigned long long hmb = ((unsigned long long)(unsigned)__builtin_amdgcn_readfirstlane((int)hi_) << 32) | (unsigned)__builtin_amdgcn_readfirstlane((int)lo_);
            nsa_coop_loop<1>(lds, ks, vst, 0, __builtin_popcountll(hmb), hmb, hm, t0, tq, selmask, ql, mrun, lrun, O, tid, c, gq);
        }
        }
        asm volatile("" ::: "memory");
#pragma unroll
        for (int h = 0; h < 3; ++h) { float lt = lrun[h]; lt += __shfl_xor(lt, 16); lt += __shfl_xor(lt, 32); const float inv = lt > 0.f ? NSA_GATE(1, h) * __builtin_amdgcn_rcpf(lt) : 0.f;
            bf16* orow = P.mix + ((size_t)b * SEQ + tq) * DM + 640 + g * 192 + h * 64;
#pragma unroll
            for (int dt = 0; dt < 4; ++dt) { const v2u w0 = outl[64 * (4 * h + dt)]; const f32x4 o = (f32x4){bflo(w0.x), bfhi(w0.x), bflo(w0.y), bfhi(w0.y)} + O[h][dt] * inv;
                v2u w; w.x = cvtpk(o[0], o[1]); w.y = cvtpk(o[2], o[3]); *(v2u*)(orow + 16 * dt + 4 * gq) = w; } }
    }
#undef NSA_GATE
}

typedef short bf16x4 __attribute__((ext_vector_type(4)));
#define MFMA16K(a, b, c) __builtin_amdgcn_mfma_f32_16x16x16bf16_1k((a), (b), (c), 0, 0, 0)
__device__ __forceinline__ bf16x4 pack4(const f32x4& a) { v2u w; w.x = cvtpk(a[0], a[1]); w.y = cvtpk(a[2], a[3]); return __builtin_bit_cast(bf16x4, w); }
constexpr int DNF_UNIT = 40960;
constexpr int DL_RAWB = 26880, DL_RAW = 0, DL_QS = 2 * DL_RAWB, DL_KS = DL_QS + 9216, DL_KT = DL_KS + 9216, DL_WL = DL_KT + 9216, DL_AII = DL_WL + 9216, DL_TINV = DL_AII + 4096, DL_VEC = DL_TINV + 4096, DL_END = DL_VEC + 2048;
static_assert(DL_END <= 131072, "DeltaNet chunk LDS map");
struct DnPre { v4u raw[4]; unsigned gb, ga; };
struct DnUnitId { int b, h, n, valid; };
__device__ __forceinline__ DnUnitId dn_unit_id(int u) { DnUnitId r; r.valid = u < BATCH * 6 * 32; const int uu = r.valid ? u : 0; r.n = uu & 31; const int bh = uu >> 5; r.b = bh / 6; r.h = bh % 6; return r; }
__device__ __forceinline__ void dn_prefetch(DnPre& P, const bf16* __restrict__ PROJ, const DnUnitId id, int tid, int lane, int wave) {
#pragma unroll
    for (int q = 0; q < 4; ++q) { const int e = tid + NTHR * q, rr = e / 24, pc = e % 24, part = pc >> 3, d0 = (pc & 7) * 8, t = 64 * id.n - 3 + rr;
        v4u val = {0u, 0u, 0u, 0u};
        if (id.valid && e < 67 * 24 && t >= 0) val = *(const v4u*)(PROJ + ((size_t)id.b * SEQ + t) * NINP + part * 384 + id.h * 64 + d0);
        P.raw[q] = val; }
    P.gb = 0u; P.ga = 0u;
    if (wave == 1 && id.valid) { const bf16* pr = PROJ + ((size_t)id.b * SEQ + 64 * id.n + lane) * NINP; P.gb = pr[PC_B + id.h]; P.ga = pr[PC_A + id.h]; }
}
__device__ __forceinline__ void dn_commit_raw(const DnPre& P, LAS unsigned char* L, int par, int tid) {
#pragma unroll
    for (int q = 0; q < 4; ++q) { const int e = tid + NTHR * q, rr = e / 24, pc = e % 24, part = pc >> 3, d0 = (pc & 7) * 8;
        if (e < 67 * 24) *(LAS v4u*)(L + DL_RAW + par * DL_RAWB + rr * 400 + (part * 64 + d0) * 2) = P.raw[q]; }
}
__device__ __forceinline__ void dn_commit_gates(const DnPre& P, LAS unsigned char* L, int par, float Aexp, float dtb, float* __restrict__ gt_out, bool valid, int lane, int wave) {
    if (wave == 1) { LAS float* vbeta = (LAS float*)(L + DL_VEC + par * 1024);
        const float beta = sigmoid_f(bf2f((bf16)P.gb)); const float z = bf2f((bf16)P.ga) + dtb; const float sp = z > 20.f ? z : log1pf(__expf(z)); float gv = -Aexp * sp;
#pragma unroll
        for (int off = 1; off < 64; off <<= 1) { const float t = __shfl_up(gv, off); if (lane >= off) gv += t; }
        const float glast = __shfl(gv, 63);
        vbeta[lane] = beta; vbeta[64 + lane] = gv; vbeta[128 + lane] = __expf(gv); vbeta[192 + lane] = __expf(glast - gv);
        if (lane == 63 && valid) *gt_out = __expf(gv); }
}
template <int PAR>
__device__ __forceinline__ void dn_chunk_unit(LAS unsigned char* L, const bf16* __restrict__ PROJ, const float* __restrict__ cw, const float* __restrict__ alog, const float* __restrict__ dtbp,
                                              unsigned char* __restrict__ dnf_all, float* __restrict__ gt_all, int u, int u_next, int tid, int lane, int wave) {
    LAS bf16* RAWs = (LAS bf16*)(L + DL_RAW + PAR * DL_RAWB); LAS bf16* QS = (LAS bf16*)(L + DL_QS); LAS bf16* KS = (LAS bf16*)(L + DL_KS); LAS bf16* KT = (LAS bf16*)(L + DL_KT); LAS bf16* WL = (LAS bf16*)(L + DL_WL);
    LAS float* AII = (LAS float*)(L + DL_AII); LAS float* TINV = (LAS float*)(L + DL_TINV);
    LAS float* vbeta = (LAS float*)(L + DL_VEC + PAR * 1024); LAS float* vgam = vbeta + 64; LAS float* vegam = vgam + 64; LAS float* vedec = vegam + 64;
    asm volatile("" : "+v"(tid), "+v"(lane), "+s"(wave));
    const int col = lane & 15, g = lane >> 4;
    const DnUnitId id = dn_unit_id(u), idn = dn_unit_id(u_next);
    const int h = id.h;
    unsigned char* dnf = dnf_all + (size_t)u * DNF_UNIT;
    LDS_BAR();
    DnPre P; dn_prefetch(P, PROJ, idn, tid, lane, wave);
    f32x4 R[4]; bf16x8 AF1, AF2, AF3a, AF3b; const f32x4 z4 = {0.f, 0.f, 0.f, 0.f};
    REP(24) {
    {
        const int part = wave >> 2, cr = 16 * (wave & 3) + (lane >> 2), d0 = 16 * (lane & 3);
        float y[16];
#pragma unroll
        for (int e = 0; e < 16; ++e) y[e] = 0.f;
#pragma unroll
        for (int j = 0; j < 4; ++j) { const LAS bf16* xr = RAWs + (cr + j) * 200 + part * 64 + d0; const v4u xa = *(const LAS v4u*)xr, xb2 = *(const LAS v4u*)(xr + 8);
            const float* wj = cw + j * 1152 + part * 384 + h * 64 + d0;
            const f32x4 w0 = *(const f32x4*)wj, w1 = *(const f32x4*)(wj + 4), w2 = *(const f32x4*)(wj + 8), w3 = *(const f32x4*)(wj + 12);
            y[0] += w0[0] * bflo(xa.x); y[1] += w0[1] * bfhi(xa.x); y[2] += w0[2] * bflo(xa.y); y[3] += w0[3] * bfhi(xa.y);
            y[4] += w1[0] * bflo(xa.z); y[5] += w1[1] * bfhi(xa.z); y[6] += w1[2] * bflo(xa.w); y[7] += w1[3] * bfhi(xa.w);
            y[8] += w2[0] * bflo(xb2.x); y[9] += w2[1] * bfhi(xb2.x); y[10] += w2[2] * bflo(xb2.y); y[11] += w2[3] * bfhi(xb2.y);
            y[12] += w3[0] * bflo(xb2.z); y[13] += w3[1] * bfhi(xb2.z); y[14] += w3[2] * bflo(xb2.w); y[15] += w3[3] * bfhi(xb2.w); }
        float ss = 0.f;
#pragma unroll
        for (int e = 0; e < 16; ++e) { y[e] = silu_f(y[e]); ss += y[e] * y[e]; }
        ss += __shfl_xor(ss, 1); ss += __shfl_xor(ss, 2);
        const float sc = rsqrtf(ss + EPS) * (part == 0 ? 0.125f : 1.0f);
        v4u o0, o1;
        o0.x = cvtpk(y[0] * sc, y[1] * sc); o0.y = cvtpk(y[2] * sc, y[3] * sc); o0.z = cvtpk(y[4] * sc, y[5] * sc); o0.w = cvtpk(y[6] * sc, y[7] * sc);
        o1.x = cvtpk(y[8] * sc, y[9] * sc); o1.y = cvtpk(y[10] * sc, y[11] * sc); o1.z = cvtpk(y[12] * sc, y[13] * sc); o1.w = cvtpk(y[14] * sc, y[15] * sc);
        LAS bf16* dst = (part == 0 ? QS : KS) + cr * 72 + d0;
        *(LAS v4u*)dst = o0; *(LAS v4u*)(dst + 8) = o1;
        if (part == 1) {
            const unsigned ow[8] = {o0.x, o0.y, o0.z, o0.w, o1.x, o1.y, o1.z, o1.w};
#pragma unroll
            for (int e2 = 0; e2 < 8; ++e2) { KT[(d0 + 2 * e2) * 72 + cr] = (bf16)(ow[e2] & 0xffffu); KT[(d0 + 2 * e2 + 1) * 72 + cr] = (bf16)(ow[e2] >> 16); } }
    }
    if (wave < 4) { const int d = 16 * wave + col; float cwv[4];
#pragma unroll
        for (int j = 0; j < 4; ++j) cwv[j] = cw[j * 1152 + 768 + h * 64 + d];
#pragma unroll
        for (int i = 0; i < 4; ++i) { float x7[7];
#pragma unroll
            for (int m = 0; m < 7; ++m) x7[m] = bf2f(RAWs[(16 * i + 4 * g + m) * 200 + 128 + d]);
#pragma unroll
            for (int r = 0; r < 4; ++r) { const float yv = (cwv[0] * x7[r] + cwv[1] * x7[r + 1]) + (cwv[2] * x7[r + 2] + cwv[3] * x7[r + 3]); R[i][r] = silu_f(yv) * vbeta[16 * i + 4 * g + r]; } } }
    LDS_BAR();
    if (wave >= 4) { const int kd = 16 * (wave - 4) + col;
#pragma unroll
        for (int i = 0; i < 4; ++i)
#pragma unroll
            for (int r = 0; r < 4; ++r) { const int c = 16 * i + 4 * g + r; R[i][r] = bf2f(KS[c * 72 + kd]) * vbeta[c] * vegam[c]; } }
    bf16x8 KF[4][2];
#pragma unroll
    for (int ct = 0; ct < 4; ++ct)
#pragma unroll
        for (int s = 0; s < 2; ++s) KF[ct][s] = *(const LAS bf16x8*)(KS + (16 * ct + col) * 72 + 32 * s + 8 * g);
#define DN_TILE(dst, ctp, ct) do { f32x4 t_ = z4; t_ = MFMA16(KF[ctp][0], KF[ct][0], t_); t_ = MFMA16(KF[ctp][1], KF[ct][1], t_); \
        const float bc_ = -vbeta[16 * (ct) + col], gc_ = vgam[16 * (ct) + col]; const f32x4 gp_ = *(const LAS f32x4*)(vgam + 16 * (ctp) + 4 * g); \
        _Pragma("unroll") for (int r_ = 0; r_ < 4; ++r_) t_[r_] = t_[r_] * bc_ * __expf(gc_ - gp_[r_]); dst = t_; } while (0)
    { f32x4 t01, t02, t12, t03, t13, t23; DN_TILE(t01, 0, 1); DN_TILE(t02, 0, 2); DN_TILE(t12, 1, 2); DN_TILE(t03, 0, 3); DN_TILE(t13, 1, 3); DN_TILE(t23, 2, 3);
        AF1 = pack8(t01, z4); AF2 = pack8(t02, t12); AF3a = pack8(t03, t13); AF3b = pack8(t23, z4); }
#undef DN_TILE
    if (wave < 4) {
        const bf16x8 kd0 = *(const LAS bf16x8*)(KS + (16 * wave + col) * 72 + 8 * g), kd1 = *(const LAS bf16x8*)(KS + (16 * wave + col) * 72 + 32 + 8 * g);
        f32x4 t = z4; t = MFMA16(kd0, kd0, t); t = MFMA16(kd1, kd1, t);
        const int cc = 16 * wave + col; const float bc = vbeta[cc], gc = vgam[cc]; const f32x4 gp = *(const LAS f32x4*)(vgam + 16 * wave + 4 * g);
#pragma unroll
        for (int r = 0; r < 4; ++r) t[r] = (col > 4 * g + r) ? t[r] * bc * __expf(gc - gp[r]) : 0.f;
        *(LAS f32x4*)(AII + wave * 256 + col * 16 + 4 * g) = t; }
    LDS_BAR();
    }
    REP(25) {
    if (wave == 1) dn_commit_gates(P, L, 1 - PAR, __expf(alog[idn.h]), dtbp[idn.h], gt_all + (idn.valid ? u_next : 0), idn.valid != 0, lane, wave);
    if (wave == 0) { const int i = g, cl = col; float t[16];
#pragma unroll
        for (int r = 0; r < 16; ++r) { float acc = (r == cl) ? 1.f : 0.f; f32x4 rowv[4];
#pragma unroll
            for (int q = 0; q < 4; ++q) if (4 * q < r) rowv[q] = *(const LAS f32x4*)(AII + i * 256 + r * 16 + 4 * q);
#pragma unroll
            for (int m = 0; m < r; ++m) acc -= rowv[m >> 2][m & 3] * t[m];
            t[r] = acc; }
#pragma unroll
        for (int r = 0; r < 16; ++r) TINV[i * 256 + r * 16 + cl] = t[r]; }
    LDS_BAR();
    }
    f32x4 X[4];
    { bf16x4 TF[4];
#pragma unroll
        for (int i = 0; i < 4; ++i) { const f32x4 tv = *(const LAS f32x4*)(TINV + i * 256 + col * 16 + 4 * g); TF[i] = pack4(tv); }
        X[0] = MFMA16K(TF[0], pack4(R[0]), z4);
        { const f32x4 y = MFMA16(AF1, pack8(X[0], z4), R[1]); X[1] = MFMA16K(TF[1], pack4(y), z4); }
        { const f32x4 y = MFMA16(AF2, pack8(X[0], X[1]), R[2]); X[2] = MFMA16K(TF[2], pack4(y), z4); }
        { f32x4 y = MFMA16(AF3a, pack8(X[0], X[1]), R[3]); y = MFMA16(AF3b, pack8(X[2], z4), y); X[3] = MFMA16K(TF[3], pack4(y), z4); } }
    if (wave >= 4) { const int kd = 16 * (wave - 4) + col;
#pragma unroll
        for (int i = 0; i < 4; ++i)
#pragma unroll
            for (int r = 0; r < 4; ++r) WL[(16 * i + 4 * g + r) * 72 + kd] = f2bf(X[i][r]); }
    dn_commit_raw(P, L, 1 - PAR, tid);
    LDS_BAR();
    if (wave < 4) {
#pragma unroll
        for (int ct = 0; ct < 4; ++ct) { v2u w; w.x = cvtpk(X[ct][0], X[ct][1]); w.y = cvtpk(X[ct][2], X[ct][3]); *(v2u*)(dnf + 32768 + (wave * 4 + ct) * 512 + lane * 8) = w; } }
    { const int ct = wave >> 1, s = wave & 1;
        { const v2u a = *(const LAS v2u*)(WL + (16 * ct + col) * 72 + 32 * s + 4 * g), bq = *(const LAS v2u*)(WL + (16 * ct + col) * 72 + 32 * s + 16 + 4 * g);
            v4u o; o.x = a.x ^ 0x80008000u; o.y = a.y ^ 0x80008000u; o.z = bq.x ^ 0x80008000u; o.w = bq.y ^ 0x80008000u;
            *(v4u*)(dnf + wave * 1024 + lane * 16) = o; }
        { const v2u a = *(const LAS v2u*)(QS + (16 * ct + col) * 72 + 32 * s + 4 * g), bq = *(const LAS v2u*)(QS + (16 * ct + col) * 72 + 32 * s + 16 + 4 * g); const float e = vegam[16 * ct + col];
            v4u o; o.x = cvtpk(bflo(a.x) * e, bfhi(a.x) * e); o.y = cvtpk(bflo(a.y) * e, bfhi(a.y) * e); o.z = cvtpk(bflo(bq.x) * e, bfhi(bq.x) * e); o.w = cvtpk(bflo(bq.y) * e, bfhi(bq.y) * e);
            *(v4u*)(dnf + 8192 + wave * 1024 + lane * 16) = o; }
        { const v2u a = *(const LAS v2u*)(KT + (16 * ct + col) * 72 + 32 * s + 4 * g), bq = *(const LAS v2u*)(KT + (16 * ct + col) * 72 + 32 * s + 16 + 4 * g);
            const f32x4 e1 = *(const LAS f32x4*)(vedec + 32 * s + 4 * g), e2 = *(const LAS f32x4*)(vedec + 32 * s + 16 + 4 * g);
            v4u o; o.x = cvtpk(bflo(a.x) * e1[0], bfhi(a.x) * e1[1]); o.y = cvtpk(bflo(a.y) * e1[2], bfhi(a.y) * e1[3]); o.z = cvtpk(bflo(bq.x) * e2[0], bfhi(bq.x) * e2[1]); o.w = cvtpk(bflo(bq.y) * e2[2], bfhi(bq.y) * e2[3]);
            *(v4u*)(dnf + 24576 + wave * 1024 + lane * 16) = o; }
        { const bf16x8 q0 = *(const LAS bf16x8*)(QS + (16 * ct + col) * 72 + 8 * g), q1 = *(const LAS bf16x8*)(QS + (16 * ct + col) * 72 + 32 + 8 * g);
            const int cc = 16 * ct + col; const float gc = vgam[cc]; f32x4 th[2];
#pragma unroll
            for (int hh = 0; hh < 2; ++hh) { const int ctp = 2 * s + hh; f32x4 t = z4;
                if (ctp <= ct) { const bf16x8 k0 = *(const LAS bf16x8*)(KS + (16 * ctp + col) * 72 + 8 * g), k1 = *(const LAS bf16x8*)(KS + (16 * ctp + col) * 72 + 32 + 8 * g);
                    t = MFMA16(k0, q0, t); t = MFMA16(k1, q1, t); const f32x4 gp = *(const LAS f32x4*)(vgam + 16 * ctp + 4 * g);
#pragma unroll
                    for (int r = 0; r < 4; ++r) t[r] = (cc >= 16 * ctp + 4 * g + r) ? t[r] * __expf(gc - gp[r]) : 0.f; }
                th[hh] = t; }
            *(bf16x8*)(dnf + 16384 + wave * 1024 + lane * 16) = pack8(th[0], th[1]); }
    }
}
__device__ __forceinline__ void dn_chunk_phase(LAS unsigned char* L, const bf16* __restrict__ PROJ, const float* __restrict__ cw, const float* __restrict__ alog, const float* __restrict__ dtbp,
                                               unsigned char* __restrict__ dnf_all, float* __restrict__ gt_all, int u0, int stride, int tid, int lane, int wave) {
    constexpr int NU = BATCH * 6 * 32;
    if (u0 >= NU) return;
    __syncthreads();
    { const DnUnitId id0 = dn_unit_id(u0); DnPre P; dn_prefetch(P, PROJ, id0, tid, lane, wave); dn_commit_raw(P, L, 0, tid); dn_commit_gates(P, L, 0, __expf(alog[id0.h]), dtbp[id0.h], gt_all + u0, true, lane, wave); }
    for (int u = u0;; u += 2 * stride) {
        dn_chunk_unit<0>(L, PROJ, cw, alog, dtbp, dnf_all, gt_all, u, u + stride, tid, lane, wave);
        if (u + stride >= NU) break;
        dn_chunk_unit<1>(L, PROJ, cw, alog, dtbp, dnf_all, gt_all, u + stride, u + 2 * stride, tid, lane, wave);
        if (u + 2 * stride >= NU) break;
    }
    asm volatile("s_waitcnt vmcnt(0) lgkmcnt(0)" ::: "memory");
    __syncthreads();
}
struct DnScanCtx { LAS unsigned char* fb; LAS float* ssq; LAS bf16* tz; const unsigned char* ubase; const float* GTp; const bf16* PROJ; bf16* MIX; float nw; int b, h, bh, vt, col, g, lane; };
struct DnScanState { f32x4 S[4]; bf16x8 Sb0, Sb1; f32x4 ua[4]; };
template <int PAR> __device__ __forceinline__ void dn_scan_chunk(const DnScanCtx& C, int n, DnScanState& T) {
    const int vt = C.vt, col = C.col, g = C.g, lane = C.lane, h = C.h;
    const f32x4 z4 = {0.f, 0.f, 0.f, 0.f};
    LDS_BAR();
    const size_t tok0 = (size_t)C.b * SEQ + 64 * n;
    v4u zl[2];
#pragma unroll
    for (int j = 0; j < 2; ++j) zl[j] = *(const v4u*)(C.PROJ + (tok0 + (lane >> 1) + 32 * j) * NINP + PC_Z + h * 64 + 16 * vt + 8 * (lane & 1));
    const bool more = n + 1 < 32;
    v4u fr[8]; v2u un[4]; float gtn = 0.f;
    { const unsigned char* nb = C.ubase + (size_t)(more ? n + 1 : n) * DNF_UNIT;
#pragma unroll
        for (int q = 0; q < 8; ++q) fr[q] = *(const v4u*)(nb + (vt * 8 + q) * 1024 + lane * 16);
#pragma unroll
        for (int ct = 0; ct < 4; ++ct) un[ct] = *(const v2u*)(nb + 32768 + (vt * 4 + ct) * 512 + lane * 8);
        gtn = C.GTp[C.bh * 32 + (more ? n + 1 : n)]; }
    const LAS unsigned char* F = C.fb + PAR * 32768 + lane * 16;
#define DN_FRAG(set, f) (*(const LAS bf16x8*)(F + (set) * 8192 + (f) * 1024))
    bf16x8 fw[8], fq[8];
#pragma unroll
    for (int f = 0; f < 8; ++f) fw[f] = DN_FRAG(0, f);
#pragma unroll
    for (int f = 0; f < 8; ++f) fq[f] = DN_FRAG(1, f);
    f32x4 vn[4];
#pragma unroll
    for (int ct = 0; ct < 4; ++ct) { f32x4 a = T.ua[ct]; a = MFMA16(fw[2 * ct], T.Sb0, a); a = MFMA16(fw[2 * ct + 1], T.Sb1, a); vn[ct] = a; }
#pragma unroll
    for (int f = 0; f < 8; ++f) fw[f] = DN_FRAG(2, f);
    f32x4 oo[4];
#pragma unroll
    for (int ct = 0; ct < 4; ++ct) { f32x4 a = z4; a = MFMA16(fq[2 * ct], T.Sb0, a); a = MFMA16(fq[2 * ct + 1], T.Sb1, a); oo[ct] = a; }
#pragma unroll
    for (int f = 0; f < 8; ++f) fq[f] = DN_FRAG(3, f);
    const bf16x8 Vb0 = pack8(vn[0], vn[1]), Vb1 = pack8(vn[2], vn[3]);
#pragma unroll
    for (int ct = 0; ct < 4; ++ct) { f32x4 a = oo[ct]; a = MFMA16(fw[2 * ct], Vb0, a); a = MFMA16(fw[2 * ct + 1], Vb1, a); oo[ct] = a; }
#pragma unroll
    for (int kt = 0; kt < 4; ++kt) { f32x4 a = T.S[kt]; a = MFMA16(fq[2 * kt], Vb0, a); a = MFMA16(fq[2 * kt + 1], Vb1, a); T.S[kt] = a; }
#undef DN_FRAG
    T.Sb0 = pack8(T.S[0], T.S[1]); T.Sb1 = pack8(T.S[2], T.S[3]);
#pragma unroll
    for (int kt = 0; kt < 4; ++kt) T.S[kt] = T.S[kt] * gtn;
#pragma unroll
    for (int ct = 0; ct < 4; ++ct) T.ua[ct] = (f32x4){bflo(un[ct].x), bfhi(un[ct].x), bflo(un[ct].y), bfhi(un[ct].y)};
    { LAS unsigned char* dst = C.fb + (1 - PAR) * 32768 + (vt * 8) * 1024 + lane * 16;
#pragma unroll
        for (int q = 0; q < 8; ++q) *(LAS v4u*)(dst + q * 1024) = fr[q]; }
#pragma unroll
    for (int ct = 0; ct < 4; ++ct) { f32x4 q = oo[ct] * oo[ct];
#pragma unroll
        for (int off = 1; off < 16; off <<= 1) { q[0] += __shfl_xor(q[0], off); q[1] += __shfl_xor(q[1], off); q[2] += __shfl_xor(q[2], off); q[3] += __shfl_xor(q[3], off); }
        if (col == 0) *(LAS f32x4*)(C.ssq + vt * 64 + 16 * ct + 4 * g) = q; }
    LAS bf16* tz = C.tz;
#pragma unroll
    for (int j = 0; j < 2; ++j) *(LAS v4u*)(tz + ((lane >> 1) + 32 * j) * 24 + 8 * (lane & 1)) = zl[j];
    LDS_BAR();
#pragma unroll
    for (int ct = 0; ct < 4; ++ct) { const f32x4 tot = (*(const LAS f32x4*)(C.ssq + 16 * ct + 4 * g) + *(const LAS f32x4*)(C.ssq + 64 + 16 * ct + 4 * g)) + (*(const LAS f32x4*)(C.ssq + 128 + 16 * ct + 4 * g) + *(const LAS f32x4*)(C.ssq + 192 + 16 * ct + 4 * g));
#pragma unroll
        for (int r = 0; r < 4; ++r) { LAS bf16* e = tz + (16 * ct + 4 * g + r) * 24 + col;
            *e = f2bf(oo[ct][r] * rsqrtf(tot[r] * (1.f / 64.f) + EPS) * C.nw * silu_f(bf2f(*e))); } }
    asm volatile("s_waitcnt lgkmcnt(0)" ::: "memory");
#pragma unroll
    for (int j = 0; j < 2; ++j) { const v4u o = *(const LAS v4u*)(tz + ((lane >> 1) + 32 * j) * 24 + 8 * (lane & 1));
        *(v4u*)(C.MIX + (tok0 + (lane >> 1) + 32 * j) * DM + h * 64 + 16 * vt + 8 * (lane & 1)) = o; }
}
__device__ __forceinline__ void dn_scan_pair(LAS unsigned char* lds, const unsigned char* __restrict__ DNFp, const float* __restrict__ GTp, const bf16* __restrict__ PROJ, bf16* __restrict__ MIX,
                                             const float* __restrict__ nrmw, int pair, int lane, int wave) {
    DnScanCtx C;
    C.vt = wave & 3; C.bh = pair; C.b = C.bh / 6; C.h = C.bh % 6; C.col = lane & 15; C.g = lane >> 4; C.lane = lane;
    C.fb = lds + RING_OFF;
    C.ssq = (LAS float*)(lds + LDSCTL_OFF + 1024);
    C.tz = (LAS bf16*)(lds + RING_OFF + 65536 + (wave & 3) * 3072);
    if (wave >= 4) {
        __syncthreads();
        for (int n = 0; n < 32; ++n) { LDS_BAR(); LDS_BAR(); }
        asm volatile("s_waitcnt vmcnt(0) lgkmcnt(0)" ::: "memory");
        __syncthreads();
        return; }
    C.ubase = DNFp + (size_t)C.bh * 32 * DNF_UNIT; C.GTp = GTp; C.PROJ = PROJ; C.MIX = MIX;
    C.nw = nrmw[16 * C.vt + C.col];
    const f32x4 z4 = {0.f, 0.f, 0.f, 0.f};
    DnScanState T;
#pragma unroll
    for (int kt = 0; kt < 4; ++kt) T.S[kt] = z4;
    T.Sb0 = pack8(z4, z4); T.Sb1 = T.Sb0;
    __syncthreads();
    { const unsigned char* nb = C.ubase;
#pragma unroll
        for (int q = 0; q < 8; ++q) *(LAS v4u*)(C.fb + (C.vt * 8 + q) * 1024 + lane * 16) = *(const v4u*)(nb + (C.vt * 8 + q) * 1024 + lane * 16);
#pragma unroll
        for (int ct = 0; ct < 4; ++ct) { const v2u w = *(const v2u*)(nb + 32768 + (C.vt * 4 + ct) * 512 + lane * 8); T.ua[ct] = (f32x4){bflo(w.x), bfhi(w.x), bflo(w.y), bfhi(w.y)}; } }
    for (int n = 0; n < 32; n += 2) { dn_scan_chunk<0>(C, n, T); dn_scan_chunk<1>(C, n + 1, T); }
    asm volatile("s_waitcnt vmcnt(0) lgkmcnt(0)" ::: "memory");
    __syncthreads();
}
__device__ __forceinline__ void cmp_mlp2_tiles(const bf16* __restrict__ HID, const bf16* __restrict__ W2T, bf16* __restrict__ KC, bf16* __restrict__ VCT, int T0, int T1, int stride, int first, int lane) {
    const int col = lane & 15, g4 = lane >> 4;
    for (int T = T0 + first; T < T1; T += stride) {
        const int row0 = 16 * T, kv = row0 >> 13, g = (row0 >> 7) & 1, b = (row0 >> 8) & 31, i0 = row0 & 127;
        bf16x8 af[4];
#pragma unroll
        for (int s4 = 0; s4 < 4; ++s4) af[s4] = *(const bf16x8*)(HID + (size_t)(row0 + col) * 256 + kv * 128 + 32 * s4 + 8 * g4);
#pragma unroll
        for (int dt = 0; dt < 4; ++dt) { f32x4 acc = {0.f, 0.f, 0.f, 0.f};
#pragma unroll
            for (int s4 = 0; s4 < 4; ++s4) { const bf16x8 bfr = *(const bf16x8*)(W2T + (size_t)(kv * 64 + 16 * dt + col) * 128 + 32 * s4 + 8 * g4); acc = MFMA16(af[s4], bfr, acc); }
            if (i0 + 4 * g4 + 3 == 127) acc[3] = 0.f;
            if (kv == 0) {
#pragma unroll
                for (int r = 0; r < 4; ++r) KC[((size_t)(b * 2 + g) * 128 + i0 + 4 * g4 + r) * 64 + 16 * dt + col] = f2bf(acc[r]);
            } else { const int pos0 = 32 * (i0 >> 5) + 8 * g4 + ((i0 & 16) ? 4 : 0);
                v2u w; w.x = cvtpk(acc[0], acc[1]); w.y = cvtpk(acc[2], acc[3]); *(v2u*)(VCT + ((size_t)(b * 2 + g) * 64 + 16 * dt + col) * 128 + pos0) = w; } }
    }
}
struct Args { const float* in[21]; float* out; unsigned char* ws; int pre, ph_lo, ph_hi, l_lo, l_hi, pad; };
typedef const Args __attribute__((address_space(4)))* ArgsP;
enum { I_X = 0, I_NORMW, I_WIN, I_DNCONV, I_DNALOG, I_DNDT, I_DNNORM, I_CFW, I_CFB, I_CFLNW, I_CFLNB, I_KPOS, I_VPOS, I_KW1, I_KW2, I_VW1, I_VW2, I_WOUT, I_WG, I_WU, I_WD };

template <unsigned PHM> __global__ void __launch_bounds__(NTHR, 2) fwd(Args args) {
    extern __shared__ __attribute__((aligned(16))) unsigned char lds_raw[];
    LAS unsigned char* lds = (LAS unsigned char*)lds_raw;
    volatile LAS unsigned* MISC = (volatile LAS unsigned*)(lds + MISC_OFF);
    for (int u = threadIdx.x; u < (LDS_BYTES - LDSCTL_OFF) / 4; u += NTHR) ((LAS unsigned*)(lds + LDSCTL_OFF))[u] = 0u;
    __syncthreads();
#if MK_ONE_LAUNCH
    XcdBarrier bar = xcd_barrier_post((unsigned*)(args.ws + WS_CTL) + CW_BAR, MISC + 8);
#define GRID_BAR() xcd_barrier(bar)
#else
#define GRID_BAR() do { } while (0)
#endif
    const int ph_lo = args.ph_lo, ph_hi = args.ph_hi;
#define PH_LOCALS() \
    int tid = threadIdx.x; asm volatile("" : "+v"(tid)); \
    const int lane = tid & 63, wave = __builtin_amdgcn_readfirstlane(tid >> 6); \
    int blk = blockIdx.x; asm volatile("" : "+s"(blk)); \
    const int G = gridDim.x, gw = blk * NWAVES + wave, NGW = G * NWAVES; \
    ArgsP ap = (ArgsP)__builtin_amdgcn_kernarg_segment_ptr(); asm volatile("" : "+s"(ap)); \
    unsigned char* const ws = ap->ws; \
    bf16* const Win_t = (bf16*)(ws + WS_WIN); bf16* const Wout_t = (bf16*)(ws + WS_WOUT); bf16* const Wgu_t = (bf16*)(ws + WS_WGU); bf16* const Wd_t = (bf16*)(ws + WS_WD); bf16* const Wc1_t = (bf16*)(ws + WS_WC1); \
    bf16* const KC = (bf16*)(ws + WS_KC); bf16* const VCT = (bf16*)(ws + WS_VCT); \
    bf16* const PROJ = (bf16*)(ws + WS_PROJ); bf16* const HFF = (bf16*)(ws + WS_PROJ); bf16* const MIX = (bf16*)(ws + WS_MIX); bf16* const MBUF = (bf16*)(ws + WS_MBUF); bf16* const XB = (bf16*)(ws + WS_XB); \
    bf16* const ACMP = (bf16*)(ws + WS_ACMP); bf16* const HID = (bf16*)(ws + WS_HID); \
    bf16* const KS = (bf16*)(ws + WS_KS); bf16* const KW = (bf16*)(ws + WS_KW); bf16* const VST = (bf16*)(ws + WS_VST); bf16* const VWT = (bf16*)(ws + WS_VWT); \
    const float* const x_in = ap->in[I_X]; float* const xres = ap->out; float* const RSTD = (float*)(ws + WS_RSTD); bf16* const XD = (bf16*)ap->out; bf16* const XM = (bf16*)(ws + WS_MIX); (void)RSTD; (void)XD; (void)XM; \
    (void)lane; (void)gw; (void)NGW; (void)Win_t; (void)Wout_t; (void)Wgu_t; (void)Wd_t; (void)Wc1_t; (void)KC; (void)VCT; (void)PROJ; (void)HFF; (void)MIX; (void)MBUF; (void)XB; (void)ACMP; (void)HID; (void)KS; (void)KW; (void)VST; (void)VWT; (void)x_in; (void)xres; (void)G;

    const int lo = ph_lo, hi = ph_hi;
#define IN(k) (((PHM >> (k)) & 1u) && lo <= (k) && (k) < hi)
    if ((PHM & 1u) && args.pre) REP(30) {
        PH_LOCALS();
        LAS float* scr = (LAS float*)(lds + RING_OFF + wave * 16384);
        constexpr int IT_IN = 16 * 104, IT_OUT = 16 * 32, IT_GU = 16 * 176, IT_D = 44 * 32, IT_C1 = 32 * 8, IT_L = IT_IN + IT_OUT + IT_GU + IT_D + IT_C1;
        for (int it = gw; it < DEPTH * IT_L; it += NGW) {
            const int l = it / IT_L; int r = it % IT_L;
            const float* nw = ap->in[I_NORMW] + (size_t)l * 4 * DM;
            if (r < IT_IN) { const float* W = ap->in[I_WIN] + (size_t)l * DM * NIN; const float* sc = nw;
                wprep_item([=](int k, int n) { const int col = win_src_col(n); return col >= 0 ? W[(size_t)k * NIN + col] * sc[k] : 0.f; }, DM, Win_t + (size_t)l * NINP * DM, scr, r, 104, lane); continue; } r -= IT_IN;
            if (r < IT_OUT) { const float* W = ap->in[I_WOUT] + (size_t)l * DM * DM;
                wprep_item([=](int k, int n) { return W[(size_t)k * DM + n]; }, DM, Wout_t + (size_t)l * DM * DM, scr, r, 32, lane); continue; } r -= IT_OUT;
            if (r < IT_GU) { const float* Wg = ap->in[I_WG] + (size_t)l * DM * DFF; const float* Wu = ap->in[I_WU] + (size_t)l * DM * DFF; const float* sc = nw + 2 * DM;
                wprep_item([=](int k, int n) { const int t = n >> 8, w = n & 255; const ptrdiff_t sel = w < 128 ? (ptrdiff_t)0 : (Wu - Wg); return Wg[sel + (ptrdiff_t)k * DFF + 128 * t + (w & 127)] * sc[k]; }, DM, Wgu_t + (size_t)l * NGU * DM, scr, r, 176, lane); continue; } r -= IT_GU;
            if (r < IT_D) { const float* W = ap->in[I_WD] + (size_t)l * DFF * DM;
                wprep_item([=](int k, int n) { return W[(size_t)k * DM + n]; }, DFF, Wd_t + (size_t)l * DM * DFF, scr, r, 32, lane); continue; } r -= IT_D;
            { const float* Wk = ap->in[I_KW1] + (size_t)l * CMP_K * 128; const float* Wv = ap->in[I_VW1] + (size_t)l * CMP_K * 128;
                wprep_item([=](int k, int n) { const ptrdiff_t sel = n < 128 ? (ptrdiff_t)0 : (Wv - Wk); return Wk[sel + (ptrdiff_t)k * 128 + (n & 127)]; }, CMP_K, Wc1_t + (size_t)l * 256 * CMP_K, scr, r, 8, lane); }
        }
        for (int e = blk * NTHR + tid; e < DEPTH * 2 * 64 * 128; e += G * NTHR) { const int n = e & 127, d = (e >> 7) & 63, kv = (e >> 13) & 1, ll = e >> 14;
            ((bf16*)(ws + WS_W2T))[e] = f2bf(ap->in[kv ? I_VW2 : I_KW2][((size_t)ll * 128 + n) * 64 + d]); }
        for (int m = gw; m < MTOK / 2; m += NGW) {
            const int m2 = m + MTOK / 2; const f32x4* xa = (const f32x4*)(x_in + (size_t)m * DM) + lane; const f32x4* xb2 = (const f32x4*)(x_in + (size_t)m2 * DM) + lane;
            f32x4 va[4], vb[4]; float sa = 0.f, sb = 0.f;
#pragma unroll
            for (int j = 0; j < 4; ++j) { va[j] = xa[64 * j]; vb[j] = xb2[64 * j]; }
#pragma unroll
            for (int j = 0; j < 4; ++j) { sa += (va[j].x * va[j].x + va[j].y * va[j].y) + (va[j].z * va[j].z + va[j].w * va[j].w); sb += (vb[j].x * vb[j].x + vb[j].y * vb[j].y) + (vb[j].z * vb[j].z + vb[j].w * vb[j].w); }
#pragma unroll
            for (int o = 1; o < 64; o <<= 1) { sa += __shfl_xor(sa, o); sb += __shfl_xor(sb, o); }
            if (lane == 0) { RSTD[m] = rsqrtf(sa * (1.f / DM) + EPS); RSTD[m2] = rsqrtf(sb * (1.f / DM) + EPS); }
            v2u* oa = (v2u*)(XB + (size_t)m * DM) + lane; v2u* ob = (v2u*)(XB + (size_t)m2 * DM) + lane;
#pragma unroll
            for (int j = 0; j < 4; ++j) { v2u w; w.x = cvtpk(va[j].x, va[j].y); w.y = cvtpk(va[j].z, va[j].w); oa[64 * j] = w; w.x = cvtpk(vb[j].x, vb[j].y); w.y = cvtpk(vb[j].z, vb[j].w); ob[64 * j] = w; }
        }
        GRID_BAR();
    }

    for (int l = args.l_lo, l_end = args.l_hi; l < l_end; ++l) {
        if (IN(1)) REP(1) {
            PH_LOCALS();
            pg8::Gemm g{l == 0 ? XB : XD, Win_t + (size_t)l * NINP * DM, MTOK, NINP, DM}; pg8::StaticOrder S; S.init(MTOK, NINP, G, blk);
            pg8::EpiBf16<0> E{PROJ, NINP, RSTD};
            pg8::gemm_phase<pg8::EpiBf16<0>, pg8::StaticOrder, true, true>(lds + RING_OFF, g, S, E);
            GRID_BAR();
        }
        if (IN(2)) REP(2) {
            PH_LOCALS();
            REP(21) {
            {
                const float* kpos = ap->in[I_KPOS] + (size_t)l * 32 * 64; const float* vpos = ap->in[I_VPOS] + (size_t)l * 32 * 64;
                for (int row = gw; row < CMP_ROWS; row += NGW) {
                    const int i = row & 127, g = (row >> 7) & 1, b = (row >> 8) & 31, kv = row >> 13;
                    const float* pos = kv ? vpos : kpos; const int pc = (kv ? PC_VC : PC_KC) + g * 64;
#pragma unroll
                    for (int cch = 0; cch < 4; ++cch) { const int ch = lane + 64 * cch, tl = ch >> 3, d0 = (ch & 7) * 8;
                        v4u o = {0u, 0u, 0u, 0u};
                        if (i < 127) { const v4u s = *(const v4u*)(PROJ + ((size_t)b * SEQ + 16 * i + tl) * NINP + pc + d0);
                            const f32x4 p0 = *(const f32x4*)(pos + tl * 64 + d0), p1 = *(const f32x4*)(pos + tl * 64 + d0 + 4);
                            o.x = cvtpk(bflo(s.x) + p0.x, bfhi(s.x) + p0.y); o.y = cvtpk(bflo(s.y) + p0.z, bfhi(s.y) + p0.w);
                            o.z = cvtpk(bflo(s.z) + p1.x, bfhi(s.z) + p1.y); o.w = cvtpk(bflo(s.w) + p1.z, bfhi(s.w) + p1.w); }
                        *(v4u*)(ACMP + (size_t)row * CMP_K + tl * 64 + d0) = o; }
                }
            }
            for (size_t ch = (size_t)blk * NTHR + tid; ch < (size_t)MTOK * 32; ch += (size_t)G * NTHR) {
                const int cc = (int)(ch & 31), which = cc >> 4, g = (cc >> 3) & 1, d0 = (cc & 7) * 8; const size_t tok = ch >> 5; const int b = (int)(tok >> 11), t = (int)(tok & 2047);
                const v4u s = *(const v4u*)(PROJ + tok * NINP + (which ? PC_KW : PC_KS) + g * 64 + d0);
                *(v4u*)((which ? KW : KS) + ((size_t)(b * 2 + g) * SEQ + t) * 64 + d0) = s;
            }
            {
                LAS bf16* tile = (LAS bf16*)(lds + RING_OFF + wave * 16384);
                for (int it = gw; it < 2 * BATCH * 2 * 32; it += NGW) {
                    const int tt = it & 31, g = (it >> 5) & 1, b = (it >> 6) & 31, which = it >> 11; const int t0 = tt * 64;
                    const bf16* src = PROJ + ((size_t)b * SEQ + t0) * NINP + (which ? PC_VW : PC_VS) + g * 64;
#pragma unroll
                    for (int q = 0; q < 8; ++q) { const int t = (lane >> 3) + 8 * q, d0 = (lane & 7) * 8; const v4u s = *(const v4u*)(src + (size_t)t * NINP + d0);
                        LAS unsigned* dst = (LAS unsigned*)(tile + t * 66 + d0); dst[0] = s.x; dst[1] = s.y; dst[2] = s.z; dst[3] = s.w; }
                    LDS_WAIT(); asm volatile("" ::: "memory");
                    bf16* dstb = (which ? VWT : VST) + (size_t)(b * 2 + g) * 64 * SEQ + t0;
#pragma unroll
                    for (int q = 0; q < 8; ++q) { const int d = (lane >> 3) + 8 * q, ck = lane & 7, gI = ck >> 2, gqq = ck & 3;
                        unsigned short e[8];
#pragma unroll
                        for (int j = 0; j < 8; ++j) { const int key = 32 * gI + (j < 4 ? 4 * gqq + j : 16 + 4 * gqq + (j - 4)); e[j] = tile[key * 66 + d]; }
                        v4u o; o.x = e[0] | ((unsigned)e[1] << 16); o.y = e[2] | ((unsigned)e[3] << 16); o.z = e[4] | ((unsigned)e[5] << 16); o.w = e[6] | ((unsigned)e[7] << 16);
                        *(v4u*)(dstb + (size_t)d * SEQ + 8 * ck) = o; }
                    LDS_WAIT(); asm volatile("" ::: "memory");
                }
            }
            }
            __syncthreads();
            REP(22) {
                LAS float* hb = (LAS float*)(lds + RING_OFF); LAS float* yb = hb + 62 * 256;
                const float* dw = ap->in[I_CFW] + (size_t)l * 31 * 256; const float* db = ap->in[I_CFB] + (size_t)l * 256;
                const float* lw = ap->in[I_CFLNW] + (size_t)l * 256; const float* lb = ap->in[I_CFLNB] + (size_t)l * 256;
                const int ch = tid & 255, half = tid >> 8; float wv[31];
#pragma unroll
                for (int j = 0; j < 31; ++j) wv[j] = dw[j * 256 + ch];
                const float bias = db[ch];
                float lwv[4], lbv[4];
#pragma unroll
                for (int k = 0; k < 4; ++k) { lwv[k] = lw[lane + 64 * k]; lbv[k] = lb[lane + 64 * k]; }
                for (int u = blk; u < BATCH * 64; u += G) {
                    const int b = u >> 6, t0 = (u & 63) * 32;
                    for (int e = tid; e < 62 * 32; e += NTHR) { const int rr = e >> 5, c8 = (e & 31) * 8, t = t0 - 30 + rr;
                        f32x4 o0 = {0.f, 0.f, 0.f, 0.f}, o1 = o0;
                        if (t >= 0) { const bf16* pr = PROJ + ((size_t)b * SEQ + t) * NINP + PC_CF + c8; const v4u a = *(const v4u*)pr, gg = *(const v4u*)(pr + 256);
                            o0 = (f32x4){bflo(a.x) * sigmoid_f(bflo(gg.x)), bfhi(a.x) * sigmoid_f(bfhi(gg.x)), bflo(a.y) * sigmoid_f(bflo(gg.y)), bfhi(a.y) * sigmoid_f(bfhi(gg.y))};
                            o1 = (f32x4){bflo(a.z) * sigmoid_f(bflo(gg.z)), bfhi(a.z) * sigmoid_f(bfhi(gg.z)), bflo(a.w) * sigmoid_f(bflo(gg.w)), bfhi(a.w) * sigmoid_f(bfhi(gg.w))}; }
                        *(LAS f32x4*)(hb + rr * 256 + c8) = o0; *(LAS f32x4*)(hb + rr * 256 + c8 + 4) = o1; }
                    __syncthreads();
                    { float hv[46];
#pragma unroll
                        for (int k = 0; k < 46; ++k) hv[k] = hb[(16 * half + k) * 256 + ch];
#pragma unroll
                        for (int i = 0; i < 16; ++i) { float acc = bias;
#pragma unroll
                            for (int j = 0; j < 31; ++j) acc += wv[j] * hv[i + j];
                            yb[(16 * half + i) * 256 + ch] = acc; } }
                    __syncthreads();
                    { float y[4][4], s1[4], s2[4];
#pragma unroll
                        for (int i4 = 0; i4 < 4; ++i4) { s1[i4] = 0.f; s2[i4] = 0.f;
#pragma unroll
                            for (int k = 0; k < 4; ++k) { const float v = yb[(wave * 4 + i4) * 256 + lane + 64 * k]; y[i4][k] = v; s1[i4] += v; s2[i4] += v * v; } }
#pragma unroll
                        for (int o = 1; o < 64; o <<= 1)
#pragma unroll
                            for (int i4 = 0; i4 < 4; ++i4) { s1[i4] += __shfl_xor(s1[i4], o); s2[i4] += __shfl_xor(s2[i4], o); }
#pragma unroll
                        for (int i4 = 0; i4 < 4; ++i4) { const float mean = s1[i4] * (1.f / 256.f); const float var = fmaxf(s2[i4] * (1.f / 256.f) - mean * mean, 0.f); const float rs = rsqrtf(var + EPS);
                            bf16* orow = MIX + ((size_t)b * SEQ + t0 + wave * 4 + i4) * DM + 384;
#pragma unroll
                            for (int k = 0; k < 4; ++k) orow[lane + 64 * k] = f2bf(silu_f((y[i4][k] - mean) * rs * lwv[k] + lbv[k])); } }
                    __syncthreads();
                }
            }
            REP(23) {
                dn_chunk_phase(lds + RING_OFF, PROJ, ap->in[I_DNCONV] + (size_t)l * 4 * 1152, ap->in[I_DNALOG] + l * 6, ap->in[I_DNDT] + l * 6, ws + WS_DNF, (float*)(ws + WS_GT), blk, G, tid, lane, wave);
            }
            GRID_BAR();
        }
        if (IN(3)) REP(3) {
            PH_LOCALS();
            if (blk < 64) {
                pg8::Gemm g{ACMP, Wc1_t + (size_t)l * 256 * CMP_K, CMP_ROWS, 256, CMP_K}; pg8::StaticOrder S; S.init(CMP_ROWS, 256, 64, blk);
                pg8::EpiBf16<1> E{HID, 256, nullptr};
                pg8::gemm_phase<pg8::EpiBf16<1>, pg8::StaticOrder, true, true>(lds + RING_OFF, g, S, E);
                pg8::Unit un; if (S.next(0, un)) { asm volatile("s_waitcnt vmcnt(0)" ::: "memory"); __syncthreads();
                    cmp_mlp2_tiles(HID, (const bf16*)(ws + WS_W2T) + (size_t)l * 2 * 64 * 128, KC, VCT, 16 * un.pm, 16 * un.pm + 16, NWAVES, wave, lane); }
            }
        }
        if (IN(11)) REP(11) {
            PH_LOCALS();
            if (blk >= 64 && blk < 64 + BATCH * 6)
                dn_scan_pair(lds, ws + WS_DNF, (const float*)(ws + WS_GT), PROJ, MIX, ap->in[I_DNNORM] + (size_t)l * 64, blk - 64, lane, wave);
            GRID_BAR();
        }
        if (IN(5)) REP(5) {
            PH_LOCALS();
            NsaPtrs P{PROJ, KC, VCT, KS, VST, KW, VWT, MIX};
            for (int u = blk; u < 1024; u += G) {
                const int hi4 = u >> 8, lo8 = u & 255, b = lo8 >> 3, g = (lo8 >> 2) & 1, q4 = lo8 & 3;
                const int q8 = hi4 == 0 ? q4 : (hi4 == 1 ? 15 - q4 : (hi4 == 2 ? 4 + q4 : 11 - q4));
                __syncthreads();
                nsa_stage_cmp(lds, P, b, g, tid);
                __syncthreads();
                nsa_item(P, lds, wave, b, g, (q8 * 8 + wave) * 16, tid, lane);
            }
            GRID_BAR();
        }
        if (IN(6)) REP(6) {
            PH_LOCALS();
            pg8::Gemm g{MIX, Wout_t + (size_t)l * DM * DM, MTOK, DM, DM}; pg8::StaticOrder S; S.init(MTOK, DM, G, blk);
            pg8::EpiBf16<0> E{MBUF, DM, nullptr};
            pg8::gemm_phase<pg8::EpiBf16<0>, pg8::StaticOrder, true, true>(lds + RING_OFF, g, S, E);
            GRID_BAR();
        }
        if (IN(7)) REP(7) {
            PH_LOCALS();
            const float* wp = ap->in[I_NORMW] + ((size_t)l * 4 + 1) * DM; bf16* const xo = (l == DEPTH - 1) ? XM : XD;
            constexpr int HM = MTOK / 2;
            if (l == 0) { for (int m = gw; m < HM; m += NGW) resid_row2<true, false>(x_in + (size_t)m * DM, x_in + (size_t)(m + HM) * DM, MBUF + (size_t)m * DM, MBUF + (size_t)(m + HM) * DM, wp, xo + (size_t)m * DM, xo + (size_t)(m + HM) * DM, RSTD + m, RSTD + m + HM, lane); }
            else { for (int m = gw; m < HM; m += NGW) resid_row2<false, false>(XD + (size_t)m * DM, XD + (size_t)(m + HM) * DM, MBUF + (size_t)m * DM, MBUF + (size_t)(m + HM) * DM, wp, xo + (size_t)m * DM, xo + (size_t)(m + HM) * DM, RSTD + m, RSTD + m + HM, lane); }
            GRID_BAR();
        }
        if (IN(8)) REP(8) {
            PH_LOCALS();
            pg8::Gemm g{(l == DEPTH - 1) ? XM : XD, Wgu_t + (size_t)l * NGU * DM, MTOK, NGU, DM}; pg8::StaticOrder S; S.init(MTOK, NGU, G, blk);
            pg8::EpiSwiGLU E{HFF, DFF, RSTD};
            pg8::gemm_phase<pg8::EpiSwiGLU, pg8::StaticOrder, true, true>(lds + RING_OFF, g, S, E);
            GRID_BAR();
        }
        if (IN(9)) REP(9) {
            PH_LOCALS();
            pg8::Gemm g{HFF, Wd_t + (size_t)l * DM * DFF, MTOK, DM, DFF}; pg8::StaticOrder S; S.init(MTOK, DM, G, blk);
            pg8::EpiBf16<0> E{MBUF, DM, nullptr};
            pg8::gemm_phase<pg8::EpiBf16<0>, pg8::StaticOrder, true, true>(lds + RING_OFF, g, S, E);
            GRID_BAR();
        }
        if (IN(10)) REP(10) {
            PH_LOCALS();
            const float* wp = ap->in[I_NORMW] + ((size_t)l * 4 + 3) * DM;
            constexpr int HM = MTOK / 2;
            if (l == DEPTH - 1) { for (int m = gw; m < HM; m += NGW) resid_row2<false, true>(XM + (size_t)m * DM, XM + (size_t)(m + HM) * DM, MBUF + (size_t)m * DM, MBUF + (size_t)(m + HM) * DM, wp, xres + (size_t)m * DM, xres + (size_t)(m + HM) * DM, RSTD + m, RSTD + m + HM, lane); }
            else { for (int m = gw; m < HM; m += NGW) resid_row2<false, false>(XD + (size_t)m * DM, XD + (size_t)(m + HM) * DM, MBUF + (size_t)m * DM, MBUF + (size_t)(m + HM) * DM, wp, XD + (size_t)m * DM, XD + (size_t)(m + HM) * DM, RSTD + m, RSTD + m + HM, lane); }
            if (l + 1 < ap->l_hi) GRID_BAR();
        }
    }
#undef IN
}

template <unsigned PHM> static int setup_kernel() {
    if (hipFuncSetAttribute((const void*)fwd<PHM>, hipFuncAttributeMaxDynamicSharedMemorySize, LDS_BYTES) != hipSuccess) { fprintf(stderr, "kernel_launch: hipFuncSetAttribute failed (mask %x)\n", PHM); return -1; }
    int per_cu = 0;
    if (hipOccupancyMaxActiveBlocksPerMultiprocessor(&per_cu, (const void*)fwd<PHM>, NTHR, LDS_BYTES) != hipSuccess || per_cu < 1) fprintf(stderr, "kernel_launch: occupancy query reports %d (mask %x)\n", per_cu, PHM);
    (void)hipGetLastError();
    return 0;
}
template <unsigned PHM> static void launch_ph(int grid, hipStream_t stream, const Args& a) { hipLaunchKernelGGL(fwd<PHM>, dim3(grid), dim3(NTHR), LDS_BYTES, stream, a); }
#ifndef PH_ALL_MASK
#define PH_ALL_MASK 0xfffu
#endif
constexpr unsigned PH_ALL = PH_ALL_MASK;
extern "C" void kernel_launch(void* const* d_in, const int* in_sizes, int n_in, void* d_out, int out_size, void* d_ws, size_t ws_size, hipStream_t stream) {
    static int grid = 0;
    if (grid == 0) {
        if (n_in != 21 || in_sizes[0] != MTOK * DM || out_size != MTOK * DM || ws_size < WS_END) { fprintf(stderr, "kernel_launch: unexpected shapes (n_in %d, in0 %d, out %d, ws %zu); nothing launched\n", n_in, n_in > 0 ? in_sizes[0] : -1, out_size, ws_size); grid = -1; return; }
        int dev = 0, cus = 0;
        if (hipGetDevice(&dev) != hipSuccess || hipDeviceGetAttribute(&cus, hipDeviceAttributeMultiprocessorCount, dev) != hipSuccess) { grid = -1; return; }
        int rc = 0;
#if MK_ONE_LAUNCH
        rc |= setup_kernel<PH_ALL>();
#else
        rc |= setup_kernel<1u << 0>(); rc |= setup_kernel<1u << 1>(); rc |= setup_kernel<1u << 2>(); rc |= setup_kernel<1u << 3>(); rc |= setup_kernel<1u << 4>(); rc |= setup_kernel<1u << 5>();
        rc |= setup_kernel<1u << 6>(); rc |= setup_kernel<1u << 7>(); rc |= setup_kernel<1u << 8>(); rc |= setup_kernel<1u << 9>(); rc |= setup_kernel<1u << 10>(); rc |= setup_kernel<1u << 11>();
#endif
        if (rc) { grid = -1; return; }
        grid = cus;
        if (grid < 128) { fprintf(stderr, "kernel_launch: needs >= 128 CUs\n"); grid = -1; return; }
    }
    if (grid < 0) return;
    if (hipMemsetAsync((char*)d_ws + WS_CTL, 0, CTL_ZERO_BYTES, stream) != hipSuccess) return;
    Args a{};
    for (int i = 0; i < 21; ++i) a.in[i] = (const float*)d_in[i];
    a.out = (float*)d_out; a.ws = (unsigned char*)d_ws;
#if MK_ONE_LAUNCH
    a.pre = 1; a.ph_lo = 1; a.ph_hi = 12; a.l_lo = 0; a.l_hi = DEPTH;
    launch_ph<PH_ALL>(grid, stream, a);
#else
    a.pre = 1; a.ph_lo = 0; a.ph_hi = 0; a.l_lo = 0; a.l_hi = 0;
    launch_ph<1u << 0>(grid, stream, a);
    for (int l = 0; l < DEPTH; ++l) {
        a.pre = 0; a.l_lo = l; a.l_hi = l + 1;
#define LP(p) do { a.ph_lo = (p); a.ph_hi = (p) + 1; launch_ph<1u << (p)>(grid, stream, a); } while (0)
        LP(1); LP(2); LP(3); LP(11); LP(4); LP(5); LP(6); LP(7); LP(8); LP(9); LP(10);
#undef LP
    }
#endif
}
```

```cpp
#include <hip/hip_runtime.h>
#include <cstdio>
#include <cstdint>

#ifndef PROBE_PH
#define PROBE_PH 0
#define PROBE_N 1
#endif
#define REP(k) for (int rep_ = 0; rep_ < ((k) == PROBE_PH ? PROBE_N : 1); ++rep_)
#ifndef MK_ONE_LAUNCH
#define MK_ONE_LAUNCH 1
#endif

namespace pg8 {
#define PG8_LAS __attribute__((address_space(3)))
typedef unsigned short bf16_t;
typedef short bf16x8 __attribute__((ext_vector_type(8)));
typedef float f32x4 __attribute__((ext_vector_type(4)));
typedef unsigned u32x4 __attribute__((ext_vector_type(4)));
constexpr int BM = 256, BK = 64, HALF = 128, HTB = HALF * BK * 2  , STAGE_BYTES = 8 * HTB, NXCD = 8, WGM = 8;

__host__ __device__ __forceinline__ int lds_byte(int r, int c) { const int st = (r >> 4) * 2 + (c >> 5), rr = r & 15, cc = c & 31, ob = rr * 64 + cc * 2; return st * 1024 + (ob ^ (((ob >> 9) & 1) << 5)); }
__host__ __device__ __forceinline__ void stage_rc(int b, int& R, int& C) { const int st = b / 1024, sb = b % 1024, swz = sb ^ (((sb >> 9) & 1) << 5); R = (st >> 1) * 16 + swz / 64; C = (st & 1) * 32 + (swz % 64) / 2; }
__host__ __device__ __forceinline__ int perm32(int rho) { const int n = rho >> 4, i = rho & 15; return 8 * (i >> 2) + 4 * n + (i & 3); }

struct Unit { int pm, pn; };
struct Gemm { const bf16_t* A; const bf16_t* Bt; int M, N, K; };

struct StaticOrder {
    int nM, nN, nwg, G, c;
    __host__ __device__ void init(int M, int N, int G_, int c_) { nM = M / BM; nN = N / BM; nwg = nM * nN; G = G_; c = c_; }
    __host__ __device__ bool next(int i, Unit& u) const {
        const long L = (long)i * G + c; if (L >= nwg) return false;
        int wgid = (int)L; { const int q = nwg / NXCD, r = nwg % NXCD, xcd = wgid % NXCD, off = wgid / NXCD; wgid = (xcd < r ? xcd * (q + 1) : r * (q + 1) + (xcd - r) * q) + off; }
        const int nig = WGM * nN, gid = wgid / nig, fm = gid * WGM, gsz = (nM - fm) < WGM ? (nM - fm) : WGM;
        u.pm = fm + ((wgid % nig) % gsz); u.pn = (wgid % nig) / gsz; return true;
    }
    __device__ __forceinline__ void a_ready(const Unit&) const {}
    __device__ __forceinline__ void done(const Unit&) const {}
};

__device__ __forceinline__ unsigned cvt_pk_bf16(float lo, float hi) { unsigned r; asm volatile("v_cvt_pk_bf16_f32 %0, %1, %2" : "=v"(r) : "v"(lo), "v"(hi)); return r; }
typedef float f32x2 __attribute__((ext_vector_type(2)));
__device__ __forceinline__ float silu_f(float v) { return v / (1.0f + __expf(-v)); }
template <int ACT> struct EpiBf16 {
    static constexpr bool PERM = true, AFTER_DRAIN = false;
    bf16_t* O; int ldc; const float* rs;
    __device__ __forceinline__ void operator()(const f32x4 (&acc)[2][2][4][2], const Unit& u, int wr, int wc, int fr, int fq) const {
        const int row0 = u.pm * BM + wr * 64 + fr; const int col0 = u.pn * BM + wc * 32 + 8 * fq;
#pragma unroll
        for (int ai = 0; ai < 2; ++ai)
#pragma unroll
            for (int m = 0; m < 4; ++m) { bf16_t* rowp = O + (size_t)(row0 + ai * HALF + m * 16) * ldc + col0; const float sc = rs ? rs[row0 + ai * HALF + m * 16] : 1.0f;
#pragma unroll
                for (int bj = 0; bj < 2; ++bj) { f32x4 v0 = acc[ai][bj][m][0] * sc, v1 = acc[ai][bj][m][1] * sc;
                    if (ACT == 1) {
#pragma unroll
                        for (int j = 0; j < 4; ++j) { v0[j] = silu_f(v0[j]); v1[j] = silu_f(v1[j]); } }
                    u32x4 w; w.x = cvt_pk_bf16(v0[0], v0[1]); w.y = cvt_pk_bf16(v0[2], v0[3]); w.z = cvt_pk_bf16(v1[0], v1[1]); w.w = cvt_pk_bf16(v1[2], v1[3]);
                    *(u32x4*)(rowp + bj * HALF) = w; } }
    }
};
struct EpiSwiGLU {
    static constexpr bool PERM = true, AFTER_DRAIN = false;
    bf16_t* O; int ldc; const float* rs;
    __device__ __forceinline__ void operator()(const f32x4 (&acc)[2][2][4][2], const Unit& u, int wr, int wc, int fr, int fq) const {
        const int row0 = u.pm * BM + wr * 64 + fr; const int col0 = u.pn * HALF + wc * 32 + 8 * fq;
#pragma unroll
        for (int ai = 0; ai < 2; ++ai)
#pragma unroll
            for (int m = 0; m < 4; ++m) { bf16_t* rowp = O + (size_t)(row0 + ai * HALF + m * 16) * ldc + col0; const float sc = rs[row0 + ai * HALF + m * 16];
                f32x4 g0 = acc[ai][0][m][0] * sc, g1 = acc[ai][0][m][1] * sc; const f32x4 u0 = acc[ai][1][m][0] * sc, u1 = acc[ai][1][m][1] * sc;
#pragma unroll
                for (int j = 0; j < 4; ++j) { g0[j] = silu_f(g0[j]) * u0[j]; g1[j] = silu_f(g1[j]) * u1[j]; }
                u32x4 w; w.x = cvt_pk_bf16(g0[0], g0[1]); w.y = cvt_pk_bf16(g0[2], g0[3]); w.z = cvt_pk_bf16(g1[0], g1[1]); w.w = cvt_pk_bf16(g1[2], g1[3]);
                *(u32x4*)rowp = w; }
    }
};

template <class Epi, class Sched, bool ALIGN_EPI = false, bool SP2 = false>
__device__ __forceinline__ void gemm_phase(PG8_LAS unsigned char* lds, const Gemm g, const Sched& S, const Epi& E) {
    int tid = threadIdx.x; asm volatile("" : "+v"(tid));
    const int wid = __builtin_amdgcn_readfirstlane(tid >> 6), lane = tid & 63, wr = wid >> 2, wc = wid & 3, fr = lane & 15, fq = lane >> 4;
    const int K = g.K, nt = K / BK;
    unsigned voffA[2], voffB[2];
#pragma unroll
    for (int i = 0; i < 2; ++i) { int R, C; stage_rc(tid * 16 + i * 8192, R, C); const int Rb = Epi::PERM ? ((R & ~31) + perm32(R & 31)) : R;
        voffA[i] = (unsigned)(R * K + C) * 2u; voffB[i] = (unsigned)(Rb * K + C) * 2u; }
    const size_t kstep = (size_t)(BK * 2);
    const size_t hstep = (size_t)HALF * K * 2;
    const size_t tstep = 2 * hstep;
    const unsigned ldsw = (unsigned)wid * 1024u;
    const int aoff = lds_byte(wr * 64 + fr, fq * 8), boff = lds_byte(wc * 32 + fr, fq * 8);
#define PG8_SA(b, h) (((b) * 2 + (h)) * HTB)
#define PG8_SB(b, h) ((4 + (b) * 2 + (h)) * HTB)
#define PG8_STAGE(bufoff, gbase, voff) do { _Pragma("unroll") for (int _i = 0; _i < 2; ++_i) \
        __builtin_amdgcn_global_load_lds((const unsigned*)((const char*)(gbase) + (voff)[_i]), (PG8_LAS unsigned*)(lds + (bufoff) + ldsw + _i * 8192), 16, 0, 0); } while (0)
#define PG8_LDA(dst, b, h) do { _Pragma("unroll") for (int m = 0; m < 4; ++m) _Pragma("unroll") for (int k = 0; k < 2; ++k) dst[m][k] = *(const PG8_LAS bf16x8*)(lds + PG8_SA(b, h) + aoff + m * 2048 + k * 1024); } while (0)
#define PG8_LDB(dst, b, h) do { _Pragma("unroll") for (int n = 0; n < 2; ++n) _Pragma("unroll") for (int k = 0; k < 2; ++k) dst[n][k] = *(const PG8_LAS bf16x8*)(lds + PG8_SB(b, h) + boff + n * 2048 + k * 1024); } while (0)
#define PG8_MMA(ai, bj, At, Bt) do { __builtin_amdgcn_s_setprio(1); _Pragma("unroll") for (int m = 0; m < 4; ++m) _Pragma("unroll") for (int n = 0; n < 2; ++n) _Pragma("unroll") for (int k = 0; k < 2; ++k) \
        acc[ai][bj][m][n] = __builtin_amdgcn_mfma_f32_16x16x32_bf16(Bt[n][k], At[m][k], acc[ai][bj][m][n], 0, 0, 0); __builtin_amdgcn_s_setprio(0); } while (0)
#define PG8_WAIT_V(n) asm volatile("s_waitcnt vmcnt(" #n ")" ::: "memory")
#define PG8_WAIT_L(n) asm volatile("s_waitcnt lgkmcnt(" #n ")" ::: "memory")
#define PG8_BAR __builtin_amdgcn_s_barrier()
#define PG8_SCHED __builtin_amdgcn_sched_barrier(0)
    Unit cur, nxt; int ui = 0;
    if (!S.next(0, cur)) return;
    f32x4 acc[2][2][4][2];
#pragma unroll
    for (int a = 0; a < 2; ++a)
#pragma unroll
        for (int b = 0; b < 2; ++b)
#pragma unroll
            for (int m = 0; m < 4; ++m)
#pragma unroll
                for (int n = 0; n < 2; ++n) acc[a][b][m][n] = (f32x4){0.f, 0.f, 0.f, 0.f};
    bf16x8 At[4][2], B0[2][2], B1[2][2];
    const char* cA = (const char*)g.A + (size_t)cur.pm * tstep; const char* cB = (const char*)g.Bt + (size_t)cur.pn * tstep;
    S.a_ready(cur);
    if constexpr (SP2) {
        PG8_STAGE(PG8_SB(0, 0), cB, voffB); PG8_STAGE(PG8_SB(0, 1), cB + hstep, voffB); PG8_STAGE(PG8_SA(0, 0), cA, voffA); PG8_STAGE(PG8_SA(0, 1), cA + hstep, voffA);
        if (wr == 1) PG8_BAR;
        PG8_WAIT_V(2); PG8_BAR;
        PG8_STAGE(PG8_SB(1, 0), cB + kstep, voffB); PG8_STAGE(PG8_SA(1, 0), cA + kstep, voffA); PG8_STAGE(PG8_SB(1, 1), cB + hstep + kstep, voffB);
        PG8_WAIT_V(6); PG8_BAR;
    } else {
        PG8_STAGE(PG8_SB(0, 0), cB, voffB); PG8_STAGE(PG8_SA(0, 0), cA, voffA); PG8_STAGE(PG8_SB(0, 1), cB + hstep, voffB); PG8_STAGE(PG8_SA(0, 1), cA + hstep, voffA);
        if (wr == 1) PG8_BAR;
        PG8_WAIT_V(4); PG8_BAR;
        PG8_STAGE(PG8_SB(1, 0), cB + kstep, voffB); PG8_STAGE(PG8_SA(1, 0), cA + kstep, voffA); PG8_STAGE(PG8_SB(1, 1), cB + hstep + kstep, voffB);
        PG8_WAIT_V(6); PG8_BAR;
    }
    for (;;) {
        const bool has_next = S.next(ui + 1, nxt);
        const char* nA = has_next ? (const char*)g.A + (size_t)nxt.pm * tstep : cA; const char* nB = has_next ? (const char*)g.Bt + (size_t)nxt.pn * tstep : cB;
        for (int t = 0; t < nt; t += 2) {
            const bool last = (t == nt - 2);
            const char* a1 = cA + (size_t)(t + 1) * kstep;
            const char* a2 = last ? nA : cA + (size_t)(t + 2) * kstep; const char* b2 = last ? nB : cB + (size_t)(t + 2) * kstep;
            const char* a3 = a2 + kstep; const char* b3 = b2 + kstep;
            if (last && has_next) S.a_ready(nxt);
            if constexpr (SP2) {
            PG8_LDB(B0, 0, 0); PG8_LDB(B1, 0, 1); PG8_SCHED; PG8_LDA(At, 0, 0); PG8_STAGE(PG8_SA(1, 1), a1 + hstep, voffA);
            PG8_WAIT_V(8); PG8_WAIT_L(0); PG8_BAR; PG8_MMA(0, 0, At, B0); PG8_MMA(0, 1, At, B1); PG8_BAR; PG8_SCHED;
            PG8_LDA(At, 0, 1); PG8_STAGE(PG8_SB(0, 0), b2, voffB); PG8_STAGE(PG8_SB(0, 1), b2 + hstep, voffB); PG8_STAGE(PG8_SA(0, 0), a2, voffA);
            PG8_WAIT_V(8); PG8_WAIT_L(0); PG8_BAR; PG8_MMA(1, 0, At, B0); PG8_MMA(1, 1, At, B1); PG8_BAR; PG8_SCHED;
            PG8_LDB(B0, 1, 0); PG8_LDB(B1, 1, 1); PG8_SCHED; PG8_LDA(At, 1, 0); PG8_STAGE(PG8_SA(0, 1), a2 + hstep, voffA);
            PG8_WAIT_V(8); PG8_WAIT_L(0); PG8_BAR; PG8_MMA(0, 0, At, B0); PG8_MMA(0, 1, At, B1); PG8_BAR; PG8_SCHED;
            PG8_LDA(At, 1, 1); PG8_STAGE(PG8_SB(1, 0), b3, voffB); PG8_STAGE(PG8_SB(1, 1), b3 + hstep, voffB); PG8_STAGE(PG8_SA(1, 0), a3, voffA);
            PG8_WAIT_V(8); PG8_WAIT_L(0); PG8_BAR; PG8_MMA(1, 0, At, B0); PG8_MMA(1, 1, At, B1); PG8_BAR; PG8_SCHED;
            } else {
            PG8_LDB(B0, 0, 0); PG8_SCHED; PG8_LDA(At, 0, 0); PG8_STAGE(PG8_SA(1, 1), a1 + hstep, voffA);
            PG8_WAIT_L(8); PG8_BAR; PG8_WAIT_L(0); PG8_MMA(0, 0, At, B0); PG8_BAR; PG8_SCHED;
            PG8_LDB(B1, 0, 1); PG8_STAGE(PG8_SB(0, 0), b2, voffB);
            PG8_BAR; PG8_WAIT_L(0); PG8_MMA(0, 1, At, B1); PG8_BAR;
            PG8_LDA(At, 0, 1); PG8_STAGE(PG8_SA(0, 0), a2, voffA);
            PG8_BAR; PG8_WAIT_L(0); PG8_MMA(1, 0, At, B0); PG8_BAR; PG8_SCHED;
            PG8_STAGE(PG8_SB(0, 1), b2 + hstep, voffB);
            PG8_WAIT_V(6); PG8_BAR; PG8_MMA(1, 1, At, B1); PG8_BAR;
            PG8_LDB(B0, 1, 0); PG8_SCHED; PG8_LDA(At, 1, 0); PG8_STAGE(PG8_SA(0, 1), a2 + hstep, voffA);
            PG8_WAIT_L(8); PG8_BAR; PG8_WAIT_L(0); PG8_MMA(0, 0, At, B0); PG8_BAR; PG8_SCHED;
            PG8_LDB(B1, 1, 1); PG8_STAGE(PG8_SB(1, 0), b3, voffB);
            PG8_BAR; PG8_WAIT_L(0); PG8_MMA(0, 1, At, B1); PG8_BAR;
            PG8_LDA(At, 1, 1); PG8_STAGE(PG8_SA(1, 0), a3, voffA);
            PG8_BAR; PG8_WAIT_L(0); PG8_MMA(1, 0, At, B0); PG8_BAR; PG8_SCHED;
            PG8_STAGE(PG8_SB(1, 1), b3 + hstep, voffB);
            PG8_WAIT_V(6); PG8_BAR; PG8_MMA(1, 1, At, B1); PG8_BAR;
            }
        }
        if constexpr (ALIGN_EPI) { if (wr == 0) PG8_BAR; }
        if constexpr (!Epi::AFTER_DRAIN) { E(acc, cur, wr, wc, fr, fq); S.done(cur); }
        if (!has_next) break;
#pragma unroll
        for (int a = 0; a < 2; ++a)
#pragma unroll
            for (int b = 0; b < 2; ++b)
#pragma unroll
                for (int m = 0; m < 4; ++m)
#pragma unroll
                    for (int n = 0; n < 2; ++n) acc[a][b][m][n] = (f32x4){0.f, 0.f, 0.f, 0.f};
        cur = nxt; cA = nA; cB = nB; ++ui;
        if constexpr (ALIGN_EPI) { if (wr == 1) PG8_BAR; }
    }
    PG8_WAIT_V(0);
    if constexpr (!ALIGN_EPI) { if (wr == 0) PG8_BAR; }
    PG8_BAR;
    if constexpr (Epi::AFTER_DRAIN) { E.fused(acc, cur, wr, wc, fr, fq, lds, wid, lane); S.done(cur); }
#undef PG8_SA
#undef PG8_SB
#undef PG8_STAGE
#undef PG8_LDA
#undef PG8_LDB
#undef PG8_MMA
#undef PG8_WAIT_V
#undef PG8_WAIT_L
#undef PG8_BAR
#undef PG8_SCHED
}
}

constexpr int NWAVES = 8, NTHR = 512;
constexpr int BATCH = 32, SEQ = 2048, DM = 1024, DEPTH = 2, MTOK = BATCH * SEQ;
constexpr int NIN = 3230, NINP = 3328, DFF = 2816, NGU = 2 * DFF;
constexpr int PC_QKV = 0, PC_Z = 1152, PC_CF = 1536, PC_NQ = 2048, PC_KC = 2432, PC_VC = 2560, PC_KS = 2688, PC_VS = 2816, PC_KW = 2944, PC_VW = 3072, PC_B = 3200, PC_A = 3206, PC_GATE = 3212;
constexpr float EPS = 1e-6f;
constexpr int CMP_ROWS = 16384, CMP_K = 2048;
constexpr int NPH = 10;

constexpr size_t MiB = 1u << 20;
constexpr size_t WS_CTL = 0, CTL_ZERO_BYTES = 1 * MiB;
constexpr size_t WS_WIN = 2 * MiB;
constexpr size_t WS_WOUT = 16 * MiB;
constexpr size_t WS_WGU = 20 * MiB;
constexpr size_t WS_WD = 42 * MiB;
constexpr size_t WS_WC1 = 53 * MiB;
constexpr size_t WS_W2T = 55 * MiB;
constexpr size_t WS_KC = 56 * MiB;
constexpr size_t WS_VCT = 57 * MiB;
constexpr size_t WS_PROJ = 64 * MiB;
constexpr size_t WS_MIX = 480 * MiB;
constexpr size_t WS_MBUF = 608 * MiB;
constexpr size_t WS_XB = 736 * MiB;
constexpr size_t WS_ACMP = 864 * MiB;
constexpr size_t WS_HID = 928 * MiB;
constexpr size_t WS_KS = 936 * MiB, WS_KW = 952 * MiB, WS_VST = 968 * MiB, WS_VWT = 984 * MiB;
constexpr size_t WS_DNF = WS_MBUF;
constexpr size_t WS_GT = 1000 * MiB;
constexpr size_t WS_RSTD = 1001 * MiB;
constexpr size_t WS_END = 1002 * MiB;
constexpr int CW_TMO = 0, CW_BAR = 4096;

constexpr int RING_OFF = 0, RING_BYTES = 131072, XTRA_OFF = 147456;
constexpr int LDSCTL_OFF = RING_BYTES, MISC_OFF = LDSCTL_OFF + 320;
constexpr int LDS_BYTES = 163840;

#define GAS __attribute__((address_space(1)))
#define LAS __attribute__((address_space(3)))
typedef unsigned short bf16;
typedef unsigned v4u __attribute__((ext_vector_type(4)));
typedef unsigned v2u __attribute__((ext_vector_type(2)));
typedef float f32x4 __attribute__((ext_vector_type(4)));
typedef float f32x2 __attribute__((ext_vector_type(2)));
typedef short bf16x8 __attribute__((ext_vector_type(8)));
struct Args;
typedef __bf16 bf16x2_t __attribute__((ext_vector_type(2)));
#define LDS_WAIT() asm volatile("s_waitcnt lgkmcnt(0)" ::: "memory")
#define VM_WAIT() asm volatile("s_waitcnt vmcnt(0)" ::: "memory")
__device__ __forceinline__ unsigned cvtpk(float lo, float hi) { f32x2 v = {lo, hi}; bf16x2_t b = __builtin_convertvector(v, bf16x2_t); return __builtin_bit_cast(unsigned, b); }
__device__ __forceinline__ bf16 f2bf(float f) { return (bf16)(cvtpk(f, 0.f) & 0xffffu); }
__device__ __forceinline__ float bf2f(bf16 v) { return __uint_as_float(((unsigned)v) << 16); }
__device__ __forceinline__ float bflo(unsigned w) { return __uint_as_float(w << 16); }
__device__ __forceinline__ float bfhi(unsigned w) { return __uint_as_float(w & 0xffff0000u); }
__device__ __forceinline__ float sigmoid_f(float v) { return __builtin_amdgcn_rcpf(1.0f + __builtin_amdgcn_exp2f(-1.4426950408889634f * v)); }
__device__ __forceinline__ float silu_f(float v) { return v * sigmoid_f(v); }
__device__ __forceinline__ float wave_sum(float v) {
#pragma unroll
    for (int o = 1; o < 64; o <<= 1) v += __shfl_xor(v, o);
    return v;
}

#define XB_TMO      128
#define XB_XCNT(j)  (256  + 64 * (j))
#define XB_XSUB(j)  (1280 + 64 * (j))
#define XB_XGEN(j)  (2304 + 64 * (j))
#define XB_TOP      3328
#define XB_TOPGEN   3392
#define XCD_BAR_WORDS 3456
#define XB_SPIN_CAP (1u << 18)
__device__ __forceinline__ unsigned xb_ld(unsigned* p)              { return __hip_atomic_load(p, __ATOMIC_RELAXED, __HIP_MEMORY_SCOPE_AGENT); }
__device__ __forceinline__ unsigned xb_add(unsigned* p, unsigned v) { return __hip_atomic_fetch_add(p, v, __ATOMIC_RELAXED, __HIP_MEMORY_SCOPE_AGENT); }
__device__ __forceinline__ unsigned xb_xcc_id() { return (unsigned)__builtin_amdgcn_s_getreg((3 << 11) | 20) & 0xFu; }
#define XB_SPIN(cond, bar) do { unsigned _sp = 0; while (cond) { __builtin_amdgcn_s_sleep(1); \
    if ((++_sp & 255u) == 0u) { if (xb_ld(&(bar)[XB_TMO])) break; if (_sp > XB_SPIN_CAP) { atomicAdd(&(bar)[XB_TMO], 1u); break; } } } } while (0)
struct XcdBarrier { unsigned* bar; unsigned x; volatile LAS unsigned* st; };
__device__ __forceinline__ XcdBarrier xcd_barrier_post(unsigned* bar, volatile LAS unsigned* st) {
    XcdBarrier b; b.bar = bar; b.x = xb_xcc_id(); b.st = st;
    if (threadIdx.x == 0) (void)xb_add(&bar[XB_XCNT(b.x)], 1u);
    return b;
}
__device__ __forceinline__ void xcd_barrier_complete(unsigned* bar, unsigned x, unsigned& nloc, unsigned& nx) {
    const unsigned G = gridDim.x * gridDim.y * gridDim.z;
    unsigned sum, cnt, mine, sp = 0u;
    for (;;) {
        sum = 0u; cnt = 0u; mine = 0u;
#pragma unroll
        for (unsigned j = 0; j < 16; ++j) { const unsigned c = xb_ld(&bar[XB_XCNT(j)]); sum += c; cnt += (c > 0u) ? 1u : 0u; mine = (j == x) ? c : mine; }
        if (sum == G) break;
        __builtin_amdgcn_s_sleep(1);
        if ((++sp & 255u) == 0u) { if (xb_ld(&bar[XB_TMO])) break; if (sp > XB_SPIN_CAP) { atomicAdd(&bar[XB_TMO], 1u); break; } }
    }
    nloc = mine > 0u ? mine : 1u; nx = cnt > 0u ? cnt : 1u;
}
__device__ __forceinline__ void xcd_barrier(const XcdBarrier& b) {
    asm volatile("s_waitcnt vmcnt(0)" ::: "memory");
    __syncthreads();
    if (threadIdx.x == 0) {
        unsigned* bar = b.bar;
        __builtin_amdgcn_s_waitcnt(0);
        unsigned nloc = b.st[0], nx = b.st[1];
        if (nloc == 0u) { xcd_barrier_complete(bar, b.x, nloc, nx); b.st[0] = nloc; b.st[1] = nx; }
        const unsigned old = xb_add(&bar[XB_XSUB(b.x)], 1u);
        const unsigned gen = old / nloc;
        if (old + 1u == (gen + 1u) * nloc) {
            __builtin_amdgcn_fence(__ATOMIC_RELEASE, "agent");
            asm volatile("s_waitcnt vmcnt(0)" ::: "memory");
            const unsigned og = xb_add(&bar[XB_TOP], 1u);
            const unsigned tg = og / nx;
            if (og + 1u == (tg + 1u) * nx) xb_add(&bar[XB_TOPGEN], 1u);
            else XB_SPIN(xb_ld(&bar[XB_TOPGEN]) == tg, bar);
            __builtin_amdgcn_fence(__ATOMIC_ACQUIRE, "agent");
            xb_add(&bar[XB_XGEN(b.x)], 1u);
            asm volatile("s_waitcnt vmcnt(0)" ::: "memory");
        } else {
            XB_SPIN(xb_ld(&bar[XB_XGEN(b.x)]) == gen, bar);
            __builtin_amdgcn_fence(__ATOMIC_ACQUIRE, "agent");
            asm volatile("s_waitcnt vmcnt(0)" ::: "memory");
        }
    }
    __syncthreads();
}

template <class SrcFn>
__device__ __forceinline__ void wprep_item(const SrcFn& src, int K, bf16* WT, LAS float* scr, int item, int nblk, int lane) {
    const int kb = item / nblk, nb = item % nblk, k0 = 64 * kb, n0 = 32 * nb;
#pragma unroll 8
    for (int i = 0; i < 32; ++i) { const int kk = 2 * i + (lane >> 5); scr[kk * 33 + (lane & 31)] = src(k0 + kk, n0 + (lane & 31)); }
    LDS_WAIT(); asm volatile("" ::: "memory");
    const int c = lane & 7;
#pragma unroll
    for (int j = 0; j < 4; ++j) { const int n = (lane >> 3) + 8 * j; const LAS float* s = scr + (8 * c) * 33 + n;
        v4u o; o.x = cvtpk(s[0 * 33], s[1 * 33]); o.y = cvtpk(s[2 * 33], s[3 * 33]); o.z = cvtpk(s[4 * 33], s[5 * 33]); o.w = cvtpk(s[6 * 33], s[7 * 33]);
        *(v4u*)(WT + (size_t)(n0 + n) * K + k0 + 8 * c) = o; }
    LDS_WAIT(); asm volatile("" ::: "memory");
}
__device__ __forceinline__ int win_src_col(int n) {
    return n < 1536 ? n : (n < 3200 ? n + 12 : (n < 3212 ? n - 3200 + 1536 : (n < NIN ? n : -1)));
}
__device__ __forceinline__ void x_row_to_bf16(const float* xrow, bf16* orow, float* rstd, int lane) {
    const f32x4* xr = (const f32x4*)xrow + lane;
    f32x4 v[4]; float s = 0.f;
#pragma unroll
    for (int j = 0; j < 4; ++j) { v[j] = xr[64 * j]; s += (v[j].x * v[j].x + v[j].y * v[j].y) + (v[j].z * v[j].z + v[j].w * v[j].w); }
    const float r = rsqrtf(wave_sum(s) * (1.f / DM) + EPS);
    if (lane == 0) *rstd = r;
    v2u* o8 = (v2u*)orow + lane;
#pragma unroll
    for (int j = 0; j < 4; ++j) { v2u w; w.x = cvtpk(v[j].x, v[j].y); w.y = cvtpk(v[j].z, v[j].w); o8[64 * j] = w; }
}
template <bool XIN_F32, bool FINAL>
__device__ __forceinline__ void resid_row2(const void* xrowA, const void* xrowB, const bf16* mrowA, const bf16* mrowB, const float* wpost, void* orowA, void* orowB, float* rstdA, float* rstdB, int lane) {
    const f32x4* wr = (const f32x4*)wpost + lane;
    f32x4 xa[4], xb[4], ma[4], mb[4]; float sa = 0.f, sb = 0.f;
#pragma unroll
    for (int j = 0; j < 4; ++j) {
        if (XIN_F32) { xa[j] = ((const f32x4*)xrowA + lane)[64 * j]; xb[j] = ((const f32x4*)xrowB + lane)[64 * j]; }
        else { const v2u wa = ((const v2u*)xrowA + lane)[64 * j], wb = ((const v2u*)xrowB + lane)[64 * j];
            xa[j] = (f32x4){bflo(wa.x), bfhi(wa.x), bflo(wa.y), bfhi(wa.y)}; xb[j] = (f32x4){bflo(wb.x), bfhi(wb.x), bflo(wb.y), bfhi(wb.y)}; }
        const v2u wa = ((const v2u*)mrowA + lane)[64 * j], wb = ((const v2u*)mrowB + lane)[64 * j];
        ma[j] = (f32x4){bflo(wa.x), bfhi(wa.x), bflo(wa.y), bfhi(wa.y)}; mb[j] = (f32x4){bflo(wb.x), bfhi(wb.x), bflo(wb.y), bfhi(wb.y)};
        sa += (ma[j].x * ma[j].x + ma[j].y * ma[j].y) + (ma[j].z * ma[j].z + ma[j].w * ma[j].w); sb += (mb[j].x * mb[j].x + mb[j].y * mb[j].y) + (mb[j].z * mb[j].z + mb[j].w * mb[j].w); }
#pragma unroll
    for (int o = 1; o < 64; o <<= 1) { sa += __shfl_xor(sa, o); sb += __shfl_xor(sb, o); }
    const float ra = rsqrtf(sa * (1.f / DM) + EPS), rb = rsqrtf(sb * (1.f / DM) + EPS);
    float s2a = 0.f, s2b = 0.f;
#pragma unroll
    for (int j = 0; j < 4; ++j) { const f32x4 w = wr[64 * j]; xa[j] = xa[j] + ma[j] * ra * w; xb[j] = xb[j] + mb[j] * rb * w;
        s2a += (xa[j].x * xa[j].x + xa[j].y * xa[j].y) + (xa[j].z * xa[j].z + xa[j].w * xa[j].w); s2b += (xb[j].x * xb[j].x + xb[j].y * xb[j].y) + (xb[j].z * xb[j].z + xb[j].w * xb[j].w); }
    if (FINAL) { f32x4* oa = (f32x4*)orowA + lane; f32x4* ob = (f32x4*)orowB + lane;
#pragma unroll
        for (int j = 0; j < 4; ++j) { oa[64 * j] = xa[j]; ob[64 * j] = xb[j]; }
    } else {
#pragma unroll
        for (int o = 1; o < 64; o <<= 1) { s2a += __shfl_xor(s2a, o); s2b += __shfl_xor(s2b, o); }
        if (lane == 0) { *rstdA = rsqrtf(s2a * (1.f / DM) + EPS); *rstdB = rsqrtf(s2b * (1.f / DM) + EPS); }
        v2u* oa = (v2u*)orowA + lane; v2u* ob = (v2u*)orowB + lane;
#pragma unroll
        for (int j = 0; j < 4; ++j) { v2u w; w.x = cvtpk(xa[j].x, xa[j].y); w.y = cvtpk(xa[j].z, xa[j].w); oa[64 * j] = w; w.x = cvtpk(xb[j].x, xb[j].y); w.y = cvtpk(xb[j].z, xb[j].w); ob[64 * j] = w; } }
}

#define MFMA16(a, b, c) __builtin_amdgcn_mfma_f32_16x16x32_bf16((a), (b), (c), 0, 0, 0)
__device__ __forceinline__ bf16x8 pack8(const f32x4& a, const f32x4& b) {
    v4u w; w.x = cvtpk(a[0], a[1]); w.y = cvtpk(a[2], a[3]); w.z = cvtpk(b[0], b[1]); w.w = cvtpk(b[2], b[3]); return __builtin_bit_cast(bf16x8, w);
}
constexpr float NSA_SC = 0.125f * 1.4426950408889634f;
__device__ __forceinline__ void nsa_load(const bf16* __restrict__ kbase, const bf16* __restrict__ vtbase, int vt_ld, int key0, bf16x8 (&ka)[2][2], bf16x8 (&va)[4], int c, int gq) {
#pragma unroll
    for (int sub = 0; sub < 2; ++sub)
#pragma unroll
        for (int s = 0; s < 2; ++s) ka[sub][s] = *(const bf16x8*)(kbase + (size_t)(key0 + 16 * sub + c) * 64 + 32 * s + 8 * gq);
#pragma unroll
    for (int dt = 0; dt < 4; ++dt) va[dt] = *(const bf16x8*)(vtbase + (size_t)(16 * dt + c) * vt_ld + key0 + 8 * gq);
}
template <int MODE>
__device__ __forceinline__ void nsa_step(const bf16x8 (&ka)[2][2], const bf16x8 (&va)[4], int key0, int tq, bool selbit, bool masked  ,
                                         const LAS bf16x8* ql, float (&mrun)[3], float (&lrun)[3], f32x4 (&O)[3][4], int gq) {
    const int kA = key0 + 4 * gq;
#pragma unroll
    for (int h = 0; h < 3; ++h) {
        const bf16x8 q0 = ql[64 * (2 * h)], q1 = ql[64 * (2 * h + 1)];
        f32x4 sA = {0.f, 0.f, 0.f, 0.f}, sB = {0.f, 0.f, 0.f, 0.f};
        sA = MFMA16(ka[0][0], q0, sA); sA = MFMA16(ka[0][1], q1, sA);
        sB = MFMA16(ka[1][0], q0, sB); sB = MFMA16(ka[1][1], q1, sB);
        float v[8];
#pragma unroll
        for (int r = 0; r < 4; ++r) { v[r] = sA[r]; v[4 + r] = sB[r]; }
        if (masked) {
#pragma unroll
            for (int r = 0; r < 4; ++r) { const int k1 = kA + r, k2 = kA + 16 + r;
                const bool ok1 = (MODE == 0) ? (k1 <= tq && k1 > tq - 512) : (selbit && k1 <= tq);
                const bool ok2 = (MODE == 0) ? (k2 <= tq && k2 > tq - 512) : (selbit && k2 <= tq);
                v[r] = ok1 ? v[r] : -1e30f; v[4 + r] = ok2 ? v[4 + r] : -1e30f; } }
        const float lm = fmaxf(fmaxf(fmaxf(v[0], v[1]), fmaxf(v[2], v[3])), fmaxf(fmaxf(v[4], v[5]), fmaxf(v[6], v[7])));
        if (__any(lm > mrun[h] + 8.0f)) {
            float mx = fmaxf(lm, __shfl_xor(lm, 16)); mx = fmaxf(mx, __shfl_xor(mx, 32));
            const float mnew = fmaxf(mrun[h], mx); const float alpha = __builtin_amdgcn_exp2f(mrun[h] - mnew); mrun[h] = mnew; lrun[h] *= alpha;
#pragma unroll
            for (int dt = 0; dt < 4; ++dt) O[h][dt] = O[h][dt] * alpha; }
        const float mh = mrun[h];
        float p[8]; float ps = 0.f;
#pragma unroll
        for (int i = 0; i < 8; ++i) { p[i] = __builtin_amdgcn_exp2f(v[i] - mh); ps += p[i]; }
        lrun[h] += ps;
        const bf16x8 pf = pack8((f32x4){p[0], p[1], p[2], p[3]}, (f32x4){p[4], p[5], p[6], p[7]});
#pragma unroll
        for (int dt = 0; dt < 4; ++dt) O[h][dt] = MFMA16(va[dt], pf, O[h][dt]);
    }
}
#define LDS_BAR() do { asm volatile("s_waitcnt lgkmcnt(0)" ::: "memory"); __builtin_amdgcn_s_barrier(); asm volatile("" ::: "memory"); } while (0)
constexpr int NSA_WSTRIDE = 12288, NSA_VCT = 98304, NSA_KC = 133120;
static_assert(8 * NSA_WSTRIDE <= NSA_VCT && NSA_VCT + 64 * 272 <= 131072 && NSA_KC >= LDSCTL_OFF + 2048 && NSA_KC + 128 * 144 <= LDS_BYTES, "NSA LDS map");
constexpr int NSA_SLOT0 = 115712, NSA_SLOT1 = 151552, NSA_HMX = LDSCTL_OFF + 1024;
static_assert(NSA_SLOT0 + 9728 <= 131072 && NSA_SLOT1 >= NSA_KC + 128 * 144 && NSA_SLOT1 + 9728 <= LDS_BYTES, "NSA tile ring");
template <int MODE>
__device__ __forceinline__ void nsa_coop_loop(LAS unsigned char* lds, const bf16* __restrict__ kbase, const bf16* __restrict__ vtbase, int klo, int ntile, unsigned long long hm_blk, unsigned long long hm_wave,
                                              int t0, int tq, unsigned selmask, const LAS bf16x8* ql, float (&mrun)[3], float (&lrun)[3], f32x4 (&O)[3][4], int tid, int c, int gq) {
    const bool isk = tid < 256; const int t2 = tid & 255;
    const bf16* tbase = isk ? kbase + (t2 >> 3) * 64 + (t2 & 7) * 8 : vtbase + (size_t)(t2 >> 2) * SEQ + (t2 & 3) * 8;
    const int kmul = isk ? 64 : 1;
    const int ldst = isk ? (t2 >> 3) * 144 + (t2 & 7) * 16 : 4608 + (t2 >> 2) * 80 + (t2 & 3) * 16;
    int keyP = klo; unsigned long long hmP = hm_blk, hmC = hm_blk;
#define NSA_NEXTP(dst) do { int k_; if (MODE == 0) { k_ = keyP; keyP += 32; } else { k_ = 32 * __builtin_ctzll(hmP); hmP &= hmP - 1ull; } dst = *(const v4u*)(tbase + (size_t)k_ * kmul); } while (0)
#define NSA_COMMIT(src, slot) (*(LAS v4u*)(lds + (slot) + ldst) = (src))
#define NSA_COMPUTE(slot, sidx) do { int key0_; if (MODE == 0) key0_ = klo + 32 * (sidx); else { key0_ = 32 * __builtin_ctzll(hmC); hmC &= hmC - 1ull; } \
        const bool rel_ = (MODE == 0) ? (key0_ <= t0 + 15 && key0_ + 31 >= t0 - 511) : (bool)((hm_wave >> (key0_ >> 5)) & 1ull); \
        if (rel_) { bf16x8 ka_[2][2], va_[4]; \
            _Pragma("unroll") for (int sub_ = 0; sub_ < 2; ++sub_) _Pragma("unroll") for (int s_ = 0; s_ < 2; ++s_) ka_[sub_][s_] = *(const LAS bf16x8*)(lds + (slot) + (16 * sub_ + c) * 144 + 64 * s_ + 16 * gq); \
            _Pragma("unroll") for (int dt_ = 0; dt_ < 4; ++dt_) va_[dt_] = *(const LAS bf16x8*)(lds + (slot) + 4608 + (16 * dt_ + c) * 80 + 16 * gq); \
            if (MODE == 0) nsa_step<0>(ka_, va_, key0_, tq, true, !(key0_ + 31 <= t0 && key0_ > t0 + 15 - 512), ql, mrun, lrun, O, gq); \
            else { const bool sb_ = (selmask >> (key0_ >> 6)) & 1u; nsa_step<1>(ka_, va_, key0_, tq, sb_, !(key0_ + 31 <= t0 && __all(sb_)), ql, mrun, lrun, O, gq); } } } while (0)
    v4u R0 = {0u, 0u, 0u, 0u}, R1 = R0;
    if (ntile > 0) { NSA_NEXTP(R0); NSA_COMMIT(R0, NSA_SLOT0); }
    if (ntile > 1) NSA_NEXTP(R0);
    if (ntile > 2) NSA_NEXTP(R1);
    LDS_BAR();
    for (int s = 0; s < ntile; s += 2) {
        if (s + 1 < ntile) NSA_COMMIT(R0, NSA_SLOT1);
        if (s + 3 < ntile) NSA_NEXTP(R0);
        NSA_COMPUTE(NSA_SLOT0, s);
        LDS_BAR();
        if (s + 1 >= ntile) break;
        if (s + 2 < ntile) NSA_COMMIT(R1, NSA_SLOT0);
        if (s + 4 < ntile) NSA_NEXTP(R1);
        NSA_COMPUTE(NSA_SLOT1, s + 1);
        LDS_BAR();
    }
#undef NSA_NEXTP
#undef NSA_COMMIT
#undef NSA_COMPUTE
}
struct NsaPtrs { const bf16* proj; const bf16* kc; const bf16* vct; const bf16* ks; const bf16* vst; const bf16* kw; const bf16* vwt; bf16* mix; };
__device__ __forceinline__ void nsa_stage_cmp(LAS unsigned char* lds, const NsaPtrs& P, int b, int g, int tid) {
    const bf16* kc = P.kc + (size_t)(b * 2 + g) * 128 * 64; const bf16* vct = P.vct + (size_t)(b * 2 + g) * 64 * 128;
#pragma unroll
    for (int q = 0; q < 2; ++q) { const int e = tid + NTHR * q;
        *(LAS v4u*)(lds + NSA_KC + (e >> 3) * 144 + (e & 7) * 16) = *(const v4u*)(kc + (e >> 3) * 64 + (e & 7) * 8);
        *(LAS v4u*)(lds + NSA_VCT + (e >> 4) * 272 + (e & 15) * 16) = *(const v4u*)(vct + (e >> 4) * 128 + (e & 15) * 8); }
}
__device__ __forceinline__ void nsa_item(const NsaPtrs& P, LAS unsigned char* lds, int wave, int b, int g, int t0, int tid, int lane) {
    asm volatile("" : "+v"(lane));
    const int c = lane & 15, gq = lane >> 4;
    const int tq = t0 + c, cur = t0 >> 6;
    const bf16* prow = P.proj + ((size_t)b * SEQ + tq) * NINP;
    LAS v2u* outl = (LAS v2u*)(lds + wave * NSA_WSTRIDE) + lane;
    LAS bf16x8* ql = (LAS bf16x8*)(lds + wave * NSA_WSTRIDE + 6144) + lane;
    unsigned graw[9];
    {
        v4u qr[6];
#pragma unroll
        for (int f = 0; f < 6; ++f) qr[f] = *(const v4u*)(prow + PC_NQ + (g * 3 + (f >> 1)) * 64 + 32 * (f & 1) + 8 * gq);
#pragma unroll
        for (int k = 0; k < 9; ++k) graw[k] = prow[PC_GATE + (k / 3) * 6 + g * 3 + (k % 3)];
#pragma unroll
        for (int f = 0; f < 6; ++f) { v4u qs; qs.x = cvtpk(bflo(qr[f].x) * NSA_SC, bfhi(qr[f].x) * NSA_SC); qs.y = cvtpk(bflo(qr[f].y) * NSA_SC, bfhi(qr[f].y) * NSA_SC);
            qs.z = cvtpk(bflo(qr[f].z) * NSA_SC, bfhi(qr[f].z) * NSA_SC); qs.w = cvtpk(bflo(qr[f].w) * NSA_SC, bfhi(qr[f].w) * NSA_SC);
            ql[64 * f] = __builtin_bit_cast(bf16x8, qs); }
    }
#define NSA_GATE(br, h) sigmoid_f(bf2f((bf16)graw[(br) * 3 + (h)]))
    asm volatile("" ::: "memory");
    float imp[8]; unsigned selmask = 0u;
    REP(31) {
#pragma unroll
    for (int st = 0; st < 8; ++st) imp[st] = 0.f;
    selmask = 0u;
    const int nvis = tq >= 31 ? ((tq - 31) >> 4) + 1 : 0;
#pragma unroll 1
    for (int h = 0; h < 3; ++h) {
        asm volatile("" ::: "memory");
        const bf16x8 qh0 = ql[64 * (2 * h)], qh1 = ql[64 * (2 * h + 1)];
        f32x4 s[8];
#pragma unroll
        for (int st = 0; st < 8; ++st) { const LAS unsigned char* kr = lds + NSA_KC + (16 * st + c) * 144 + 16 * gq;
            const bf16x8 a0 = *(const LAS bf16x8*)kr, a1 = *(const LAS bf16x8*)(kr + 64);
            f32x4 z = {0.f, 0.f, 0.f, 0.f}; z = MFMA16(a0, qh0, z); z = MFMA16(a1, qh1, z); s[st] = z; }
        float mx = -1e30f;
#pragma unroll
        for (int st = 0; st < 8; ++st)
#pragma unroll
            for (int r = 0; r < 4; ++r) { const int i = 16 * st + 4 * gq + r; const float v = (i < nvis) ? s[st][r] : -1e30f; s[st][r] = v; mx = fmaxf(mx, v); }
        mx = fmaxf(mx, __shfl_xor(mx, 16)); mx = fmaxf(mx, __shfl_xor(mx, 32)); mx = fmaxf(mx, -1e20f);
        float sum = 0.f;
#pragma unroll
        for (int st = 0; st < 8; ++st)
#pragma unroll
            for (int r = 0; r < 4; ++r) { const float p = __builtin_amdgcn_exp2f(s[st][r] - mx); s[st][r] = p; sum += p; }
        sum += __shfl_xor(sum, 16); sum += __shfl_xor(sum, 32);
        const float inv = sum > 0.f ? __builtin_amdgcn_rcpf(sum) : 0.f;
#pragma unroll
        for (int st = 0; st < 8; ++st) s[st] = s[st] * inv;
        float sh[8];
#pragma unroll
        for (int st = 0; st < 8; ++st) sh[st] = __shfl(s[st][3], (lane + 48) & 63);
#pragma unroll
        for (int st = 0; st < 8; ++st) { const float prev = gq > 0 ? sh[st] : (st > 0 ? sh[st > 0 ? st - 1 : 0] : 0.f);
            imp[st] += (s[st][0] + s[st][1]) + (s[st][2] + s[st][3]) + prev; }
        f32x4 Oc[4];
#pragma unroll
        for (int dt = 0; dt < 4; ++dt) Oc[dt] = (f32x4){0.f, 0.f, 0.f, 0.f};
#pragma unroll
        for (int ks = 0; ks < 4; ++ks) { const bf16x8 pf = pack8(s[2 * ks], s[2 * ks + 1]);
#pragma unroll
            for (int dt = 0; dt < 4; ++dt) { const bf16x8 vf = *(const LAS bf16x8*)(lds + NSA_VCT + (16 * dt + c) * 272 + 64 * ks + 16 * gq); Oc[dt] = MFMA16(vf, pf, Oc[dt]); } }
        { const float gt = sigmoid_f(bf2f((bf16)(h == 0 ? graw[0] : (h == 1 ? graw[1] : graw[2]))));
#pragma unroll
            for (int dt = 0; dt < 4; ++dt) { const f32x4 o = Oc[dt] * gt; v2u w; w.x = cvtpk(o[0], o[1]); w.y = cvtpk(o[2], o[3]); outl[64 * (4 * h + dt)] = w; } }
    }
    {
        unsigned key[8];
#pragma unroll
        for (int st = 0; st < 8; ++st) { const int j = 4 * st + gq; const bool elig = j <= cur, forced = (j == 0) || (j == cur) || (j == cur - 1);
            const float sc = elig ? (imp[st] + (forced ? 1e4f : 0.f)) : -1e4f; const unsigned u = __float_as_uint(sc);
            key[st] = (((u & 0x80000000u) ? ~u : (u | 0x80000000u)) & ~31u) | (unsigned)(31 - j); }
#pragma unroll
        for (int it = 0; it < 8; ++it) {
            unsigned bk = key[0];
#pragma unroll
            for (int st = 1; st < 8; ++st) bk = bk > key[st] ? bk : key[st];
            { const unsigned o = (unsigned)__shfl_xor((int)bk, 16); bk = bk > o ? bk : o; }
            { const unsigned o = (unsigned)__shfl_xor((int)bk, 32); bk = bk > o ? bk : o; }
            const int bj = 31 - (int)(bk & 31u);
            selmask |= 1u << bj;
#pragma unroll
            for (int st = 0; st < 8; ++st) if (4 * st + gq == bj) key[st] = 0u;
        }
    }
    }
    float mrun[3], lrun[3]; f32x4 O[3][4];
    {
        const bf16* kw = P.kw + (size_t)(b * 2 + g) * SEQ * 64; const bf16* vwt = P.vwt + (size_t)(b * 2 + g) * 64 * SEQ;
        REP(32) {
#pragma unroll
        for (int h = 0; h < 3; ++h) { mrun[h] = -1e20f; lrun[h] = 0.f;
#pragma unroll
            for (int dt = 0; dt < 4; ++dt) O[h][dt] = (f32x4){0.f, 0.f, 0.f, 0.f}; }
        asm volatile("" ::: "memory");
        { const int T0 = t0 - 16 * wave; int klo = T0 - 511; klo = klo < 0 ? 0 : klo; klo &= ~31; const int klast = (T0 + 127) & ~31;
            nsa_coop_loop<0>(lds, kw, vwt, klo, (klast - klo) / 32 + 1, 0ull, 0ull, t0, tq, selmask, ql, mrun, lrun, O, tid, c, gq); }
        }
#pragma unroll
        for (int h = 0; h < 3; ++h) { float lt = lrun[h]; lt += __shfl_xor(lt, 16); lt += __shfl_xor(lt, 32); const float inv = lt > 0.f ? NSA_GATE(2, h) * __builtin_amdgcn_rcpf(lt) : 0.f;
#pragma unroll
            for (int dt = 0; dt < 4; ++dt) { const v2u w0 = outl[64 * (4 * h + dt)]; const f32x4 o = (f32x4){bflo(w0.x), bfhi(w0.x), bflo(w0.y), bfhi(w0.y)} + O[h][dt] * inv;
                v2u w; w.x = cvtpk(o[0], o[1]); w.y = cvtpk(o[2], o[3]); outl[64 * (4 * h + dt)] = w; } }
        asm volatile("" ::: "memory");
    }
    {
        const bf16* ks = P.ks + (size_t)(b * 2 + g) * SEQ * 64; const bf16* vst = P.vst + (size_t)(b * 2 + g) * 64 * SEQ;
        REP(33) {
#pragma unroll
        for (int h = 0; h < 3; ++h) { mrun[h] = -1e20f; lrun[h] = 0.f;
#pragma unroll
            for (int dt = 0; dt < 4; ++dt) O[h][dt] = (f32x4){0.f, 0.f, 0.f, 0.f}; }
        {
            unsigned um = selmask;
#pragma unroll
            for (int off = 1; off < 64; off <<= 1) um |= (unsigned)__shfl_xor((int)um, off);
            um = (unsigned)__builtin_amdgcn_readfirstlane((int)um) & ((2u << cur) - 1u);
            unsigned long long x = um;
            x = (x | (x << 16)) & 0x0000FFFF0000FFFFull; x = (x | (x << 8)) & 0x00FF00FF00FF00FFull; x = (x | (x << 4)) & 0x0F0F0F0F0F0F0F0Full;
            x = (x | (x << 2)) & 0x3333333333333333ull; x = (x | (x << 1)) & 0x5555555555555555ull;
            unsigned long long hm = x | (x << 1);
            if (64 * cur + 32 > t0 + 15) hm &= ~(1ull << (2 * cur + 1));
            LAS unsigned* hmx = (LAS unsigned*)(lds + NSA_HMX);
            if (lane == 0) { hmx[2 * wave] = (unsigned)hm; hmx[2 * wave + 1] = (unsigned)(hm >> 32); }
            LDS_BAR();
            unsigned lo_ = 0u, hi_ = 0u;
#pragma unroll
            for (int w8 = 0; w8 < 8; ++w8) { lo_ |= hmx[2 * w8]; hi_ |= hmx[2 * w8 + 1]; }
            const unsigned long long hmb = ((unsigned long long)(unsigned)__builtin_amdgcn_readfirstlane((int)hi_) << 32) | (unsigned)__builtin_amdgcn_readfirstlane((int)lo_);
            nsa_coop_loop<1>(lds, ks, vst, 0, __builtin_popcountll(hmb), hmb, hm, t0, tq, selmask, ql, mrun, lrun, O, tid, c, gq);
        }
        }
        asm volatile("" ::: "memory");
#pragma unroll
        for (int h = 0; h < 3; ++h) { float lt = lrun[h]; lt += __shfl_xor(lt, 16); lt += __shfl_xor(lt, 32); const float inv = lt > 0.f ? NSA_GATE(1, h) * __builtin_amdgcn_rcpf(lt) : 0.f;
            bf16* orow = P.mix + ((size_t)b * SEQ + tq) * DM + 640 + g * 192 + h * 64;
#pragma unroll
            for (int dt = 0; dt < 4; ++dt) { const v2u w0 = outl[64 * (4 * h + dt)]; const f32x4 o = (f32x4){bflo(w0.x), bfhi(w0.x), bflo(w0.y), bfhi(w0.y)} + O[h][dt] * inv;
                v2u w; w.x = cvtpk(o[0], o[1]); w.y = cvtpk(o[2], o[3]); *(v2u*)(orow + 16 * dt + 4 * gq) = w; } }
    }
#undef NSA_GATE
}

typedef short bf16x4 __attribute__((ext_vector_type(4)));
#define MFMA16K(a, b, c) __builtin_amdgcn_mfma_f32_16x16x16bf16_1k((a), (b), (c), 0, 0, 0)
__device__ __forceinline__ bf16x4 pack4(const f32x4& a) { v2u w; w.x = cvtpk(a[0], a[1]); w.y = cvtpk(a[2], a[3]); return __builtin_bit_cast(bf16x4, w); }
constexpr int DNF_UNIT = 40960;
constexpr int DL_RAWB = 26880, DL_RAW = 0, DL_QS = 2 * DL_RAWB, DL_KS = DL_QS + 9216, DL_KT = DL_KS + 9216, DL_WL = DL_KT + 9216, DL_AII = DL_WL + 9216, DL_TINV = DL_AII + 4096, DL_VEC = DL_TINV + 4096, DL_END = DL_VEC + 2048;
static_assert(DL_END <= 131072, "DeltaNet chunk LDS map");
struct DnPre { v4u raw[4]; unsigned gb, ga; };
struct DnUnitId { int b, h, n, valid; };
__device__ __forceinline__ DnUnitId dn_unit_id(int u) { DnUnitId r; r.valid = u < BATCH * 6 * 32; const int uu = r.valid ? u : 0; r.n = uu & 31; const int bh = uu >> 5; r.b = bh / 6; r.h = bh % 6; return r; }
__device__ __forceinline__ void dn_prefetch(DnPre& P, const bf16* __restrict__ PROJ, const DnUnitId id, int tid, int lane, int wave) {
#pragma unroll
    for (int q = 0; q < 4; ++q) { const int e = tid + NTHR * q, rr = e / 24, pc = e % 24, part = pc >> 3, d0 = (pc & 7) * 8, t = 64 * id.n - 3 + rr;
        v4u val = {0u, 0u, 0u, 0u};
        if (id.valid && e < 67 * 24 && t >= 0) val = *(const v4u*)(PROJ + ((size_t)id.b * SEQ + t) * NINP + part * 384 + id.h * 64 + d0);
        P.raw[q] = val; }
    P.gb = 0u; P.ga = 0u;
    if (wave == 1 && id.valid) { const bf16* pr = PROJ + ((size_t)id.b * SEQ + 64 * id.n + lane) * NINP; P.gb = pr[PC_B + id.h]; P.ga = pr[PC_A + id.h]; }
}
__device__ __forceinline__ void dn_commit_raw(const DnPre& P, LAS unsigned char* L, int par, int tid) {
#pragma unroll
    for (int q = 0; q < 4; ++q) { const int e = tid + NTHR * q, rr = e / 24, pc = e % 24, part = pc >> 3, d0 = (pc & 7) * 8;
        if (e < 67 * 24) *(LAS v4u*)(L + DL_RAW + par * DL_RAWB + rr * 400 + (part * 64 + d0) * 2) = P.raw[q]; }
}
__device__ __forceinline__ void dn_commit_gates(const DnPre& P, LAS unsigned char* L, int par, float Aexp, float dtb, float* __restrict__ gt_out, bool valid, int lane, int wave) {
    if (wave == 1) { LAS float* vbeta = (LAS float*)(L + DL_VEC + par * 1024);
        const float beta = sigmoid_f(bf2f((bf16)P.gb)); const float z = bf2f((bf16)P.ga) + dtb; const float sp = z > 20.f ? z : log1pf(__expf(z)); float gv = -Aexp * sp;
#pragma unroll
        for (int off = 1; off < 64; off <<= 1) { const float t = __shfl_up(gv, off); if (lane >= off) gv += t; }
        const float glast = __shfl(gv, 63);
        vbeta[lane] = beta; vbeta[64 + lane] = gv; vbeta[128 + lane] = __expf(gv); vbeta[192 + lane] = __expf(glast - gv);
        if (lane == 63 && valid) *gt_out = __expf(gv); }
}
template <int PAR>
__device__ __forceinline__ void dn_chunk_unit(LAS unsigned char* L, const bf16* __restrict__ PROJ, const float* __restrict__ cw, const float* __restrict__ alog, const float* __restrict__ dtbp,
                                              unsigned char* __restrict__ dnf_all, float* __restrict__ gt_all, int u, int u_next, int tid, int lane, int wave) {
    LAS bf16* RAWs = (LAS bf16*)(L + DL_RAW + PAR * DL_RAWB); LAS bf16* QS = (LAS bf16*)(L + DL_QS); LAS bf16* KS = (LAS bf16*)(L + DL_KS); LAS bf16* KT = (LAS bf16*)(L + DL_KT); LAS bf16* WL = (LAS bf16*)(L + DL_WL);
    LAS float* AII = (LAS float*)(L + DL_AII); LAS float* TINV = (LAS float*)(L + DL_TINV);
    LAS float* vbeta = (LAS float*)(L + DL_VEC + PAR * 1024); LAS float* vgam = vbeta + 64; LAS float* vegam = vgam + 64; LAS float* vedec = vegam + 64;
    asm volatile("" : "+v"(tid), "+v"(lane), "+s"(wave));
    const int col = lane & 15, g = lane >> 4;
    const DnUnitId id = dn_unit_id(u), idn = dn_unit_id(u_next);
    const int h = id.h;
    unsigned char* dnf = dnf_all + (size_t)u * DNF_UNIT;
    LDS_BAR();
    DnPre P; dn_prefetch(P, PROJ, idn, tid, lane, wave);
    f32x4 R[4]; bf16x8 AF1, AF2, AF3a, AF3b; const f32x4 z4 = {0.f, 0.f, 0.f, 0.f};
    REP(24) {
    {
        const int part = wave >> 2, cr = 16 * (wave & 3) + (lane >> 2), d0 = 16 * (lane & 3);
        float y[16];
#pragma unroll
        for (int e = 0; e < 16; ++e) y[e] = 0.f;
#pragma unroll
        for (int j = 0; j < 4; ++j) { const LAS bf16* xr = RAWs + (cr + j) * 200 + part * 64 + d0; const v4u xa = *(const LAS v4u*)xr, xb2 = *(const LAS v4u*)(xr + 8);
            const float* wj = cw + j * 1152 + part * 384 + h * 64 + d0;
            const f32x4 w0 = *(const f32x4*)wj, w1 = *(const f32x4*)(wj + 4), w2 = *(const f32x4*)(wj + 8), w3 = *(const f32x4*)(wj + 12);
            y[0] += w0[0] * bflo(xa.x); y[1] += w0[1] * bfhi(xa.x); y[2] += w0[2] * bflo(xa.y); y[3] += w0[3] * bfhi(xa.y);
            y[4] += w1[0] * bflo(xa.z); y[5] += w1[1] * bfhi(xa.z); y[6] += w1[2] * bflo(xa.w); y[7] += w1[3] * bfhi(xa.w);
            y[8] += w2[0] * bflo(xb2.x); y[9] += w2[1] * bfhi(xb2.x); y[10] += w2[2] * bflo(xb2.y); y[11] += w2[3] * bfhi(xb2.y);
            y[12] += w3[0] * bflo(xb2.z); y[13] += w3[1] * bfhi(xb2.z); y[14] += w3[2] * bflo(xb2.w); y[15] += w3[3] * bfhi(xb2.w); }
        float ss = 0.f;
#pragma unroll
        for (int e = 0; e < 16; ++e) { y[e] = silu_f(y[e]); ss += y[e] * y[e]; }
        ss += __shfl_xor(ss, 1); ss += __shfl_xor(ss, 2);
        const float sc = rsqrtf(ss + EPS) * (part == 0 ? 0.125f : 1.0f);
        v4u o0, o1;
        o0.x = cvtpk(y[0] * sc, y[1] * sc); o0.y = cvtpk(y[2] * sc, y[3] * sc); o0.z = cvtpk(y[4] * sc, y[5] * sc); o0.w = cvtpk(y[6] * sc, y[7] * sc);
        o1.x = cvtpk(y[8] * sc, y[9] * sc); o1.y = cvtpk(y[10] * sc, y[11] * sc); o1.z = cvtpk(y[12] * sc, y[13] * sc); o1.w = cvtpk(y[14] * sc, y[15] * sc);
        LAS bf16* dst = (part == 0 ? QS : KS) + cr * 72 + d0;
        *(LAS v4u*)dst = o0; *(LAS v4u*)(dst + 8) = o1;
        if (part == 1) {
            const unsigned ow[8] = {o0.x, o0.y, o0.z, o0.w, o1.x, o1.y, o1.z, o1.w};
#pragma unroll
            for (int e2 = 0; e2 < 8; ++e2) { KT[(d0 + 2 * e2) * 72 + cr] = (bf16)(ow[e2] & 0xffffu); KT[(d0 + 2 * e2 + 1) * 72 + cr] = (bf16)(ow[e2] >> 16); } }
    }
    if (wave < 4) { const int d = 16 * wave + col; float cwv[4];
#pragma unroll
        for (int j = 0; j < 4; ++j) cwv[j] = cw[j * 1152 + 768 + h * 64 + d];
#pragma unroll
        for (int i = 0; i < 4; ++i) { float x7[7];
#pragma unroll
            for (int m = 0; m < 7; ++m) x7[m] = bf2f(RAWs[(16 * i + 4 * g + m) * 200 + 128 + d]);
#pragma unroll
            for (int r = 0; r < 4; ++r) { const float yv = (cwv[0] * x7[r] + cwv[1] * x7[r + 1]) + (cwv[2] * x7[r + 2] + cwv[3] * x7[r + 3]); R[i][r] = silu_f(yv) * vbeta[16 * i + 4 * g + r]; } } }
    LDS_BAR();
    if (wave >= 4) { const int kd = 16 * (wave - 4) + col;
#pragma unroll
        for (int i = 0; i < 4; ++i)
#pragma unroll
            for (int r = 0; r < 4; ++r) { const int c = 16 * i + 4 * g + r; R[i][r] = bf2f(KS[c * 72 + kd]) * vbeta[c] * vegam[c]; } }
    bf16x8 KF[4][2];
#pragma unroll
    for (int ct = 0; ct < 4; ++ct)
#pragma unroll
        for (int s = 0; s < 2; ++s) KF[ct][s] = *(const LAS bf16x8*)(KS + (16 * ct + col) * 72 + 32 * s + 8 * g);
#define DN_TILE(dst, ctp, ct) do { f32x4 t_ = z4; t_ = MFMA16(KF[ctp][0], KF[ct][0], t_); t_ = MFMA16(KF[ctp][1], KF[ct][1], t_); \
        const float bc_ = -vbeta[16 * (ct) + col], gc_ = vgam[16 * (ct) + col]; const f32x4 gp_ = *(const LAS f32x4*)(vgam + 16 * (ctp) + 4 * g); \
        _Pragma("unroll") for (int r_ = 0; r_ < 4; ++r_) t_[r_] = t_[r_] * bc_ * __expf(gc_ - gp_[r_]); dst = t_; } while (0)
    { f32x4 t01, t02, t12, t03, t13, t23; DN_TILE(t01, 0, 1); DN_TILE(t02, 0, 2); DN_TILE(t12, 1, 2); DN_TILE(t03, 0, 3); DN_TILE(t13, 1, 3); DN_TILE(t23, 2, 3);
        AF1 = pack8(t01, z4); AF2 = pack8(t02, t12); AF3a = pack8(t03, t13); AF3b = pack8(t23, z4); }
#undef DN_TILE
    if (wave < 4) {
        const bf16x8 kd0 = *(const LAS bf16x8*)(KS + (16 * wave + col) * 72 + 8 * g), kd1 = *(const LAS bf16x8*)(KS + (16 * wave + col) * 72 + 32 + 8 * g);
        f32x4 t = z4; t = MFMA16(kd0, kd0, t); t = MFMA16(kd1, kd1, t);
        const int cc = 16 * wave + col; const float bc = vbeta[cc], gc = vgam[cc]; const f32x4 gp = *(const LAS f32x4*)(vgam + 16 * wave + 4 * g);
#pragma unroll
        for (int r = 0; r < 4; ++r) t[r] = (col > 4 * g + r) ? t[r] * bc * __expf(gc - gp[r]) : 0.f;
        *(LAS f32x4*)(AII + wave * 256 + col * 16 + 4 * g) = t; }
    LDS_BAR();
    }
    REP(25) {
    if (wave == 1) dn_commit_gates(P, L, 1 - PAR, __expf(alog[idn.h]), dtbp[idn.h], gt_all + (idn.valid ? u_next : 0), idn.valid != 0, lane, wave);
    if (wave == 0) { const int i = g, cl = col; float t[16];
#pragma unroll
        for (int r = 0; r < 16; ++r) { float acc = (r == cl) ? 1.f : 0.f; f32x4 rowv[4];
#pragma unroll
            for (int q = 0; q < 4; ++q) if (4 * q < r) rowv[q] = *(const LAS f32x4*)(AII + i * 256 + r * 16 + 4 * q);
#pragma unroll
            for (int m = 0; m < r; ++m) acc -= rowv[m >> 2][m & 3] * t[m];
            t[r] = acc; }
#pragma unroll
        for (int r = 0; r < 16; ++r) TINV[i * 256 + r * 16 + cl] = t[r]; }
    LDS_BAR();
    }
    f32x4 X[4];
    { bf16x4 TF[4];
#pragma unroll
        for (int i = 0; i < 4; ++i) { const f32x4 tv = *(const LAS f32x4*)(TINV + i * 256 + col * 16 + 4 * g); TF[i] = pack4(tv); }
        X[0] = MFMA16K(TF[0], pack4(R[0]), z4);
        { const f32x4 y = MFMA16(AF1, pack8(X[0], z4), R[1]); X[1] = MFMA16K(TF[1], pack4(y), z4); }
        { const f32x4 y = MFMA16(AF2, pack8(X[0], X[1]), R[2]); X[2] = MFMA16K(TF[2], pack4(y), z4); }
        { f32x4 y = MFMA16(AF3a, pack8(X[0], X[1]), R[3]); y = MFMA16(AF3b, pack8(X[2], z4), y); X[3] = MFMA16K(TF[3], pack4(y), z4); } }
    if (wave >= 4) { const int kd = 16 * (wave - 4) + col;
#pragma unroll
        for (int i = 0; i < 4; ++i)
#pragma unroll
            for (int r = 0; r < 4; ++r) WL[(16 * i + 4 * g + r) * 72 + kd] = f2bf(X[i][r]); }
    dn_commit_raw(P, L, 1 - PAR, tid);
    LDS_BAR();
    if (wave < 4) {
#pragma unroll
        for (int ct = 0; ct < 4; ++ct) { v2u w; w.x = cvtpk(X[ct][0], X[ct][1]); w.y = cvtpk(X[ct][2], X[ct][3]); *(v2u*)(dnf + 32768 + (wave * 4 + ct) * 512 + lane * 8) = w; } }
    { const int ct = wave >> 1, s = wave & 1;
        { const v2u a = *(const LAS v2u*)(WL + (16 * ct + col) * 72 + 32 * s + 4 * g), bq = *(const LAS v2u*)(WL + (16 * ct + col) * 72 + 32 * s + 16 + 4 * g);
            v4u o; o.x = a.x ^ 0x80008000u; o.y = a.y ^ 0x80008000u; o.z = bq.x ^ 0x80008000u; o.w = bq.y ^ 0x80008000u;
            *(v4u*)(dnf + wave * 1024 + lane * 16) = o; }
        { const v2u a = *(const LAS v2u*)(QS + (16 * ct + col) * 72 + 32 * s + 4 * g), bq = *(const LAS v2u*)(QS + (16 * ct + col) * 72 + 32 * s + 16 + 4 * g); const float e = vegam[16 * ct + col];
            v4u o; o.x = cvtpk(bflo(a.x) * e, bfhi(a.x) * e); o.y = cvtpk(bflo(a.y) * e, bfhi(a.y) * e); o.z = cvtpk(bflo(bq.x) * e, bfhi(bq.x) * e); o.w = cvtpk(bflo(bq.y) * e, bfhi(bq.y) * e);
            *(v4u*)(dnf + 8192 + wave * 1024 + lane * 16) = o; }
        { const v2u a = *(const LAS v2u*)(KT + (16 * ct + col) * 72 + 32 * s + 4 * g), bq = *(const LAS v2u*)(KT + (16 * ct + col) * 72 + 32 * s + 16 + 4 * g);
            const f32x4 e1 = *(const LAS f32x4*)(vedec + 32 * s + 4 * g), e2 = *(const LAS f32x4*)(vedec + 32 * s + 16 + 4 * g);
            v4u o; o.x = cvtpk(bflo(a.x) * e1[0], bfhi(a.x) * e1[1]); o.y = cvtpk(bflo(a.y) * e1[2], bfhi(a.y) * e1[3]); o.z = cvtpk(bflo(bq.x) * e2[0], bfhi(bq.x) * e2[1]); o.w = cvtpk(bflo(bq.y) * e2[2], bfhi(bq.y) * e2[3]);
            *(v4u*)(dnf + 24576 + wave * 1024 + lane * 16) = o; }
        { const bf16x8 q0 = *(const LAS bf16x8*)(QS + (16 * ct + col) * 72 + 8 * g), q1 = *(const LAS bf16x8*)(QS + (16 * ct + col) * 72 + 32 + 8 * g);
            const int cc = 16 * ct + col; const float gc = vgam[cc]; f32x4 th[2];
#pragma unroll
            for (int hh = 0; hh < 2; ++hh) { const int ctp = 2 * s + hh; f32x4 t = z4;
                if (ctp <= ct) { const bf16x8 k0 = *(const LAS bf16x8*)(KS + (16 * ctp + col) * 72 + 8 * g), k1 = *(const LAS bf16x8*)(KS + (16 * ctp + col) * 72 + 32 + 8 * g);
                    t = MFMA16(k0, q0, t); t = MFMA16(k1, q1, t); const f32x4 gp = *(const LAS f32x4*)(vgam + 16 * ctp + 4 * g);
#pragma unroll
                    for (int r = 0; r < 4; ++r) t[r] = (cc >= 16 * ctp + 4 * g + r) ? t[r] * __expf(gc - gp[r]) : 0.f; }
                th[hh] = t; }
            *(bf16x8*)(dnf + 16384 + wave * 1024 + lane * 16) = pack8(th[0], th[1]); }
    }
}
constexpr int DW_RAW = 0, DW_AII = 9728, DW_VEC = DW_AII + 4096, DW_END = DW_VEC + 1024;
static_assert(DW_END <= 16384, "per-wave LDS of the wave-autonomous DeltaNet chunk unit");
__device__ __forceinline__ void dnw_stage_issue(v4u (&rg)[9], const bf16* __restrict__ PROJ, int b, int h, int n, int part, int lane) {
#pragma unroll
    for (int it = 0; it < 9; ++it) { const int e = lane + 64 * it, rr = e >> 3, ch = e & 7, t = 64 * n - 3 + rr; v4u val = {0u, 0u, 0u, 0u};
        if (e < 67 * 8 && t >= 0) val = *(const v4u*)(PROJ + ((size_t)b * SEQ + t) * NINP + part * 384 + h * 64 + ch * 8);
        rg[it] = val; }
}
__device__ __forceinline__ void dnw_stage_commit(const v4u (&rg)[9], LAS unsigned char* W, int lane) {
#pragma unroll
    for (int it = 0; it < 9; ++it) { const int e = lane + 64 * it, rr = e >> 3, ch = e & 7; if (e < 67 * 8) *(LAS v4u*)(W + DW_RAW + rr * 144 + ch * 16) = rg[it]; }
}
__device__ __forceinline__ void dnw_conv_qk(const LAS unsigned char* W, const float* __restrict__ cwp, float qscale, bf16x8 (&F)[4][2], int c, int g) {
    v4u Fp[4][2]; float ss[4] = {0.f, 0.f, 0.f, 0.f};
#pragma unroll
    for (int s = 0; s < 2; ++s) {
        f32x4 wa[4], wb[4];
#pragma unroll
        for (int tap = 0; tap < 4; ++tap) { wa[tap] = *(const f32x4*)(cwp + tap * 1152 + 32 * s + 4 * g); wb[tap] = *(const f32x4*)(cwp + tap * 1152 + 32 * s + 16 + 4 * g); }
#pragma unroll
        for (int ct = 0; ct < 4; ++ct) { f32x4 ya = {0.f, 0.f, 0.f, 0.f}, yb = ya;
#pragma unroll
            for (int tap = 0; tap < 4; ++tap) { const LAS unsigned char* rp = W + DW_RAW + (16 * ct + c + tap) * 144 + 64 * s + 8 * g;
                const v2u xa = *(const LAS v2u*)rp, xb = *(const LAS v2u*)(rp + 32);
                ya = ya + wa[tap] * (f32x4){bflo(xa.x), bfhi(xa.x), bflo(xa.y), bfhi(xa.y)}; yb = yb + wb[tap] * (f32x4){bflo(xb.x), bfhi(xb.x), bflo(xb.y), bfhi(xb.y)}; }
#pragma unroll
            for (int e = 0; e < 4; ++e) { ya[e] = silu_f(ya[e]); yb[e] = silu_f(yb[e]); ss[ct] += ya[e] * ya[e] + yb[e] * yb[e]; }
            v4u w; w.x = cvtpk(ya[0], ya[1]); w.y = cvtpk(ya[2], ya[3]); w.z = cvtpk(yb[0], yb[1]); w.w = cvtpk(yb[2], yb[3]); Fp[ct][s] = w; }
    }
#pragma unroll
    for (int ct = 0; ct < 4; ++ct) { float t = ss[ct]; t += __shfl_xor(t, 16); t += __shfl_xor(t, 32);
        const float sc = rsqrtf(t + EPS) * qscale;
#pragma unroll
        for (int s = 0; s < 2; ++s) { const v4u q = Fp[ct][s]; v4u w; w.x = cvtpk(bflo(q.x) * sc, bfhi(q.x) * sc); w.y = cvtpk(bflo(q.y) * sc, bfhi(q.y) * sc); w.z = cvtpk(bflo(q.z) * sc, bfhi(q.z) * sc); w.w = cvtpk(bflo(q.w) * sc, bfhi(q.w) * sc);
            F[ct][s] = __builtin_bit_cast(bf16x8, w); } }
}
__device__ __forceinline__ void dn_chunk_wave(LAS unsigned char* W, const bf16* __restrict__ PROJ, const float* __restrict__ cw, float Aexp, float dtb,
                                              unsigned char* __restrict__ dnf, float* __restrict__ gt_out, int b, int h, int n, int lane) {
    asm volatile("" : "+v"(lane));
    const int c = lane & 15, g = lane >> 4;
    LAS float* AII = (LAS float*)(W + DW_AII); LAS float* vbeta = (LAS float*)(W + DW_VEC); LAS float* vgam = vbeta + 64; LAS float* vegam = vgam + 64; LAS float* vedec = vegam + 64;
    const f32x4 z4 = {0.f, 0.f, 0.f, 0.f};
    v4u rg[9];
    dnw_stage_issue(rg, PROJ, b, h, n, 0, lane);
    { const bf16* pr = PROJ + ((size_t)b * SEQ + 64 * n + lane) * NINP; const float beta = sigmoid_f(bf2f(pr[PC_B + h]));
        const float z = bf2f(pr[PC_A + h]) + dtb; const float sp = z > 20.f ? z : log1pf(__expf(z)); float gv = -Aexp * sp;
#pragma unroll
        for (int off = 1; off < 64; off <<= 1) { const float t = __shfl_up(gv, off); if (lane >= off) gv += t; }
        const float glast = __shfl(gv, 63);
        vbeta[lane] = beta; vgam[lane] = gv; vegam[lane] = __expf(gv); vedec[lane] = __expf(glast - gv);
        if (lane == 63) *gt_out = __expf(gv); }
    bf16x8 KF[4][2];
    {
    bf16x8 QF[4][2];
    dnw_stage_commit(rg, W, lane); asm volatile("" ::: "memory");
    dnw_stage_issue(rg, PROJ, b, h, n, 1, lane);
    dnw_conv_qk(W, cw + h * 64, 0.125f, QF, c, g);
#pragma unroll
    for (int ct = 0; ct < 4; ++ct) { const float e = vegam[16 * ct + c];
#pragma unroll
        for (int s = 0; s < 2; ++s) { const v4u q = __builtin_bit_cast(v4u, QF[ct][s]);
            v4u o; o.x = cvtpk(bflo(q.x) * e, bfhi(q.x) * e); o.y = cvtpk(bflo(q.y) * e, bfhi(q.y) * e); o.z = cvtpk(bflo(q.z) * e, bfhi(q.z) * e); o.w = cvtpk(bflo(q.w) * e, bfhi(q.w) * e);
            *(v4u*)(dnf + 8192 + (2 * ct + s) * 1024 + lane * 16) = o; } }
    asm volatile("" ::: "memory");
    dnw_stage_commit(rg, W, lane); asm volatile("" ::: "memory");
    dnw_stage_issue(rg, PROJ, b, h, n, 2, lane);
    dnw_conv_qk(W, cw + 384 + h * 64, 1.0f, KF, c, g);
#pragma unroll
    for (int ct = 0; ct < 4; ++ct) { const float gc = vgam[16 * ct + c];
#pragma unroll
        for (int sp = 0; sp < 2; ++sp) { f32x4 th[2];
#pragma unroll
            for (int hh = 0; hh < 2; ++hh) { const int ctp = 2 * sp + hh; f32x4 t = z4;
                if (ctp <= ct) { t = MFMA16(KF[ctp][0], QF[ct][0], t); t = MFMA16(KF[ctp][1], QF[ct][1], t); const f32x4 gp = *(const LAS f32x4*)(vgam + 16 * ctp + 4 * g);
#pragma unroll
                    for (int r = 0; r < 4; ++r) t[r] = (16 * ct + c >= 16 * ctp + 4 * g + r) ? t[r] * __expf(gc - gp[r]) : 0.f; }
                th[hh] = t; }
            *(bf16x8*)(dnf + 16384 + (2 * ct + sp) * 1024 + lane * 16) = pack8(th[0], th[1]); } }
    }
    asm volatile("" ::: "memory");
    dnw_stage_commit(rg, W, lane); asm volatile("" ::: "memory");
#define DNW_TILE(dst, ctp, ct) do { f32x4 t_ = z4; t_ = MFMA16(KF[ctp][0], KF[ct][0], t_); t_ = MFMA16(KF[ctp][1], KF[ct][1], t_); \
        const float bc_ = -vbeta[16 * (ct) + c], gc_ = vgam[16 * (ct) + c]; const f32x4 gp_ = *(const LAS f32x4*)(vgam + 16 * (ctp) + 4 * g); \
        _Pragma("unroll") for (int r_ = 0; r_ < 4; ++r_) t_[r_] = t_[r_] * bc_ * __expf(gc_ - gp_[r_]); dst = t_; } while (0)
    bf16x8 AF1, AF2, AF3a, AF3b;
    { f32x4 t01, t02, t12, t03, t13, t23; DNW_TILE(t01, 0, 1); DNW_TILE(t02, 0, 2); DNW_TILE(t12, 1, 2); DNW_TILE(t03, 0, 3); DNW_TILE(t13, 1, 3); DNW_TILE(t23, 2, 3);
        AF1 = pack8(t01, z4); AF2 = pack8(t02, t12); AF3a = pack8(t03, t13); AF3b = pack8(t23, z4); }
#undef DNW_TILE
#pragma unroll
    for (int i = 0; i < 4; ++i) { f32x4 t = z4; t = MFMA16(KF[i][0], KF[i][0], t); t = MFMA16(KF[i][1], KF[i][1], t);
        const float bc = vbeta[16 * i + c], gc = vgam[16 * i + c]; const f32x4 gp = *(const LAS f32x4*)(vgam + 16 * i + 4 * g);
#pragma unroll
        for (int r = 0; r < 4; ++r) t[r] = (c > 4 * g + r) ? t[r] * bc * __expf(gc - gp[r]) : 0.f;
        *(LAS f32x4*)(AII + i * 256 + c * 16 + 4 * g) = t; }
    asm volatile("" ::: "memory");
    { const int i = g, cl = c; float t[16];
#pragma unroll
        for (int r = 0; r < 16; ++r) { float acc = (r == cl) ? 1.f : 0.f; f32x4 rowv[4];
#pragma unroll
            for (int q = 0; q < 4; ++q) if (4 * q < r) rowv[q] = *(const LAS f32x4*)(AII + i * 256 + r * 16 + 4 * q);
#pragma unroll
            for (int m = 0; m < r; ++m) acc -= rowv[m >> 2][m & 3] * t[m];
            t[r] = acc; }
        asm volatile("" ::: "memory");
#pragma unroll
        for (int r = 0; r < 16; ++r) AII[i * 256 + r * 16 + cl] = t[r]; }
    asm volatile("" ::: "memory");
    bf16x4 TF[4];
#pragma unroll
    for (int i = 0; i < 4; ++i) { const f32x4 tv = *(const LAS f32x4*)(AII + i * 256 + c * 16 + 4 * g); TF[i] = pack4(tv); }
#define DNW_SOLVE(X, R) do { X[0] = MFMA16K(TF[0], pack4(R[0]), z4); \
        { const f32x4 y_ = MFMA16(AF1, pack8(X[0], z4), R[1]); X[1] = MFMA16K(TF[1], pack4(y_), z4); } \
        { const f32x4 y_ = MFMA16(AF2, pack8(X[0], X[1]), R[2]); X[2] = MFMA16K(TF[2], pack4(y_), z4); } \
        { f32x4 y_ = MFMA16(AF3a, pack8(X[0], X[1]), R[3]); y_ = MFMA16(AF3b, pack8(X[2], z4), y_); X[3] = MFMA16K(TF[3], pack4(y_), z4); } } while (0)
#pragma unroll 1
    for (int vt = 0; vt < 4; ++vt) { const int d = 16 * vt + c; float cwv[4];
#pragma unroll
        for (int j = 0; j < 4; ++j) cwv[j] = cw[j * 1152 + 768 + h * 64 + d];
        f32x4 R[4], X[4];
#pragma unroll
        for (int i = 0; i < 4; ++i) { float x7[7];
#pragma unroll
            for (int m = 0; m < 7; ++m) x7[m] = bf2f(*(const LAS bf16*)(W + DW_RAW + (16 * i + 4 * g + m) * 144 + 2 * d));
            const f32x4 bt = *(const LAS f32x4*)(vbeta + 16 * i + 4 * g);
#pragma unroll
            for (int r = 0; r < 4; ++r) R[i][r] = silu_f((cwv[0] * x7[r] + cwv[1] * x7[r + 1]) + (cwv[2] * x7[r + 2] + cwv[3] * x7[r + 3])) * bt[r]; }
        DNW_SOLVE(X, R);
#pragma unroll
        for (int ct = 0; ct < 4; ++ct) { v2u w; w.x = cvtpk(X[ct][0], X[ct][1]); w.y = cvtpk(X[ct][2], X[ct][3]); *(v2u*)(dnf + 32768 + (vt * 4 + ct) * 512 + lane * 8) = w; } }
    bf16x4 I16; { v2u w; w.x = ((4 * g == c) ? 0x3F80u : 0u) | ((4 * g + 1 == c) ? 0x3F800000u : 0u); w.y = ((4 * g + 2 == c) ? 0x3F80u : 0u) | ((4 * g + 3 == c) ? 0x3F800000u : 0u); I16 = __builtin_bit_cast(bf16x4, w); }
#pragma unroll 1
    for (int s2 = 0; s2 < 2; ++s2) {
        f32x4 Xw[2][4];
#pragma unroll
        for (int hh = 0; hh < 2; ++hh) {
            v4u iw = {0u, 0u, 0u, 0u};
            if (g == (c >> 2)) { const int j = 4 * hh + (c & 3); const unsigned one = (j & 1) ? 0x3F800000u : 0x3F80u; const int wsel = j >> 1; iw.x = wsel == 0 ? one : 0u; iw.y = wsel == 1 ? one : 0u; iw.z = wsel == 2 ? one : 0u; iw.w = wsel == 3 ? one : 0u; }
            const bf16x8 Isel = __builtin_bit_cast(bf16x8, iw);
            const int kt = 2 * s2 + hh;
            f32x4 Kt[4], R[4];
#pragma unroll
            for (int i = 0; i < 4; ++i) { Kt[i] = (s2 == 0) ? MFMA16(KF[i][0], Isel, z4) : MFMA16(KF[i][1], Isel, z4);
                const f32x4 bt = *(const LAS f32x4*)(vbeta + 16 * i + 4 * g), eg = *(const LAS f32x4*)(vegam + 16 * i + 4 * g); R[i] = Kt[i] * bt * eg; }
            DNW_SOLVE(Xw[hh], R);
#pragma unroll
            for (int sp = 0; sp < 2; ++sp) { const f32x4 e1 = *(const LAS f32x4*)(vedec + 32 * sp + 4 * g), e2 = *(const LAS f32x4*)(vedec + 32 * sp + 16 + 4 * g);
                *(bf16x8*)(dnf + 24576 + (2 * kt + sp) * 1024 + lane * 16) = pack8(Kt[2 * sp] * e1, Kt[2 * sp + 1] * e2); }
        }
#pragma unroll
        for (int i = 0; i < 4; ++i) { const f32x4 D0 = MFMA16K(pack4(Xw[0][i]), I16, z4), D1 = MFMA16K(pack4(Xw[1][i]), I16, z4);
            *(bf16x8*)(dnf + (2 * i + s2) * 1024 + lane * 16) = pack8(D0 * -1.0f, D1 * -1.0f); }
    }
#undef DNW_SOLVE
}
__device__ __forceinline__ void dn_chunk_phase(LAS unsigned char* L, const bf16* __restrict__ PROJ, const float* __restrict__ cw, const float* __restrict__ alog, const float* __restrict__ dtbp,
                                               unsigned char* __restrict__ dnf_all, float* __restrict__ gt_all, int u0, int stride, int tid, int lane, int wave) {
    constexpr int NU = BATCH * 6 * 32;
    if (u0 >= NU) return;
    __syncthreads();
    { const DnUnitId id0 = dn_unit_id(u0); DnPre P; dn_prefetch(P, PROJ, id0, tid, lane, wave); dn_commit_raw(P, L, 0, tid); dn_commit_gates(P, L, 0, __expf(alog[id0.h]), dtbp[id0.h], gt_all + u0, true, lane, wave); }
    for (int u = u0;; u += 2 * stride) {
        dn_chunk_unit<0>(L, PROJ, cw, alog, dtbp, dnf_all, gt_all, u, u + stride, tid, lane, wave);
        if (u + stride >= NU) break;
        dn_chunk_unit<1>(L, PROJ, cw, alog, dtbp, dnf_all, gt_all, u + stride, u + 2 * stride, tid, lane, wave);
        if (u + 2 * stride >= NU) break;
    }
    asm volatile("s_waitcnt vmcnt(0) lgkmcnt(0)" ::: "memory");
    __syncthreads();
}
struct DnScanCtx { LAS unsigned char* fb; LAS float* ssq; LAS bf16* tz; const unsigned char* ubase; const float* GTp; const bf16* PROJ; bf16* MIX; float nw; int b, h, bh, vt, col, g, lane; };
struct DnScanState { f32x4 S[4]; bf16x8 Sb0, Sb1; f32x4 ua[4]; };
template <int PAR> __device__ __forceinline__ void dn_scan_chunk(const DnScanCtx& C, int n, DnScanState& T) {
    const int vt = C.vt, col = C.col, g = C.g, lane = C.lane, h = C.h;
    const f32x4 z4 = {0.f, 0.f, 0.f, 0.f};
    LDS_BAR();
    const size_t tok0 = (size_t)C.b * SEQ + 64 * n;
    v4u zl[2];
#pragma unroll
    for (int j = 0; j < 2; ++j) zl[j] = *(const v4u*)(C.PROJ + (tok0 + (lane >> 1) + 32 * j) * NINP + PC_Z + h * 64 + 16 * vt + 8 * (lane & 1));
    const bool more = n + 1 < 32;
    v4u fr[8]; v2u un[4]; float gtn = 0.f;
    { const unsigned char* nb = C.ubase + (size_t)(more ? n + 1 : n) * DNF_UNIT;
#pragma unroll
        for (int q = 0; q < 8; ++q) fr[q] = *(const v4u*)(nb + (vt * 8 + q) * 1024 + lane * 16);
#pragma unroll
        for (int ct = 0; ct < 4; ++ct) un[ct] = *(const v2u*)(nb + 32768 + (vt * 4 + ct) * 512 + lane * 8);
        gtn = C.GTp[C.bh * 32 + (more ? n + 1 : n)]; }
    const LAS unsigned char* F = C.fb + PAR * 32768 + lane * 16;
#define DN_FRAG(set, f) (*(const LAS bf16x8*)(F + (set) * 8192 + (f) * 1024))
    bf16x8 fw[8], fq[8];
#pragma unroll
    for (int f = 0; f < 8; ++f) fw[f] = DN_FRAG(0, f);
#pragma unroll
    for (int f = 0; f < 8; ++f) fq[f] = DN_FRAG(1, f);
    f32x4 vn[4];
#pragma unroll
    for (int ct = 0; ct < 4; ++ct) { f32x4 a = T.ua[ct]; a = MFMA16(fw[2 * ct], T.Sb0, a); a = MFMA16(fw[2 * ct + 1], T.Sb1, a); vn[ct] = a; }
#pragma unroll
    for (int f = 0; f < 8; ++f) fw[f] = DN_FRAG(2, f);
    f32x4 oo[4];
#pragma unroll
    for (int ct = 0; ct < 4; ++ct) { f32x4 a = z4; a = MFMA16(fq[2 * ct], T.Sb0, a); a = MFMA16(fq[2 * ct + 1], T.Sb1, a); oo[ct] = a; }
#pragma unroll
    for (int f = 0; f < 8; ++f) fq[f] = DN_FRAG(3, f);
    const bf16x8 Vb0 = pack8(vn[0], vn[1]), Vb1 = pack8(vn[2], vn[3]);
#pragma unroll
    for (int ct = 0; ct < 4; ++ct) { f32x4 a = oo[ct]; a = MFMA16(fw[2 * ct], Vb0, a); a = MFMA16(fw[2 * ct + 1], Vb1, a); oo[ct] = a; }
#pragma unroll
    for (int kt = 0; kt < 4; ++kt) { f32x4 a = T.S[kt]; a = MFMA16(fq[2 * kt], Vb0, a); a = MFMA16(fq[2 * kt + 1], Vb1, a); T.S[kt] = a; }
#undef DN_FRAG
    T.Sb0 = pack8(T.S[0], T.S[1]); T.Sb1 = pack8(T.S[2], T.S[3]);
#pragma unroll
    for (int kt = 0; kt < 4; ++kt) T.S[kt] = T.S[kt] * gtn;
#pragma unroll
    for (int ct = 0; ct < 4; ++ct) T.ua[ct] = (f32x4){bflo(un[ct].x), bfhi(un[ct].x), bflo(un[ct].y), bfhi(un[ct].y)};
    { LAS unsigned char* dst = C.fb + (1 - PAR) * 32768 + (vt * 8) * 1024 + lane * 16;
#pragma unroll
        for (int q = 0; q < 8; ++q) *(LAS v4u*)(dst + q * 1024) = fr[q]; }
#pragma unroll
    for (int ct = 0; ct < 4; ++ct) { f32x4 q = oo[ct] * oo[ct];
#pragma unroll
        for (int off = 1; off < 16; off <<= 1) { q[0] += __shfl_xor(q[0], off); q[1] += __shfl_xor(q[1], off); q[2] += __shfl_xor(q[2], off); q[3] += __shfl_xor(q[3], off); }
        if (col == 0) *(LAS f32x4*)(C.ssq + vt * 64 + 16 * ct + 4 * g) = q; }
    LAS bf16* tz = C.tz;
#pragma unroll
    for (int j = 0; j < 2; ++j) *(LAS v4u*)(tz + ((lane >> 1) + 32 * j) * 24 + 8 * (lane & 1)) = zl[j];
    LDS_BAR();
#pragma unroll
    for (int ct = 0; ct < 4; ++ct) { const f32x4 tot = (*(const LAS f32x4*)(C.ssq + 16 * ct + 4 * g) + *(const LAS f32x4*)(C.ssq + 64 + 16 * ct + 4 * g)) + (*(const LAS f32x4*)(C.ssq + 128 + 16 * ct + 4 * g) + *(const LAS f32x4*)(C.ssq + 192 + 16 * ct + 4 * g));
#pragma unroll
        for (int r = 0; r < 4; ++r) { LAS bf16* e = tz + (16 * ct + 4 * g + r) * 24 + col;
            *e = f2bf(oo[ct][r] * rsqrtf(tot[r] * (1.f / 64.f) + EPS) * C.nw * silu_f(bf2f(*e))); } }
    asm volatile("s_waitcnt lgkmcnt(0)" ::: "memory");
#pragma unroll
    for (int j = 0; j < 2; ++j) { const v4u o = *(const LAS v4u*)(tz + ((lane >> 1) + 32 * j) * 24 + 8 * (lane & 1));
        *(v4u*)(C.MIX + (tok0 + (lane >> 1) + 32 * j) * DM + h * 64 + 16 * vt + 8 * (lane & 1)) = o; }
}
__device__ __forceinline__ void dn_scan_pair(LAS unsigned char* lds, const unsigned char* __restrict__ DNFp, const float* __restrict__ GTp, const bf16* __restrict__ PROJ, bf16* __restrict__ MIX,
                                             const float* __restrict__ nrmw, int pair, int lane, int wave) {
    DnScanCtx C;
    C.vt = wave & 3; C.bh = pair; C.b = C.bh / 6; C.h = C.bh % 6; C.col = lane & 15; C.g = lane >> 4; C.lane = lane;
    C.fb = lds + RING_OFF;
    C.ssq = (LAS float*)(lds + LDSCTL_OFF + 1024);
    C.tz = (LAS bf16*)(lds + RING_OFF + 65536 + (wave & 3) * 3072);
    if (wave >= 4) {
        __syncthreads();
        for (int n = 0; n < 32; ++n) { LDS_BAR(); LDS_BAR(); }
        asm volatile("s_waitcnt vmcnt(0) lgkmcnt(0)" ::: "memory");
        __syncthreads();
        return; }
    C.ubase = DNFp + (size_t)C.bh * 32 * DNF_UNIT; C.GTp = GTp; C.PROJ = PROJ; C.MIX = MIX;
    C.nw = nrmw[16 * C.vt + C.col];
    const f32x4 z4 = {0.f, 0.f, 0.f, 0.f};
    DnScanState T;
#pragma unroll
    for (int kt = 0; kt < 4; ++kt) T.S[kt] = z4;
    T.Sb0 = pack8(z4, z4); T.Sb1 = T.Sb0;
    __syncthreads();
    { const unsigned char* nb = C.ubase;
#pragma unroll
        for (int q = 0; q < 8; ++q) *(LAS v4u*)(C.fb + (C.vt * 8 + q) * 1024 + lane * 16) = *(const v4u*)(nb + (C.vt * 8 + q) * 1024 + lane * 16);
#pragma unroll
        for (int ct = 0; ct < 4; ++ct) { const v2u w = *(const v2u*)(nb + 32768 + (C.vt * 4 + ct) * 512 + lane * 8); T.ua[ct] = (f32x4){bflo(w.x), bfhi(w.x), bflo(w.y), bfhi(w.y)}; } }
    for (int n = 0; n < 32; n += 2) { dn_scan_chunk<0>(C, n, T); dn_scan_chunk<1>(C, n + 1, T); }
    asm volatile("s_waitcnt vmcnt(0) lgkmcnt(0)" ::: "memory");
    __syncthreads();
}
__device__ __forceinline__ void cmp_mlp2_tiles(const bf16* __restrict__ HID, const bf16* __restrict__ W2T, bf16* __restrict__ KC, bf16* __restrict__ VCT, int T0, int T1, int stride, int first, int lane) {
    const int col = lane & 15, g4 = lane >> 4;
    for (int T = T0 + first; T < T1; T += stride) {
        const int row0 = 16 * T, kv = row0 >> 13, g = (row0 >> 7) & 1, b = (row0 >> 8) & 31, i0 = row0 & 127;
        bf16x8 af[4];
#pragma unroll
        for (int s4 = 0; s4 < 4; ++s4) af[s4] = *(const bf16x8*)(HID + (size_t)(row0 + col) * 256 + kv * 128 + 32 * s4 + 8 * g4);
#pragma unroll
        for (int dt = 0; dt < 4; ++dt) { f32x4 acc = {0.f, 0.f, 0.f, 0.f};
#pragma unroll
            for (int s4 = 0; s4 < 4; ++s4) { const bf16x8 bfr = *(const bf16x8*)(W2T + (size_t)(kv * 64 + 16 * dt + col) * 128 + 32 * s4 + 8 * g4); acc = MFMA16(af[s4], bfr, acc); }
            if (i0 + 4 * g4 + 3 == 127) acc[3] = 0.f;
            if (kv == 0) {
#pragma unroll
                for (int r = 0; r < 4; ++r) KC[((size_t)(b * 2 + g) * 128 + i0 + 4 * g4 + r) * 64 + 16 * dt + col] = f2bf(acc[r]);
            } else { const int pos0 = 32 * (i0 >> 5) + 8 * g4 + ((i0 & 16) ? 4 : 0);
                v2u w; w.x = cvtpk(acc[0], acc[1]); w.y = cvtpk(acc[2], acc[3]); *(v2u*)(VCT + ((size_t)(b * 2 + g) * 64 + 16 * dt + col) * 128 + pos0) = w; } }
    }
}
struct Args { const float* in[21]; float* out; unsigned char* ws; int pre, ph_lo, ph_hi, l_lo, l_hi, pad; };
typedef const Args __attribute__((address_space(4)))* ArgsP;
enum { I_X = 0, I_NORMW, I_WIN, I_DNCONV, I_DNALOG, I_DNDT, I_DNNORM, I_CFW, I_CFB, I_CFLNW, I_CFLNB, I_KPOS, I_VPOS, I_KW1, I_KW2, I_VW1, I_VW2, I_WOUT, I_WG, I_WU, I_WD };

template <unsigned PHM> __global__ void __launch_bounds__(NTHR, 2) fwd(Args args) {
    extern __shared__ __attribute__((aligned(16))) unsigned char lds_raw[];
    LAS unsigned char* lds = (LAS unsigned char*)lds_raw;
    volatile LAS unsigned* MISC = (volatile LAS unsigned*)(lds + MISC_OFF);
    for (int u = threadIdx.x; u < (LDS_BYTES - LDSCTL_OFF) / 4; u += NTHR) ((LAS unsigned*)(lds + LDSCTL_OFF))[u] = 0u;
    __syncthreads();
#if MK_ONE_LAUNCH
    XcdBarrier bar = xcd_barrier_post((unsigned*)(args.ws + WS_CTL) + CW_BAR, MISC + 8);
#define GRID_BAR() xcd_barrier(bar)
#else
#define GRID_BAR() do { } while (0)
#endif
    const int ph_lo = args.ph_lo, ph_hi = args.ph_hi;
#define PH_LOCALS() \
    int tid = threadIdx.x; asm volatile("" : "+v"(tid)); \
    const int lane = tid & 63, wave = __builtin_amdgcn_readfirstlane(tid >> 6); \
    int blk = blockIdx.x; asm volatile("" : "+s"(blk)); \
    const int G = gridDim.x, gw = blk * NWAVES + wave, NGW = G * NWAVES; \
    ArgsP ap = (ArgsP)__builtin_amdgcn_kernarg_segment_ptr(); asm volatile("" : "+s"(ap)); \
    unsigned char* const ws = ap->ws; \
    bf16* const Win_t = (bf16*)(ws + WS_WIN); bf16* const Wout_t = (bf16*)(ws + WS_WOUT); bf16* const Wgu_t = (bf16*)(ws + WS_WGU); bf16* const Wd_t = (bf16*)(ws + WS_WD); bf16* const Wc1_t = (bf16*)(ws + WS_WC1); \
    bf16* const KC = (bf16*)(ws + WS_KC); bf16* const VCT = (bf16*)(ws + WS_VCT); \
    bf16* const PROJ = (bf16*)(ws + WS_PROJ); bf16* const HFF = (bf16*)(ws + WS_PROJ); bf16* const MIX = (bf16*)(ws + WS_MIX); bf16* const MBUF = (bf16*)(ws + WS_MBUF); bf16* const XB = (bf16*)(ws + WS_XB); \
    bf16* const ACMP = (bf16*)(ws + WS_ACMP); bf16* const HID = (bf16*)(ws + WS_HID); \
    bf16* const KS = (bf16*)(ws + WS_KS); bf16* const KW = (bf16*)(ws + WS_KW); bf16* const VST = (bf16*)(ws + WS_VST); bf16* const VWT = (bf16*)(ws + WS_VWT); \
    const float* const x_in = ap->in[I_X]; float* const xres = ap->out; float* const RSTD = (float*)(ws + WS_RSTD); bf16* const XD = (bf16*)ap->out; bf16* const XM = (bf16*)(ws + WS_MIX); (void)RSTD; (void)XD; (void)XM; \
    (void)lane; (void)gw; (void)NGW; (void)Win_t; (void)Wout_t; (void)Wgu_t; (void)Wd_t; (void)Wc1_t; (void)KC; (void)VCT; (void)PROJ; (void)HFF; (void)MIX; (void)MBUF; (void)XB; (void)ACMP; (void)HID; (void)KS; (void)KW; (void)VST; (void)VWT; (void)x_in; (void)xres; (void)G;

    const int lo = ph_lo, hi = ph_hi;
#define IN(k) (((PHM >> (k)) & 1u) && lo <= (k) && (k) < hi)
    if ((PHM & 1u) && args.pre) REP(30) {
        PH_LOCALS();
        LAS float* scr = (LAS float*)(lds + RING_OFF + wave * 16384);
        constexpr int IT_IN = 16 * 104, IT_OUT = 16 * 32, IT_GU = 16 * 176, IT_D = 44 * 32, IT_C1 = 32 * 8, IT_L = IT_IN + IT_OUT + IT_GU + IT_D + IT_C1;
        for (int it = gw; it < DEPTH * IT_L; it += NGW) {
            const int l = it / IT_L; int r = it % IT_L;
            const float* nw = ap->in[I_NORMW] + (size_t)l * 4 * DM;
            if (r < IT_IN) { const float* W = ap->in[I_WIN] + (size_t)l * DM * NIN; const float* sc = nw;
                wprep_item([=](int k, int n) { const int col = win_src_col(n); return col >= 0 ? W[(size_t)k * NIN + col] * sc[k] : 0.f; }, DM, Win_t + (size_t)l * NINP * DM, scr, r, 104, lane); continue; } r -= IT_IN;
            if (r < IT_OUT) { const float* W = ap->in[I_WOUT] + (size_t)l * DM * DM;
                wprep_item([=](int k, int n) { return W[(size_t)k * DM + n]; }, DM, Wout_t + (size_t)l * DM * DM, scr, r, 32, lane); continue; } r -= IT_OUT;
            if (r < IT_GU) { const float* Wg = ap->in[I_WG] + (size_t)l * DM * DFF; const float* Wu = ap->in[I_WU] + (size_t)l * DM * DFF; const float* sc = nw + 2 * DM;
                wprep_item([=](int k, int n) { const int t = n >> 8, w = n & 255; const ptrdiff_t sel = w < 128 ? (ptrdiff_t)0 : (Wu - Wg); return Wg[sel + (ptrdiff_t)k * DFF + 128 * t + (w & 127)] * sc[k]; }, DM, Wgu_t + (size_t)l * NGU * DM, scr, r, 176, lane); continue; } r -= IT_GU;
            if (r < IT_D) { const float* W = ap->in[I_WD] + (size_t)l * DFF * DM;
                wprep_item([=](int k, int n) { return W[(size_t)k * DM + n]; }, DFF, Wd_t + (size_t)l * DM * DFF, scr, r, 32, lane); continue; } r -= IT_D;
            { const float* Wk = ap->in[I_KW1] + (size_t)l * CMP_K * 128; const float* Wv = ap->in[I_VW1] + (size_t)l * CMP_K * 128;
                wprep_item([=](int k, int n) { const ptrdiff_t sel = n < 128 ? (ptrdiff_t)0 : (Wv - Wk); return Wk[sel + (ptrdiff_t)k * 128 + (n & 127)]; }, CMP_K, Wc1_t + (size_t)l * 256 * CMP_K, scr, r, 8, lane); }
        }
        for (int e = blk * NTHR + tid; e < DEPTH * 2 * 64 * 128; e += G * NTHR) { const int n = e & 127, d = (e >> 7) & 63, kv = (e >> 13) & 1, ll = e >> 14;
            ((bf16*)(ws + WS_W2T))[e] = f2bf(ap->in[kv ? I_VW2 : I_KW2][((size_t)ll * 128 + n) * 64 + d]); }
        for (int m = gw; m < MTOK / 2; m += NGW) {
            const int m2 = m + MTOK / 2; const f32x4* xa = (const f32x4*)(x_in + (size_t)m * DM) + lane; const f32x4* xb2 = (const f32x4*)(x_in + (size_t)m2 * DM) + lane;
            f32x4 va[4], vb[4]; float sa = 0.f, sb = 0.f;
#pragma unroll
            for (int j = 0; j < 4; ++j) { va[j] = xa[64 * j]; vb[j] = xb2[64 * j]; }
#pragma unroll
            for (int j = 0; j < 4; ++j) { sa += (va[j].x * va[j].x + va[j].y * va[j].y) + (va[j].z * va[j].z + va[j].w * va[j].w); sb += (vb[j].x * vb[j].x + vb[j].y * vb[j].y) + (vb[j].z * vb[j].z + vb[j].w * vb[j].w); }
#pragma unroll
            for (int o = 1; o < 64; o <<= 1) { sa += __shfl_xor(sa, o); sb += __shfl_xor(sb, o); }
            if (lane == 0) { RSTD[m] = rsqrtf(sa * (1.f / DM) + EPS); RSTD[m2] = rsqrtf(sb * (1.f / DM) + EPS); }
            v2u* oa = (v2u*)(XB + (size_t)m * DM) + lane; v2u* ob = (v2u*)(XB + (size_t)m2 * DM) + lane;
#pragma unroll
            for (int j = 0; j < 4; ++j) { v2u w; w.x = cvtpk(va[j].x, va[j].y); w.y = cvtpk(va[j].z, va[j].w); oa[64 * j] = w; w.x = cvtpk(vb[j].x, vb[j].y); w.y = cvtpk(vb[j].z, vb[j].w); ob[64 * j] = w; }
        }
        GRID_BAR();
    }

    for (int l = args.l_lo, l_end = args.l_hi; l < l_end; ++l) {
        if (IN(1)) REP(1) {
            PH_LOCALS();
            pg8::Gemm g{l == 0 ? XB : XD, Win_t + (size_t)l * NINP * DM, MTOK, NINP, DM}; pg8::StaticOrder S; S.init(MTOK, NINP, G, blk);
            pg8::EpiBf16<0> E{PROJ, NINP, RSTD};
            pg8::gemm_phase<pg8::EpiBf16<0>, pg8::StaticOrder, true, true>(lds + RING_OFF, g, S, E);
            GRID_BAR();
        }
        if (IN(2)) REP(2) {
            PH_LOCALS();
            REP(21) {
            {
                const float* kpos = ap->in[I_KPOS] + (size_t)l * 32 * 64; const float* vpos = ap->in[I_VPOS] + (size_t)l * 32 * 64;
                for (int row = gw; row < CMP_ROWS; row += NGW) {
                    const int i = row & 127, g = (row >> 7) & 1, b = (row >> 8) & 31, kv = row >> 13;
                    const float* pos = kv ? vpos : kpos; const int pc = (kv ? PC_VC : PC_KC) + g * 64;
#pragma unroll
                    for (int cch = 0; cch < 4; ++cch) { const int ch = lane + 64 * cch, tl = ch >> 3, d0 = (ch & 7) * 8;
                        v4u o = {0u, 0u, 0u, 0u};
                        if (i < 127) { const v4u s = *(const v4u*)(PROJ + ((size_t)b * SEQ + 16 * i + tl) * NINP + pc + d0);
                            const f32x4 p0 = *(const f32x4*)(pos + tl * 64 + d0), p1 = *(const f32x4*)(pos + tl * 64 + d0 + 4);
                            o.x = cvtpk(bflo(s.x) + p0.x, bfhi(s.x) + p0.y); o.y = cvtpk(bflo(s.y) + p0.z, bfhi(s.y) + p0.w);
                            o.z = cvtpk(bflo(s.z) + p1.x, bfhi(s.z) + p1.y); o.w = cvtpk(bflo(s.w) + p1.z, bfhi(s.w) + p1.w); }
                        *(v4u*)(ACMP + (size_t)row * CMP_K + tl * 64 + d0) = o; }
                }
            }
            for (size_t ch = (size_t)blk * NTHR + tid; ch < (size_t)MTOK * 32; ch += (size_t)G * NTHR) {
                const int cc = (int)(ch & 31), which = cc >> 4, g = (cc >> 3) & 1, d0 = (cc & 7) * 8; const size_t tok = ch >> 5; const int b = (int)(tok >> 11), t = (int)(tok & 2047);
                const v4u s = *(const v4u*)(PROJ + tok * NINP + (which ? PC_KW : PC_KS) + g * 64 + d0);
                *(v4u*)((which ? KW : KS) + ((size_t)(b * 2 + g) * SEQ + t) * 64 + d0) = s;
            }
            {
                LAS bf16* tile = (LAS bf16*)(lds + RING_OFF + wave * 16384);
                for (int it = gw; it < 2 * BATCH * 2 * 32; it += NGW) {
                    const int tt = it & 31, g = (it >> 5) & 1, b = (it >> 6) & 31, which = it >> 11; const int t0 = tt * 64;
                    const bf16* src = PROJ + ((size_t)b * SEQ + t0) * NINP + (which ? PC_VW : PC_VS) + g * 64;
#pragma unroll
                    for (int q = 0; q < 8; ++q) { const int t = (lane >> 3) + 8 * q, d0 = (lane & 7) * 8; const v4u s = *(const v4u*)(src + (size_t)t * NINP + d0);
                        LAS unsigned* dst = (LAS unsigned*)(tile + t * 66 + d0); dst[0] = s.x; dst[1] = s.y; dst[2] = s.z; dst[3] = s.w; }
                    LDS_WAIT(); asm volatile("" ::: "memory");
                    bf16* dstb = (which ? VWT : VST) + (size_t)(b * 2 + g) * 64 * SEQ + t0;
#pragma unroll
                    for (int q = 0; q < 8; ++q) { const int d = (lane >> 3) + 8 * q, ck = lane & 7, gI = ck >> 2, gqq = ck & 3;
                        unsigned short e[8];
#pragma unroll
                        for (int j = 0; j < 8; ++j) { const int key = 32 * gI + (j < 4 ? 4 * gqq + j : 16 + 4 * gqq + (j - 4)); e[j] = tile[key * 66 + d]; }
                        v4u o; o.x = e[0] | ((unsigned)e[1] << 16); o.y = e[2] | ((unsigned)e[3] << 16); o.z = e[4] | ((unsigned)e[5] << 16); o.w = e[6] | ((unsigned)e[7] << 16);
                        *(v4u*)(dstb + (size_t)d * SEQ + 8 * ck) = o; }
                    LDS_WAIT(); asm volatile("" ::: "memory");
                }
            }
            }
            __syncthreads();
            REP(22) {
                LAS float* hb = (LAS float*)(lds + RING_OFF); LAS float* yb = hb + 62 * 256;
                const float* dw = ap->in[I_CFW] + (size_t)l * 31 * 256; const float* db = ap->in[I_CFB] + (size_t)l * 256;
                const float* lw = ap->in[I_CFLNW] + (size_t)l * 256; const float* lb = ap->in[I_CFLNB] + (size_t)l * 256;
                const int ch = tid & 255, half = tid >> 8; float wv[31];
#pragma unroll
                for (int j = 0; j < 31; ++j) wv[j] = dw[j * 256 + ch];
                const float bias = db[ch];
                float lwv[4], lbv[4];
#pragma unroll
                for (int k = 0; k < 4; ++k) { lwv[k] = lw[lane + 64 * k]; lbv[k] = lb[lane + 64 * k]; }
                for (int u = blk; u < BATCH * 64; u += G) {
                    const int b = u >> 6, t0 = (u & 63) * 32;
                    for (int e = tid; e < 62 * 32; e += NTHR) { const int rr = e >> 5, c8 = (e & 31) * 8, t = t0 - 30 + rr;
                        f32x4 o0 = {0.f, 0.f, 0.f, 0.f}, o1 = o0;
                        if (t >= 0) { const bf16* pr = PROJ + ((size_t)b * SEQ + t) * NINP + PC_CF + c8; const v4u a = *(const v4u*)pr, gg = *(const v4u*)(pr + 256);
                            o0 = (f32x4){bflo(a.x) * sigmoid_f(bflo(gg.x)), bfhi(a.x) * sigmoid_f(bfhi(gg.x)), bflo(a.y) * sigmoid_f(bflo(gg.y)), bfhi(a.y) * sigmoid_f(bfhi(gg.y))};
                            o1 = (f32x4){bflo(a.z) * sigmoid_f(bflo(gg.z)), bfhi(a.z) * sigmoid_f(bfhi(gg.z)), bflo(a.w) * sigmoid_f(bflo(gg.w)), bfhi(a.w) * sigmoid_f(bfhi(gg.w))}; }
                        *(LAS f32x4*)(hb + rr * 256 + c8) = o0; *(LAS f32x4*)(hb + rr * 256 + c8 + 4) = o1; }
                    __syncthreads();
                    { float hv[46];
#pragma unroll
                        for (int k = 0; k < 46; ++k) hv[k] = hb[(16 * half + k) * 256 + ch];
#pragma unroll
                        for (int i = 0; i < 16; ++i) { float acc = bias;
#pragma unroll
                            for (int j = 0; j < 31; ++j) acc += wv[j] * hv[i + j];
                            yb[(16 * half + i) * 256 + ch] = acc; } }
                    __syncthreads();
                    { float y[4][4], s1[4], s2[4];
#pragma unroll
                        for (int i4 = 0; i4 < 4; ++i4) { s1[i4] = 0.f; s2[i4] = 0.f;
#pragma unroll
                            for (int k = 0; k < 4; ++k) { const float v = yb[(wave * 4 + i4) * 256 + lane + 64 * k]; y[i4][k] = v; s1[i4] += v; s2[i4] += v * v; } }
#pragma unroll
                        for (int o = 1; o < 64; o <<= 1)
#pragma unroll
                            for (int i4 = 0; i4 < 4; ++i4) { s1[i4] += __shfl_xor(s1[i4], o); s2[i4] += __shfl_xor(s2[i4], o); }
#pragma unroll
                        for (int i4 = 0; i4 < 4; ++i4) { const float mean = s1[i4] * (1.f / 256.f); const float var = fmaxf(s2[i4] * (1.f / 256.f) - mean * mean, 0.f); const float rs = rsqrtf(var + EPS);
                            bf16* orow = MIX + ((size_t)b * SEQ + t0 + wave * 4 + i4) * DM + 384;
#pragma unroll
                            for (int k = 0; k < 4; ++k) orow[lane + 64 * k] = f2bf(silu_f((y[i4][k] - mean) * rs * lwv[k] + lbv[k])); } }
                    __syncthreads();
                }
            }
            REP(23) {
                { const float* cwl = ap->in[I_DNCONV] + (size_t)l * 4 * 1152; const float* alog = ap->in[I_DNALOG] + l * 6; const float* dtbp = ap->in[I_DNDT] + l * 6;
                    for (int u = gw; u < BATCH * 6 * 32; u += NGW) { const int n = u & 31, bh = u >> 5, b = bh / 6, h = bh % 6;
                        dn_chunk_wave(lds + RING_OFF + wave * 16384, PROJ, cwl, __expf(alog[h]), dtbp[h], ws + WS_DNF + (size_t)u * DNF_UNIT, (float*)(ws + WS_GT) + u, b, h, n, lane); } }
            }
            GRID_BAR();
        }
        if (IN(3)) REP(3) {
            PH_LOCALS();
            if (blk < 64) {
                pg8::Gemm g{ACMP, Wc1_t + (size_t)l * 256 * CMP_K, CMP_ROWS, 256, CMP_K}; pg8::StaticOrder S; S.init(CMP_ROWS, 256, 64, blk);
                pg8::EpiBf16<1> E{HID, 256, nullptr};
                pg8::gemm_phase<pg8::EpiBf16<1>, pg8::StaticOrder, true, true>(lds + RING_OFF, g, S, E);
                pg8::Unit un; if (S.next(0, un)) { asm volatile("s_waitcnt vmcnt(0)" ::: "memory"); __syncthreads();
                    cmp_mlp2_tiles(HID, (const bf16*)(ws + WS_W2T) + (size_t)l * 2 * 64 * 128, KC, VCT, 16 * un.pm, 16 * un.pm + 16, NWAVES, wave, lane); }
            }
        }
        if (IN(11)) REP(11) {
            PH_LOCALS();
            if (blk >= 64 && blk < 64 + BATCH * 6)
                dn_scan_pair(lds, ws + WS_DNF, (const float*)(ws + WS_GT), PROJ, MIX, ap->in[I_DNNORM] + (size_t)l * 64, blk - 64, lane, wave);
            GRID_BAR();
        }
        if (IN(5)) REP(5) {
            PH_LOCALS();
            NsaPtrs P{PROJ, KC, VCT, KS, VST, KW, VWT, MIX};
            for (int u = blk; u < 1024; u += G) {
                const int hi4 = u >> 8, lo8 = u & 255, b = lo8 >> 3, g = (lo8 >> 2) & 1, q4 = lo8 & 3;
                const int q8 = hi4 == 0 ? q4 : (hi4 == 1 ? 15 - q4 : (hi4 == 2 ? 4 + q4 : 11 - q4));
                __syncthreads();
                nsa_stage_cmp(lds, P, b, g, tid);
                __syncthreads();
                nsa_item(P, lds, wave, b, g, (q8 * 8 + wave) * 16, tid, lane);
            }
            GRID_BAR();
        }
        if (IN(6)) REP(6) {
            PH_LOCALS();
            pg8::Gemm g{MIX, Wout_t + (size_t)l * DM * DM, MTOK, DM, DM}; pg8::StaticOrder S; S.init(MTOK, DM, G, blk);
            pg8::EpiBf16<0> E{MBUF, DM, nullptr};
            pg8::gemm_phase<pg8::EpiBf16<0>, pg8::StaticOrder, true, true>(lds + RING_OFF, g, S, E);
            GRID_BAR();
        }
        if (IN(7)) REP(7) {
            PH_LOCALS();
            const float* wp = ap->in[I_NORMW] + ((size_t)l * 4 + 1) * DM; bf16* const xo = (l == DEPTH - 1) ? XM : XD;
            constexpr int HM = MTOK / 2;
            if (l == 0) { for (int m = gw; m < HM; m += NGW) resid_row2<true, false>(x_in + (size_t)m * DM, x_in + (size_t)(m + HM) * DM, MBUF + (size_t)m * DM, MBUF + (size_t)(m + HM) * DM, wp, xo + (size_t)m * DM, xo + (size_t)(m + HM) * DM, RSTD + m, RSTD + m + HM, lane); }
            else { for (int m = gw; m < HM; m += NGW) resid_row2<false, false>(XD + (size_t)m * DM, XD + (size_t)(m + HM) * DM, MBUF + (size_t)m * DM, MBUF + (size_t)(m + HM) * DM, wp, xo + (size_t)m * DM, xo + (size_t)(m + HM) * DM, RSTD + m, RSTD + m + HM, lane); }
            GRID_BAR();
        }
        if (IN(8)) REP(8) {
            PH_LOCALS();
            pg8::Gemm g{(l == DEPTH - 1) ? XM : XD, Wgu_t + (size_t)l * NGU * DM, MTOK, NGU, DM}; pg8::StaticOrder S; S.init(MTOK, NGU, G, blk);
            pg8::EpiSwiGLU E{HFF, DFF, RSTD};
            pg8::gemm_phase<pg8::EpiSwiGLU, pg8::StaticOrder, true, true>(lds + RING_OFF, g, S, E);
            GRID_BAR();
        }
        if (IN(9)) REP(9) {
            PH_LOCALS();
            pg8::Gemm g{HFF, Wd_t + (size_t)l * DM * DFF, MTOK, DM, DFF}; pg8::StaticOrder S; S.init(MTOK, DM, G, blk);
            pg8::EpiBf16<0> E{MBUF, DM, nullptr};
            pg8::gemm_phase<pg8::EpiBf16<0>, pg8::StaticOrder, true, true>(lds + RING_OFF, g, S, E);
            GRID_BAR();
        }
        if (IN(10)) REP(10) {
            PH_LOCALS();
            const float* wp = ap->in[I_NORMW] + ((size_t)l * 4 + 3) * DM;
            constexpr int HM = MTOK / 2;
            if (l == DEPTH - 1) { for (int m = gw; m < HM; m += NGW) resid_row2<false, true>(XM + (size_t)m * DM, XM + (size_t)(m + HM) * DM, MBUF + (size_t)m * DM, MBUF + (size_t)(m + HM) * DM, wp, xres + (size_t)m * DM, xres + (size_t)(m + HM) * DM, RSTD + m, RSTD + m + HM, lane); }
            else { for (int m = gw; m < HM; m += NGW) resid_row2<false, false>(XD + (size_t)m * DM, XD + (size_t)(m + HM) * DM, MBUF + (size_t)m * DM, MBUF + (size_t)(m + HM) * DM, wp, XD + (size_t)m * DM, XD + (size_t)(m + HM) * DM, RSTD + m, RSTD + m + HM, lane); }
            if (l + 1 < ap->l_hi) GRID_BAR();
        }
    }
#undef IN
}

template <unsigned PHM> static int setup_kernel() {
    if (hipFuncSetAttribute((const void*)fwd<PHM>, hipFuncAttributeMaxDynamicSharedMemorySize, LDS_BYTES) != hipSuccess) { fprintf(stderr, "kernel_launch: hipFuncSetAttribute failed (mask %x)\n", PHM); return -1; }
    int per_cu = 0;
    if (hipOccupancyMaxActiveBlocksPerMultiprocessor(&per_cu, (const void*)fwd<PHM>, NTHR, LDS_BYTES) != hipSuccess || per_cu < 1) fprintf(stderr, "kernel_launch: occupancy query reports %d (mask %x)\n", per_cu, PHM);
    (void)hipGetLastError();
    return 0;
}
template <unsigned PHM> static void launch_ph(int grid, hipStream_t stream, const Args& a) { hipLaunchKernelGGL(fwd<PHM>, dim3(grid), dim3(NTHR), LDS_BYTES, stream, a); }
#ifndef PH_ALL_MASK
#define PH_ALL_MASK 0xfffu
#endif
constexpr unsigned PH_ALL = PH_ALL_MASK;
extern "C" void kernel_launch(void* const* d_in, const int* in_sizes, int n_in, void* d_out, int out_size, void* d_ws, size_t ws_size, hipStream_t stream) {
    static int grid = 0;
    if (grid == 0) {
        if (n_in != 21 || in_sizes[0] != MTOK * DM || out_size != MTOK * DM || ws_size < WS_END) { fprintf(stderr, "kernel_launch: unexpected shapes (n_in %d, in0 %d, out %d, ws %zu); nothing launched\n", n_in, n_in > 0 ? in_sizes[0] : -1, out_size, ws_size); grid = -1; return; }
        int dev = 0, cus = 0;
        if (hipGetDevice(&dev) != hipSuccess || hipDeviceGetAttribute(&cus, hipDeviceAttributeMultiprocessorCount, dev) != hipSuccess) { grid = -1; return; }
        int rc = 0;
#if MK_ONE_LAUNCH
        rc |= setup_kernel<PH_ALL>();
#else
        rc |= setup_kernel<1u << 0>(); rc |= setup_kernel<1u << 1>(); rc |= setup_kernel<1u << 2>(); rc |= setup_kernel<1u << 3>(); rc |= setup_kernel<1u << 4>(); rc |= setup_kernel<1u << 5>();
        rc |= setup_kernel<1u << 6>(); rc |= setup_kernel<1u << 7>(); rc |= setup_kernel<1u << 8>(); rc |= setup_kernel<1u << 9>(); rc |= setup_kernel<1u << 10>(); rc |= setup_kernel<1u << 11>();
#endif
        if (rc) { grid = -1; return; }
        grid = cus;
        if (grid < 128) { fprintf(stderr, "kernel_launch: needs >= 128 CUs\n"); grid = -1; return; }
    }
    if (grid < 0) return;
    if (hipMemsetAsync((char*)d_ws + WS_CTL, 0, CTL_ZERO_BYTES, stream) != hipSuccess) return;
    Args a{};
    for (int i = 0; i < 21; ++i) a.in[i] = (const float*)d_in[i];
    a.out = (float*)d_out; a.ws = (unsigned char*)d_ws;
#if MK_ONE_LAUNCH
    a.pre = 1; a.ph_lo = 1; a.ph_hi = 12; a.l_lo = 0; a.l_hi = DEPTH;
    launch_ph<PH_ALL>(grid, stream, a);
#else
    a.pre = 1; a.ph_lo = 0; a.ph_hi = 0; a.l_lo = 0; a.l_hi = 0;
    launch_ph<1u << 0>(grid, stream, a);
    for (int l = 0; l < DEPTH; ++l) {
        a.pre = 0; a.l_lo = l; a.l_hi = l + 1;
#define LP(p) do { a.ph_lo = (p); a.ph_hi = (p) + 1; launch_ph<1u << (p)>(grid, stream, a); } while (0)
        LP(1); LP(2); LP(3); LP(11); LP(4); LP(5); LP(6); LP(7); LP(8); LP(9); LP(10);
#undef LP
    }
#endif
}
```

```cpp
#include <hip/hip_runtime.h>
#include <cstdio>
#include <cstdint>

#ifndef PROBE_PH
#define PROBE_PH 0
#define PROBE_N 1
#endif
#define REP(k) for (int rep_ = 0; rep_ < ((k) == PROBE_PH ? PROBE_N : 1); ++rep_)
#ifndef MK_ONE_LAUNCH
#define MK_ONE_LAUNCH 1
#endif

namespace pg8 {
#define PG8_LAS __attribute__((address_space(3)))
typedef unsigned short bf16_t;
typedef short bf16x8 __attribute__((ext_vector_type(8)));
typedef float f32x4 __attribute__((ext_vector_type(4)));
typedef unsigned u32x4 __attribute__((ext_vector_type(4)));
constexpr int BM = 256, BK = 64, HALF = 128, HTB = HALF * BK * 2  , STAGE_BYTES = 8 * HTB, NXCD = 8, WGM = 8;

__host__ __device__ __forceinline__ int lds_byte(int r, int c) { const int st = (r >> 4) * 2 + (c >> 5), rr = r & 15, cc = c & 31, ob = rr * 64 + cc * 2; return st * 1024 + (ob ^ (((ob >> 9) & 1) << 5)); }
__host__ __device__ __forceinline__ void stage_rc(int b, int& R, int& C) { const int st = b / 1024, sb = b % 1024, swz = sb ^ (((sb >> 9) & 1) << 5); R = (st >> 1) * 16 + swz / 64; C = (st & 1) * 32 + (swz % 64) / 2; }
__host__ __device__ __forceinline__ int perm32(int rho) { const int n = rho >> 4, i = rho & 15; return 8 * (i >> 2) + 4 * n + (i & 3); }

struct Unit { int pm, pn; };
struct Gemm { const bf16_t* A; const bf16_t* Bt; int M, N, K; };

struct StaticOrder {
    int nM, nN, nwg, G, c;
    __host__ __device__ void init(int M, int N, int G_, int c_) { nM = M / BM; nN = N / BM; nwg = nM * nN; G = G_; c = c_; }
    __host__ __device__ bool next(int i, Unit& u) const {
        const long L = (long)i * G + c; if (L >= nwg) return false;
        int wgid = (int)L; { const int q = nwg / NXCD, r = nwg % NXCD, xcd = wgid % NXCD, off = wgid / NXCD; wgid = (xcd < r ? xcd * (q + 1) : r * (q + 1) + (xcd - r) * q) + off; }
        const int nig = WGM * nN, gid = wgid / nig, fm = gid * WGM, gsz = (nM - fm) < WGM ? (nM - fm) : WGM;
        u.pm = fm + ((wgid % nig) % gsz); u.pn = (wgid % nig) / gsz; return true;
    }
    __device__ __forceinline__ void a_ready(const Unit&) const {}
    __device__ __forceinline__ void done(const Unit&) const {}
};

__device__ __forceinline__ unsigned cvt_pk_bf16(float lo, float hi) { unsigned r; asm volatile("v_cvt_pk_bf16_f32 %0, %1, %2" : "=v"(r) : "v"(lo), "v"(hi)); return r; }
typedef float f32x2 __attribute__((ext_vector_type(2)));
__device__ __forceinline__ float silu_f(float v) { return v / (1.0f + __expf(-v)); }
template <int ACT> struct EpiBf16 {
    static constexpr bool PERM = true, AFTER_DRAIN = false;
    bf16_t* O; int ldc; const float* rs;
    __device__ __forceinline__ void operator()(const f32x4 (&acc)[2][2][4][2], const Unit& u, int wr, int wc, int fr, int fq) const {
        const int row0 = u.pm * BM + wr * 64 + fr; const int col0 = u.pn * BM + wc * 32 + 8 * fq;
#pragma unroll
        for (int ai = 0; ai < 2; ++ai)
#pragma unroll
            for (int m = 0; m < 4; ++m) { bf16_t* rowp = O + (size_t)(row0 + ai * HALF + m * 16) * ldc + col0; const float sc = rs ? rs[row0 + ai * HALF + m * 16] : 1.0f;
#pragma unroll
                for (int bj = 0; bj < 2; ++bj) { f32x4 v0 = acc[ai][bj][m][0] * sc, v1 = acc[ai][bj][m][1] * sc;
                    if (ACT == 1) {
#pragma unroll
                        for (int j = 0; j < 4; ++j) { v0[j] = silu_f(v0[j]); v1[j] = silu_f(v1[j]); } }
                    u32x4 w; w.x = cvt_pk_bf16(v0[0], v0[1]); w.y = cvt_pk_bf16(v0[2], v0[3]); w.z = cvt_pk_bf16(v1[0], v1[1]); w.w = cvt_pk_bf16(v1[2], v1[3]);
                    *(u32x4*)(rowp + bj * HALF) = w; } }
    }
};
struct EpiSwiGLU {
    static constexpr bool PERM = true, AFTER_DRAIN = false;
    bf16_t* O; int ldc; const float* rs;
    __device__ __forceinline__ void operator()(const f32x4 (&acc)[2][2][4][2], const Unit& u, int wr, int wc, int fr, int fq) const {
        const int row0 = u.pm * BM + wr * 64 + fr; const int col0 = u.pn * HALF + wc * 32 + 8 * fq;
#pragma unroll
        for (int ai = 0; ai < 2; ++ai)
#pragma unroll
            for (int m = 0; m < 4; ++m) { bf16_t* rowp = O + (size_t)(row0 + ai * HALF + m * 16) * ldc + col0; const float sc = rs[row0 + ai * HALF + m * 16];
                f32x4 g0 = acc[ai][0][m][0] * sc, g1 = acc[ai][0][m][1] * sc; const f32x4 u0 = acc[ai][1][m][0] * sc, u1 = acc[ai][1][m][1] * sc;
#pragma unroll
                for (int j = 0; j < 4; ++j) { g0[j] = silu_f(g0[j]) * u0[j]; g1[j] = silu_f(g1[j]) * u1[j]; }
                u32x4 w; w.x = cvt_pk_bf16(g0[0], g0[1]); w.y = cvt_pk_bf16(g0[2], g0[3]); w.z = cvt_pk_bf16(g1[0], g1[1]); w.w = cvt_pk_bf16(g1[2], g1[3]);
                *(u32x4*)rowp = w; }
    }
};

template <class Epi, class Sched, bool ALIGN_EPI = false, bool SP2 = false>
__device__ __forceinline__ void gemm_phase(PG8_LAS unsigned char* lds, const Gemm g, const Sched& S, const Epi& E) {
    int tid = threadIdx.x; asm volatile("" : "+v"(tid));
    const int wid = __builtin_amdgcn_readfirstlane(tid >> 6), lane = tid & 63, wr = wid >> 2, wc = wid & 3, fr = lane & 15, fq = lane >> 4;
    const int K = g.K, nt = K / BK;
    unsigned voffA[2], voffB[2];
#pragma unroll
    for (int i = 0; i < 2; ++i) { int R, C; stage_rc(tid * 16 + i * 8192, R, C); const int Rb = Epi::PERM ? ((R & ~31) + perm32(R & 31)) : R;
        voffA[i] = (unsigned)(R * K + C) * 2u; voffB[i] = (unsigned)(Rb * K + C) * 2u; }
    const size_t kstep = (size_t)(BK * 2);
    const size_t hstep = (size_t)HALF * K * 2;
    const size_t tstep = 2 * hstep;
    const unsigned ldsw = (unsigned)wid * 1024u;
    const int aoff = lds_byte(wr * 64 + fr, fq * 8), boff = lds_byte(wc * 32 + fr, fq * 8);
#define PG8_SA(b, h) (((b) * 2 + (h)) * HTB)
#define PG8_SB(b, h) ((4 + (b) * 2 + (h)) * HTB)
#define PG8_STAGE(bufoff, gbase, voff) do { _Pragma("unroll") for (int _i = 0; _i < 2; ++_i) \
        __builtin_amdgcn_global_load_lds((const unsigned*)((const char*)(gbase) + (voff)[_i]), (PG8_LAS unsigned*)(lds + (bufoff) + ldsw + _i * 8192), 16, 0, 0); } while (0)
#define PG8_LDA(dst, b, h) do { _Pragma("unroll") for (int m = 0; m < 4; ++m) _Pragma("unroll") for (int k = 0; k < 2; ++k) dst[m][k] = *(const PG8_LAS bf16x8*)(lds + PG8_SA(b, h) + aoff + m * 2048 + k * 1024); } while (0)
#define PG8_LDB(dst, b, h) do { _Pragma("unroll") for (int n = 0; n < 2; ++n) _Pragma("unroll") for (int k = 0; k < 2; ++k) dst[n][k] = *(const PG8_LAS bf16x8*)(lds + PG8_SB(b, h) + boff + n * 2048 + k * 1024); } while (0)
#define PG8_MMA(ai, bj, At, Bt) do { __builtin_amdgcn_s_setprio(1); _Pragma("unroll") for (int m = 0; m < 4; ++m) _Pragma("unroll") for (int n = 0; n < 2; ++n) _Pragma("unroll") for (int k = 0; k < 2; ++k) \
        acc[ai][bj][m][n] = __builtin_amdgcn_mfma_f32_16x16x32_bf16(Bt[n][k], At[m][k], acc[ai][bj][m][n], 0, 0, 0); __builtin_amdgcn_s_setprio(0); } while (0)
#define PG8_WAIT_V(n) asm volatile("s_waitcnt vmcnt(" #n ")" ::: "memory")
#define PG8_WAIT_L(n) asm volatile("s_waitcnt lgkmcnt(" #n ")" ::: "memory")
#define PG8_BAR __builtin_amdgcn_s_barrier()
#define PG8_SCHED __builtin_amdgcn_sched_barrier(0)
    Unit cur, nxt; int ui = 0;
    if (!S.next(0, cur)) return;
    f32x4 acc[2][2][4][2];
#pragma unroll
    for (int a = 0; a < 2; ++a)
#pragma unroll
        for (int b = 0; b < 2; ++b)
#pragma unroll
            for (int m = 0; m < 4; ++m)
#pragma unroll
                for (int n = 0; n < 2; ++n) acc[a][b][m][n] = (f32x4){0.f, 0.f, 0.f, 0.f};
    bf16x8 At[4][2], B0[2][2], B1[2][2];
    const char* cA = (const char*)g.A + (size_t)cur.pm * tstep; const char* cB = (const char*)g.Bt + (size_t)cur.pn * tstep;
    S.a_ready(cur);
    if constexpr (SP2) {
        PG8_STAGE(PG8_SB(0, 0), cB, voffB); PG8_STAGE(PG8_SB(0, 1), cB + hstep, voffB); PG8_STAGE(PG8_SA(0, 0), cA, voffA); PG8_STAGE(PG8_SA(0, 1), cA + hstep, voffA);
        if (wr == 1) PG8_BAR;
        PG8_WAIT_V(2); PG8_BAR;
        PG8_STAGE(PG8_SB(1, 0), cB + kstep, voffB); PG8_STAGE(PG8_SA(1, 0), cA + kstep, voffA); PG8_STAGE(PG8_SB(1, 1), cB + hstep + kstep, voffB);
        PG8_WAIT_V(6); PG8_BAR;
    } else {
        PG8_STAGE(PG8_SB(0, 0), cB, voffB); PG8_STAGE(PG8_SA(0, 0), cA, voffA); PG8_STAGE(PG8_SB(0, 1), cB + hstep, voffB); PG8_STAGE(PG8_SA(0, 1), cA + hstep, voffA);
        if (wr == 1) PG8_BAR;
        PG8_WAIT_V(4); PG8_BAR;
        PG8_STAGE(PG8_SB(1, 0), cB + kstep, voffB); PG8_STAGE(PG8_SA(1, 0), cA + kstep, voffA); PG8_STAGE(PG8_SB(1, 1), cB + hstep + kstep, voffB);
        PG8_WAIT_V(6); PG8_BAR;
    }
    for (;;) {
        const bool has_next = S.next(ui + 1, nxt);
        const char* nA = has_next ? (const char*)g.A + (size_t)nxt.pm * tstep : cA; const char* nB = has_next ? (const char*)g.Bt + (size_t)nxt.pn * tstep : cB;
        for (int t = 0; t < nt; t += 2) {
            const bool last = (t == nt - 2);
            const char* a1 = cA + (size_t)(t + 1) * kstep;
            const char* a2 = last ? nA : cA + (size_t)(t + 2) * kstep; const char* b2 = last ? nB : cB + (size_t)(t + 2) * kstep;
            const char* a3 = a2 + kstep; const char* b3 = b2 + kstep;
            if (last && has_next) S.a_ready(nxt);
            if constexpr (SP2) {
            PG8_LDB(B0, 0, 0); PG8_LDB(B1, 0, 1); PG8_SCHED; PG8_LDA(At, 0, 0); PG8_STAGE(PG8_SA(1, 1), a1 + hstep, voffA);
            PG8_WAIT_V(8); PG8_WAIT_L(0); PG8_BAR; PG8_MMA(0, 0, At, B0); PG8_MMA(0, 1, At, B1); PG8_BAR; PG8_SCHED;
            PG8_LDA(At, 0, 1); PG8_STAGE(PG8_SB(0, 0), b2, voffB); PG8_STAGE(PG8_SB(0, 1), b2 + hstep, voffB); PG8_STAGE(PG8_SA(0, 0), a2, voffA);
            PG8_WAIT_V(8); PG8_WAIT_L(0); PG8_BAR; PG8_MMA(1, 0, At, B0); PG8_MMA(1, 1, At, B1); PG8_BAR; PG8_SCHED;
            PG8_LDB(B0, 1, 0); PG8_LDB(B1, 1, 1); PG8_SCHED; PG8_LDA(At, 1, 0); PG8_STAGE(PG8_SA(0, 1), a2 + hstep, voffA);
            PG8_WAIT_V(8); PG8_WAIT_L(0); PG8_BAR; PG8_MMA(0, 0, At, B0); PG8_MMA(0, 1, At, B1); PG8_BAR; PG8_SCHED;
            PG8_LDA(At, 1, 1); PG8_STAGE(PG8_SB(1, 0), b3, voffB); PG8_STAGE(PG8_SB(1, 1), b3 + hstep, voffB); PG8_STAGE(PG8_SA(1, 0), a3, voffA);
            PG8_WAIT_V(8); PG8_WAIT_L(0); PG8_BAR; PG8_MMA(1, 0, At, B0); PG8_MMA(1, 1, At, B1); PG8_BAR; PG8_SCHED;
            } else {
            PG8_LDB(B0, 0, 0); PG8_SCHED; PG8_LDA(At, 0, 0); PG8_STAGE(PG8_SA(1, 1), a1 + hstep, voffA);
            PG8_WAIT_L(8); PG8_BAR; PG8_WAIT_L(0); PG8_MMA(0, 0, At, B0); PG8_BAR; PG8_SCHED;
            PG8_LDB(B1, 0, 1); PG8_STAGE(PG8_SB(0, 0), b2, voffB);
            PG8_BAR; PG8_WAIT_L(0); PG8_MMA(0, 1, At, B1); PG8_BAR;
            PG8_LDA(At, 0, 1); PG8_STAGE(PG8_SA(0, 0), a2, voffA);
            PG8_BAR; PG8_WAIT_L(0); PG8_MMA(1, 0, At, B0); PG8_BAR; PG8_SCHED;
            PG8_STAGE(PG8_SB(0, 1), b2 + hstep, voffB);
            PG8_WAIT_V(6); PG8_BAR; PG8_MMA(1, 1, At, B1); PG8_BAR;
            PG8_LDB(B0, 1, 0); PG8_SCHED; PG8_LDA(At, 1, 0); PG8_STAGE(PG8_SA(0, 1), a2 + hstep, voffA);
            PG8_WAIT_L(8); PG8_BAR; PG8_WAIT_L(0); PG8_MMA(0, 0, At, B0); PG8_BAR; PG8_SCHED;
            PG8_LDB(B1, 1, 1); PG8_STAGE(PG8_SB(1, 0), b3, voffB);
            PG8_BAR; PG8_WAIT_L(0); PG8_MMA(0, 1, At, B1); PG8_BAR;
            PG8_LDA(At, 1, 1); PG8_STAGE(PG8_SA(1, 0), a3, voffA);
            PG8_BAR; PG8_WAIT_L(0); PG8_MMA(1, 0, At, B0); PG8_BAR; PG8_SCHED;
            PG8_STAGE(PG8_SB(1, 1), b3 + hstep, voffB);
            PG8_WAIT_V(6); PG8_BAR; PG8_MMA(1, 1, At, B1); PG8_BAR;
            }
        }
        if constexpr (ALIGN_EPI) { if (wr == 0) PG8_BAR; }
        if constexpr (!Epi::AFTER_DRAIN) { E(acc, cur, wr, wc, fr, fq); S.done(cur); }
        if (!has_next) break;
#pragma unroll
        for (int a = 0; a < 2; ++a)
#pragma unroll
            for (int b = 0; b < 2; ++b)
#pragma unroll
                for (int m = 0; m < 4; ++m)
#pragma unroll
                    for (int n = 0; n < 2; ++n) acc[a][b][m][n] = (f32x4){0.f, 0.f, 0.f, 0.f};
        cur = nxt; cA = nA; cB = nB; ++ui;
        if constexpr (ALIGN_EPI) { if (wr == 1) PG8_BAR; }
    }
    PG8_WAIT_V(0);
    if constexpr (!ALIGN_EPI) { if (wr == 0) PG8_BAR; }
    PG8_BAR;
    if constexpr (Epi::AFTER_DRAIN) { E.fused(acc, cur, wr, wc, fr, fq, lds, wid, lane); S.done(cur); }
#undef PG8_SA
#undef PG8_SB
#undef PG8_STAGE
#undef PG8_LDA
#undef PG8_LDB
#undef PG8_MMA
#undef PG8_WAIT_V
#undef PG8_WAIT_L
#undef PG8_BAR
#undef PG8_SCHED
}
}

constexpr int NWAVES = 8, NTHR = 512;
constexpr int BATCH = 32, SEQ = 2048, DM = 1024, DEPTH = 2, MTOK = BATCH * SEQ;
constexpr int NIN = 3230, NINP = 3328, DFF = 2816, NGU = 2 * DFF;
constexpr int PC_QKV = 0, PC_Z = 1152, PC_CF = 1536, PC_NQ = 2048, PC_KC = 2432, PC_VC = 2560, PC_KS = 2688, PC_VS = 2816, PC_KW = 2944, PC_VW = 3072, PC_B = 3200, PC_A = 3206, PC_GATE = 3212;
constexpr float EPS = 1e-6f;
constexpr int CMP_ROWS = 16384, CMP_K = 2048;
constexpr int NPH = 10;

constexpr size_t MiB = 1u << 20;
constexpr size_t WS_CTL = 0, CTL_ZERO_BYTES = 1 * MiB;
constexpr size_t WS_WIN = 2 * MiB;
constexpr size_t WS_WOUT = 16 * MiB;
constexpr size_t WS_WGU = 20 * MiB;
constexpr size_t WS_WD = 42 * MiB;
constexpr size_t WS_WC1 = 53 * MiB;
constexpr size_t WS_W2T = 55 * MiB;
constexpr size_t WS_KC = 56 * MiB;
constexpr size_t WS_VCT = 57 * MiB;
constexpr size_t WS_PROJ = 64 * MiB;
constexpr size_t WS_MIX = 480 * MiB;
constexpr size_t WS_MBUF = 608 * MiB;
constexpr size_t WS_XB = 736 * MiB;
constexpr size_t WS_ACMP = 864 * MiB;
constexpr size_t WS_HID = 928 * MiB;
constexpr size_t WS_KS = 936 * MiB, WS_KW = 952 * MiB, WS_VST = 968 * MiB, WS_VWT = 984 * MiB;
constexpr size_t WS_DNF = WS_MBUF;
constexpr size_t WS_GT = 1000 * MiB;
constexpr size_t WS_RSTD = 1001 * MiB;
constexpr size_t WS_END = 1002 * MiB;
constexpr int CW_TMO = 0, CW_BAR = 4096;

constexpr int RING_OFF = 0, RING_BYTES = 131072, XTRA_OFF = 147456;
constexpr int LDSCTL_OFF = RING_BYTES, MISC_OFF = LDSCTL_OFF + 320;
constexpr int LDS_BYTES = 163840;

#define GAS __attribute__((address_space(1)))
#define LAS __attribute__((address_space(3)))
typedef unsigned short bf16;
typedef unsigned v4u __attribute__((ext_vector_type(4)));
typedef unsigned v2u __attribute__((ext_vector_type(2)));
typedef float f32x4 __attribute__((ext_vector_type(4)));
typedef float f32x2 __attribute__((ext_vector_type(2)));
typedef short bf16x8 __attribute__((ext_vector_type(8)));
struct Args;
typedef __bf16 bf16x2_t __attribute__((ext_vector_type(2)));
#define LDS_WAIT() asm volatile("s_waitcnt lgkmcnt(0)" ::: "memory")
#define VM_WAIT() asm volatile("s_waitcnt vmcnt(0)" ::: "memory")
__device__ __forceinline__ unsigned cvtpk(float lo, float hi) { f32x2 v = {lo, hi}; bf16x2_t b = __builtin_convertvector(v, bf16x2_t); return __builtin_bit_cast(unsigned, b); }
__device__ __forceinline__ bf16 f2bf(float f) { return (bf16)(cvtpk(f, 0.f) & 0xffffu); }
__device__ __forceinline__ float bf2f(bf16 v) { return __uint_as_float(((unsigned)v) << 16); }
__device__ __forceinline__ float bflo(unsigned w) { return __uint_as_float(w << 16); }
__device__ __forceinline__ float bfhi(unsigned w) { return __uint_as_float(w & 0xffff0000u); }
__device__ __forceinline__ float sigmoid_f(float v) { return __builtin_amdgcn_rcpf(1.0f + __builtin_amdgcn_exp2f(-1.4426950408889634f * v)); }
__device__ __forceinline__ float silu_f(float v) { return v * sigmoid_f(v); }
__device__ __forceinline__ float wave_sum(float v) {
#pragma unroll
    for (int o = 1; o < 64; o <<= 1) v += __shfl_xor(v, o);
    return v;
}

#define XB_TMO      128
#define XB_XCNT(j)  (256  + 64 * (j))
#define XB_XSUB(j)  (1280 + 64 * (j))
#define XB_XGEN(j)  (2304 + 64 * (j))
#define XB_TOP      3328
#define XB_TOPGEN   3392
#define XCD_BAR_WORDS 3456
#define XB_SPIN_CAP (1u << 18)
__device__ __forceinline__ unsigned xb_ld(unsigned* p)              { return __hip_atomic_load(p, __ATOMIC_RELAXED, __HIP_MEMORY_SCOPE_AGENT); }
__device__ __forceinline__ unsigned xb_add(unsigned* p, unsigned v) { return __hip_atomic_fetch_add(p, v, __ATOMIC_RELAXED, __HIP_MEMORY_SCOPE_AGENT); }
__device__ __forceinline__ unsigned xb_xcc_id() { return (unsigned)__builtin_amdgcn_s_getreg((3 << 11) | 20) & 0xFu; }
#define XB_SPIN(cond, bar) do { unsigned _sp = 0; while (cond) { __builtin_amdgcn_s_sleep(1); \
    if ((++_sp & 255u) == 0u) { if (xb_ld(&(bar)[XB_TMO])) break; if (_sp > XB_SPIN_CAP) { atomicAdd(&(bar)[XB_TMO], 1u); break; } } } } while (0)
struct XcdBarrier { unsigned* bar; unsigned x; volatile LAS unsigned* st; };
__device__ __forceinline__ XcdBarrier xcd_barrier_post(unsigned* bar, volatile LAS unsigned* st) {
    XcdBarrier b; b.bar = bar; b.x = xb_xcc_id(); b.st = st;
    if (threadIdx.x == 0) (void)xb_add(&bar[XB_XCNT(b.x)], 1u);
    return b;
}
__device__ __forceinline__ void xcd_barrier_complete(unsigned* bar, unsigned x, unsigned& nloc, unsigned& nx) {
    const unsigned G = gridDim.x * gridDim.y * gridDim.z;
    unsigned sum, cnt, mine, sp = 0u;
    for (;;) {
        sum = 0u; cnt = 0u; mine = 0u;
#pragma unroll
        for (unsigned j = 0; j < 16; ++j) { const unsigned c = xb_ld(&bar[XB_XCNT(j)]); sum += c; cnt += (c > 0u) ? 1u : 0u; mine = (j == x) ? c : mine; }
        if (sum == G) break;
        __builtin_amdgcn_s_sleep(1);
        if ((++sp & 255u) == 0u) { if (xb_ld(&bar[XB_TMO])) break; if (sp > XB_SPIN_CAP) { atomicAdd(&bar[XB_TMO], 1u); break; } }
    }
    nloc = mine > 0u ? mine : 1u; nx = cnt > 0u ? cnt : 1u;
}
__device__ __forceinline__ void xcd_barrier(const XcdBarrier& b) {
    asm volatile("s_waitcnt vmcnt(0)" ::: "memory");
    __syncthreads();
    if (threadIdx.x == 0) {
        unsigned* bar = b.bar;
        __builtin_amdgcn_s_waitcnt(0);
        unsigned nloc = b.st[0], nx = b.st[1];
        if (nloc == 0u) { xcd_barrier_complete(bar, b.x, nloc, nx); b.st[0] = nloc; b.st[1] = nx; }
        const unsigned old = xb_add(&bar[XB_XSUB(b.x)], 1u);
        const unsigned gen = old / nloc;
        if (old + 1u == (gen + 1u) * nloc) {
            __builtin_amdgcn_fence(__ATOMIC_RELEASE, "agent");
            asm volatile("s_waitcnt vmcnt(0)" ::: "memory");
            const unsigned og = xb_add(&bar[XB_TOP], 1u);
            const unsigned tg = og / nx;
            if (og + 1u == (tg + 1u) * nx) xb_add(&bar[XB_TOPGEN], 1u);
            else XB_SPIN(xb_ld(&bar[XB_TOPGEN]) == tg, bar);
            __builtin_amdgcn_fence(__ATOMIC_ACQUIRE, "agent");
            xb_add(&bar[XB_XGEN(b.x)], 1u);
            asm volatile("s_waitcnt vmcnt(0)" ::: "memory");
        } else {
            XB_SPIN(xb_ld(&bar[XB_XGEN(b.x)]) == gen, bar);
            __builtin_amdgcn_fence(__ATOMIC_ACQUIRE, "agent");
            asm volatile("s_waitcnt vmcnt(0)" ::: "memory");
        }
    }
    __syncthreads();
}

template <class SrcFn>
__device__ __forceinline__ void wprep_item(const SrcFn& src, int K, bf16* WT, LAS float* scr, int item, int nblk, int lane) {
    const int kb = item / nblk, nb = item % nblk, k0 = 64 * kb, n0 = 32 * nb;
#pragma unroll 8
    for (int i = 0; i < 32; ++i) { const int kk = 2 * i + (lane >> 5); scr[kk * 33 + (lane & 31)] = src(k0 + kk, n0 + (lane & 31)); }
    LDS_WAIT(); asm volatile("" ::: "memory");
    const int c = lane & 7;
#pragma unroll
    for (int j = 0; j < 4; ++j) { const int n = (lane >> 3) + 8 * j; const LAS float* s = scr + (8 * c) * 33 + n;
        v4u o; o.x = cvtpk(s[0 * 33], s[1 * 33]); o.y = cvtpk(s[2 * 33], s[3 * 33]); o.z = cvtpk(s[4 * 33], s[5 * 33]); o.w = cvtpk(s[6 * 33], s[7 * 33]);
        *(v4u*)(WT + (size_t)(n0 + n) * K + k0 + 8 * c) = o; }
    LDS_WAIT(); asm volatile("" ::: "memory");
}
__device__ __forceinline__ int win_src_col(int n) {
    return n < 1536 ? n : (n < 3200 ? n + 12 : (n < 3212 ? n - 3200 + 1536 : (n < NIN ? n : -1)));
}
__device__ __forceinline__ void x_row_to_bf16(const float* xrow, bf16* orow, float* rstd, int lane) {
    const f32x4* xr = (const f32x4*)xrow + lane;
    f32x4 v[4]; float s = 0.f;
#pragma unroll
    for (int j = 0; j < 4; ++j) { v[j] = xr[64 * j]; s += (v[j].x * v[j].x + v[j].y * v[j].y) + (v[j].z * v[j].z + v[j].w * v[j].w); }
    const float r = rsqrtf(wave_sum(s) * (1.f / DM) + EPS);
    if (lane == 0) *rstd = r;
    v2u* o8 = (v2u*)orow + lane;
#pragma unroll
    for (int j = 0; j < 4; ++j) { v2u w; w.x = cvtpk(v[j].x, v[j].y); w.y = cvtpk(v[j].z, v[j].w); o8[64 * j] = w; }
}
template <bool XIN_F32, bool FINAL>
__device__ __forceinline__ void resid_row2(const void* xrowA, const void* xrowB, const bf16* mrowA, const bf16* mrowB, const float* wpost, void* orowA, void* orowB, float* rstdA, float* rstdB, int lane) {
    const f32x4* wr = (const f32x4*)wpost + lane;
    f32x4 xa[4], xb[4], ma[4], mb[4]; float sa = 0.f, sb = 0.f;
#pragma unroll
    for (int j = 0; j < 4; ++j) {
        if (XIN_F32) { xa[j] = ((const f32x4*)xrowA + lane)[64 * j]; xb[j] = ((const f32x4*)xrowB + lane)[64 * j]; }
        else { const v2u wa = ((const v2u*)xrowA + lane)[64 * j], wb = ((const v2u*)xrowB + lane)[64 * j];
            xa[j] = (f32x4){bflo(wa.x), bfhi(wa.x), bflo(wa.y), bfhi(wa.y)}; xb[j] = (f32x4){bflo(wb.x), bfhi(wb.x), bflo(wb.y), bfhi(wb.y)}; }
        const v2u wa = ((const v2u*)mrowA + lane)[64 * j], wb = ((const v2u*)mrowB + lane)[64 * j];
        ma[j] = (f32x4){bflo(wa.x), bfhi(wa.x), bflo(wa.y), bfhi(wa.y)}; mb[j] = (f32x4){bflo(wb.x), bfhi(wb.x), bflo(wb.y), bfhi(wb.y)};
        sa += (ma[j].x * ma[j].x + ma[j].y * ma[j].y) + (ma[j].z * ma[j].z + ma[j].w * ma[j].w); sb += (mb[j].x * mb[j].x + mb[j].y * mb[j].y) + (mb[j].z * mb[j].z + mb[j].w * mb[j].w); }
#pragma unroll
    for (int o = 1; o < 64; o <<= 1) { sa += __shfl_xor(sa, o); sb += __shfl_xor(sb, o); }
    const float ra = rsqrtf(sa * (1.f / DM) + EPS), rb = rsqrtf(sb * (1.f / DM) + EPS);
    float s2a = 0.f, s2b = 0.f;
#pragma unroll
    for (int j = 0; j < 4; ++j) { const f32x4 w = wr[64 * j]; xa[j] = xa[j] + ma[j] * ra * w; xb[j] = xb[j] + mb[j] * rb * w;
        s2a += (xa[j].x * xa[j].x + xa[j].y * xa[j].y) + (xa[j].z * xa[j].z + xa[j].w * xa[j].w); s2b += (xb[j].x * xb[j].x + xb[j].y * xb[j].y) + (xb[j].z * xb[j].z + xb[j].w * xb[j].w); }
    if (FINAL) { f32x4* oa = (f32x4*)orowA + lane; f32x4* ob = (f32x4*)orowB + lane;
#pragma unroll
        for (int j = 0; j < 4; ++j) { oa[64 * j] = xa[j]; ob[64 * j] = xb[j]; }
    } else {
#pragma unroll
        for (int o = 1; o < 64; o <<= 1) { s2a += __shfl_xor(s2a, o); s2b += __shfl_xor(s2b, o); }
        if (lane == 0) { *rstdA = rsqrtf(s2a * (1.f / DM) + EPS); *rstdB = rsqrtf(s2b * (1.f / DM) + EPS); }
        v2u* oa = (v2u*)orowA + lane; v2u* ob = (v2u*)orowB + lane;
#pragma unroll
        for (int j = 0; j < 4; ++j) { v2u w; w.x = cvtpk(xa[j].x, xa[j].y); w.y = cvtpk(xa[j].z, xa[j].w); oa[64 * j] = w; w.x = cvtpk(xb[j].x, xb[j].y); w.y = cvtpk(xb[j].z, xb[j].w); ob[64 * j] = w; } }
}

#define MFMA16(a, b, c) __builtin_amdgcn_mfma_f32_16x16x32_bf16((a), (b), (c), 0, 0, 0)
__device__ __forceinline__ bf16x8 pack8(const f32x4& a, const f32x4& b) {
    v4u w; w.x = cvtpk(a[0], a[1]); w.y = cvtpk(a[2], a[3]); w.z = cvtpk(b[0], b[1]); w.w = cvtpk(b[2], b[3]); return __builtin_bit_cast(bf16x8, w);
}
constexpr float NSA_SC = 0.125f * 1.4426950408889634f;
__device__ __forceinline__ void nsa_load(const bf16* __restrict__ kbase, const bf16* __restrict__ vtbase, int vt_ld, int key0, bf16x8 (&ka)[2][2], bf16x8 (&va)[4], int c, int gq) {
#pragma unroll
    for (int sub = 0; sub < 2; ++sub)
#pragma unroll
        for (int s = 0; s < 2; ++s) ka[sub][s] = *(const bf16x8*)(kbase + (size_t)(key0 + 16 * sub + c) * 64 + 32 * s + 8 * gq);
#pragma unroll
    for (int dt = 0; dt < 4; ++dt) va[dt] = *(const bf16x8*)(vtbase + (size_t)(16 * dt + c) * vt_ld + key0 + 8 * gq);
}
template <int MODE>
__device__ __forceinline__ void nsa_step(const bf16x8 (&ka)[2][2], const bf16x8 (&va)[4], int key0, int tq, bool selbit, bool masked  ,
                                         const LAS bf16x8* ql, float (&mrun)[3], float (&lrun)[3], f32x4 (&O)[3][4], int gq) {
    const int kA = key0 + 4 * gq;
#pragma unroll
    for (int h = 0; h < 3; ++h) {
        const bf16x8 q0 = ql[64 * (2 * h)], q1 = ql[64 * (2 * h + 1)];
        f32x4 sA = {0.f, 0.f, 0.f, 0.f}, sB = {0.f, 0.f, 0.f, 0.f};
        sA = MFMA16(ka[0][0], q0, sA); sA = MFMA16(ka[0][1], q1, sA);
        sB = MFMA16(ka[1][0], q0, sB); sB = MFMA16(ka[1][1], q1, sB);
        float v[8];
#pragma unroll
        for (int r = 0; r < 4; ++r) { v[r] = sA[r]; v[4 + r] = sB[r]; }
        if (masked) {
#pragma unroll
            for (int r = 0; r < 4; ++r) { const int k1 = kA + r, k2 = kA + 16 + r;
                const bool ok1 = (MODE == 0) ? (k1 <= tq && k1 > tq - 512) : (selbit && k1 <= tq);
                const bool ok2 = (MODE == 0) ? (k2 <= tq && k2 > tq - 512) : (selbit && k2 <= tq);
                v[r] = ok1 ? v[r] : -1e30f; v[4 + r] = ok2 ? v[4 + r] : -1e30f; } }
        const float lm = fmaxf(fmaxf(fmaxf(v[0], v[1]), fmaxf(v[2], v[3])), fmaxf(fmaxf(v[4], v[5]), fmaxf(v[6], v[7])));
        if (__any(lm > mrun[h] + 8.0f)) {
            float mx = fmaxf(lm, __shfl_xor(lm, 16)); mx = fmaxf(mx, __shfl_xor(mx, 32));
            const float mnew = fmaxf(mrun[h], mx); const float alpha = __builtin_amdgcn_exp2f(mrun[h] - mnew); mrun[h] = mnew; lrun[h] *= alpha;
#pragma unroll
            for (int dt = 0; dt < 4; ++dt) O[h][dt] = O[h][dt] * alpha; }
        const float mh = mrun[h];
        float p[8]; float ps = 0.f;
#pragma unroll
        for (int i = 0; i < 8; ++i) { p[i] = __builtin_amdgcn_exp2f(v[i] - mh); ps += p[i]; }
        lrun[h] += ps;
        const bf16x8 pf = pack8((f32x4){p[0], p[1], p[2], p[3]}, (f32x4){p[4], p[5], p[6], p[7]});
#pragma unroll
        for (int dt = 0; dt < 4; ++dt) O[h][dt] = MFMA16(va[dt], pf, O[h][dt]);
    }
}
#define LDS_BAR() do { asm volatile("s_waitcnt lgkmcnt(0)" ::: "memory"); __builtin_amdgcn_s_barrier(); asm volatile("" ::: "memory"); } while (0)
constexpr int NSA_WSTRIDE = 12288, NSA_VCT = 98304, NSA_KC = 133120;
static_assert(8 * NSA_WSTRIDE <= NSA_VCT && NSA_VCT + 64 * 272 <= 131072 && NSA_KC >= LDSCTL_OFF + 2048 && NSA_KC + 128 * 144 <= LDS_BYTES, "NSA LDS map");
constexpr int NSA_SLOT0 = NSA_VCT, NSA_SLOT1 = NSA_KC, NSA_HMX = LDSCTL_OFF + 1024;
static_assert(NSA_SLOT0 + 18432 <= 131072 && NSA_SLOT1 + 18432 <= LDS_BYTES, "NSA tile ring");
template <int MODE>
__device__ __forceinline__ void nsa_coop_loop(LAS unsigned char* lds, const bf16* __restrict__ kbase, const bf16* __restrict__ vtbase, int klo, int ntile, unsigned um_blk, unsigned long long hm_wave,
                                              int t0, int tq, unsigned selmask, const LAS bf16x8* ql, float (&mrun)[3], float (&lrun)[3], f32x4 (&O)[3][4], int tid, int c, int gq) {
    const bf16* tbk = kbase + (tid >> 3) * 64 + (tid & 7) * 8; const bf16* tbv = vtbase + (size_t)(tid >> 3) * SEQ + (tid & 7) * 8;
    const int ldst = (tid >> 3) * 144 + (tid & 7) * 16;
    int keyP = klo; unsigned umP = um_blk, umC = um_blk;
#define NSA_NEXTP(dk, dv) do { int k_; if (MODE == 0) { k_ = keyP; keyP += 64; } else { k_ = 64 * __builtin_ctz(umP); umP &= umP - 1u; } dk = *(const v4u*)(tbk + (size_t)k_ * 64); dv = *(const v4u*)(tbv + k_); } while (0)
#define NSA_COMMIT(sk, sv, slot) do { *(LAS v4u*)(lds + (slot) + ldst) = (sk); *(LAS v4u*)(lds + (slot) + 9216 + ldst) = (sv); } while (0)
#define NSA_COMPUTE(slot, sidx) do { int keyt_; if (MODE == 0) keyt_ = klo + 64 * (sidx); else { keyt_ = 64 * __builtin_ctz(umC); umC &= umC - 1u; } \
        _Pragma("unroll") for (int hf_ = 0; hf_ < 2; ++hf_) { const int key0_ = keyt_ + 32 * hf_; \
        const bool rel_ = (MODE == 0) ? (key0_ <= t0 + 15 && key0_ + 31 >= t0 - 511) : (bool)((hm_wave >> (key0_ >> 5)) & 1ull); \
        if (rel_) { bf16x8 ka_[2][2], va_[4]; \
            _Pragma("unroll") for (int sub_ = 0; sub_ < 2; ++sub_) _Pragma("unroll") for (int s_ = 0; s_ < 2; ++s_) ka_[sub_][s_] = *(const LAS bf16x8*)(lds + (slot) + (32 * hf_ + 16 * sub_ + c) * 144 + 64 * s_ + 16 * gq); \
            _Pragma("unroll") for (int dt_ = 0; dt_ < 4; ++dt_) va_[dt_] = *(const LAS bf16x8*)(lds + (slot) + 9216 + (16 * dt_ + c) * 144 + 64 * hf_ + 16 * gq); \
            if (MODE == 0) nsa_step<0>(ka_, va_, key0_, tq, true, !(key0_ + 31 <= t0 && key0_ > t0 + 15 - 512), ql, mrun, lrun, O, gq); \
            else { const bool sb_ = (selmask >> (key0_ >> 6)) & 1u; nsa_step<1>(ka_, va_, key0_, tq, sb_, !(key0_ + 31 <= t0 && __all(sb_)), ql, mrun, lrun, O, gq); } } } } while (0)
    v4u K0 = {0u, 0u, 0u, 0u}, V0 = K0, K1 = K0, V1 = K0;
    if (ntile > 0) NSA_NEXTP(K0, V0);
    LDS_BAR();
    if (ntile > 0) NSA_COMMIT(K0, V0, NSA_SLOT0);
    if (ntile > 1) NSA_NEXTP(K0, V0);
    if (ntile > 2) NSA_NEXTP(K1, V1);
    LDS_BAR();
    for (int s = 0; s < ntile; s += 2) {
        if (s + 1 < ntile) NSA_COMMIT(K0, V0, NSA_SLOT1);
        if (s + 3 < ntile) NSA_NEXTP(K0, V0);
        NSA_COMPUTE(NSA_SLOT0, s);
        LDS_BAR();
        if (s + 1 >= ntile) break;
        if (s + 2 < ntile) NSA_COMMIT(K1, V1, NSA_SLOT0);
        if (s + 4 < ntile) NSA_NEXTP(K1, V1);
        NSA_COMPUTE(NSA_SLOT1, s + 1);
        LDS_BAR();
    }
#undef NSA_NEXTP
#undef NSA_COMMIT
#undef NSA_COMPUTE
}
struct NsaPtrs { const bf16* proj; const bf16* kc; const bf16* vct; const bf16* ks; const bf16* vst; const bf16* kw; const bf16* vwt; bf16* mix; };
__device__ __forceinline__ void nsa_stage_cmp(LAS unsigned char* lds, const NsaPtrs& P, int b, int g, int tid) {
    const bf16* kc = P.kc + (size_t)(b * 2 + g) * 128 * 64; const bf16* vct = P.vct + (size_t)(b * 2 + g) * 64 * 128;
#pragma unroll
    for (int q = 0; q < 2; ++q) { const int e = tid + NTHR * q;
        *(LAS v4u*)(lds + NSA_KC + (e >> 3) * 144 + (e & 7) * 16) = *(const v4u*)(kc + (e >> 3) * 64 + (e & 7) * 8);
        *(LAS v4u*)(lds + NSA_VCT + (e >> 4) * 272 + (e & 15) * 16) = *(const v4u*)(vct + (e >> 4) * 128 + (e & 15) * 8); }
}
__device__ __forceinline__ void nsa_item(const NsaPtrs& P, LAS unsigned char* lds, int wave, int b, int g, int t0, int tid, int lane) {
    asm volatile("" : "+v"(lane));
    const int c = lane & 15, gq = lane >> 4;
    const int tq = t0 + c, cur = t0 >> 6;
    const bf16* prow = P.proj + ((size_t)b * SEQ + tq) * NINP;
    LAS v2u* outl = (LAS v2u*)(lds + wave * NSA_WSTRIDE) + lane;
    LAS bf16x8* ql = (LAS bf16x8*)(lds + wave * NSA_WSTRIDE + 6144) + lane;
    unsigned graw[9];
    {
        v4u qr[6];
#pragma unroll
        for (int f = 0; f < 6; ++f) qr[f] = *(const v4u*)(prow + PC_NQ + (g * 3 + (f >> 1)) * 64 + 32 * (f & 1) + 8 * gq);
#pragma unroll
        for (int k = 0; k < 9; ++k) graw[k] = prow[PC_GATE + (k / 3) * 6 + g * 3 + (k % 3)];
#pragma unroll
        for (int f = 0; f < 6; ++f) { v4u qs; qs.x = cvtpk(bflo(qr[f].x) * NSA_SC, bfhi(qr[f].x) * NSA_SC); qs.y = cvtpk(bflo(qr[f].y) * NSA_SC, bfhi(qr[f].y) * NSA_SC);
            qs.z = cvtpk(bflo(qr[f].z) * NSA_SC, bfhi(qr[f].z) * NSA_SC); qs.w = cvtpk(bflo(qr[f].w) * NSA_SC, bfhi(qr[f].w) * NSA_SC);
            ql[64 * f] = __builtin_bit_cast(bf16x8, qs); }
    }
#define NSA_GATE(br, h) sigmoid_f(bf2f((bf16)graw[(br) * 3 + (h)]))
    asm volatile("" ::: "memory");
    float imp[8]; unsigned selmask = 0u;
    REP(31) {
#pragma unroll
    for (int st = 0; st < 8; ++st) imp[st] = 0.f;
    selmask = 0u;
    const int nvis = tq >= 31 ? ((tq - 31) >> 4) + 1 : 0;
#pragma unroll 1
    for (int h = 0; h < 3; ++h) {
        asm volatile("" ::: "memory");
        const bf16x8 qh0 = ql[64 * (2 * h)], qh1 = ql[64 * (2 * h + 1)];
        f32x4 s[8];
#pragma unroll
        for (int st = 0; st < 8; ++st) { const LAS unsigned char* kr = lds + NSA_KC + (16 * st + c) * 144 + 16 * gq;
            const bf16x8 a0 = *(const LAS bf16x8*)kr, a1 = *(const LAS bf16x8*)(kr + 64);
            f32x4 z = {0.f, 0.f, 0.f, 0.f}; z = MFMA16(a0, qh0, z); z = MFMA16(a1, qh1, z); s[st] = z; }
        float mx = -1e30f;
#pragma unroll
        for (int st = 0; st < 8; ++st)
#pragma unroll
            for (int r = 0; r < 4; ++r) { const int i = 16 * st + 4 * gq + r; const float v = (i < nvis) ? s[st][r] : -1e30f; s[st][r] = v; mx = fmaxf(mx, v); }
        mx = fmaxf(mx, __shfl_xor(mx, 16)); mx = fmaxf(mx, __shfl_xor(mx, 32)); mx = fmaxf(mx, -1e20f);
        float sum = 0.f;
#pragma unroll
        for (int st = 0; st < 8; ++st)
#pragma unroll
            for (int r = 0; r < 4; ++r) { const float p = __builtin_amdgcn_exp2f(s[st][r] - mx); s[st][r] = p; sum += p; }
        sum += __shfl_xor(sum, 16); sum += __shfl_xor(sum, 32);
        const float inv = sum > 0.f ? __builtin_amdgcn_rcpf(sum) : 0.f;
#pragma unroll
        for (int st = 0; st < 8; ++st) s[st] = s[st] * inv;
        float sh[8];
#pragma unroll
        for (int st = 0; st < 8; ++st) sh[st] = __shfl(s[st][3], (lane + 48) & 63);
#pragma unroll
        for (int st = 0; st < 8; ++st) { const float prev = gq > 0 ? sh[st] : (st > 0 ? sh[st > 0 ? st - 1 : 0] : 0.f);
            imp[st] += (s[st][0] + s[st][1]) + (s[st][2] + s[st][3]) + prev; }
        f32x4 Oc[4];
#pragma unroll
        for (int dt = 0; dt < 4; ++dt) Oc[dt] = (f32x4){0.f, 0.f, 0.f, 0.f};
#pragma unroll
        for (int ks = 0; ks < 4; ++ks) { const bf16x8 pf = pack8(s[2 * ks], s[2 * ks + 1]);
#pragma unroll
            for (int dt = 0; dt < 4; ++dt) { const bf16x8 vf = *(const LAS bf16x8*)(lds + NSA_VCT + (16 * dt + c) * 272 + 64 * ks + 16 * gq); Oc[dt] = MFMA16(vf, pf, Oc[dt]); } }
        { const float gt = sigmoid_f(bf2f((bf16)(h == 0 ? graw[0] : (h == 1 ? graw[1] : graw[2]))));
#pragma unroll
            for (int dt = 0; dt < 4; ++dt) { const f32x4 o = Oc[dt] * gt; v2u w; w.x = cvtpk(o[0], o[1]); w.y = cvtpk(o[2], o[3]); outl[64 * (4 * h + dt)] = w; } }
    }
    {
        unsigned key[8];
#pragma unroll
        for (int st = 0; st < 8; ++st) { const int j = 4 * st + gq; const bool elig = j <= cur, forced = (j == 0) || (j == cur) || (j == cur - 1);
            const float sc = elig ? (imp[st] + (forced ? 1e4f : 0.f)) : -1e4f; const unsigned u = __float_as_uint(sc);
            key[st] = (((u & 0x80000000u) ? ~u : (u | 0x80000000u)) & ~31u) | (unsigned)(31 - j); }
#pragma unroll
        for (int it = 0; it < 8; ++it) {
            unsigned bk = key[0];
#pragma unroll
            for (int st = 1; st < 8; ++st) bk = bk > key[st] ? bk : key[st];
            { const unsigned o = (unsigned)__shfl_xor((int)bk, 16); bk = bk > o ? bk : o; }
            { const unsigned o = (unsigned)__shfl_xor((int)bk, 32); bk = bk > o ? bk : o; }
            const int bj = 31 - (int)(bk & 31u);
            selmask |= 1u << bj;
#pragma unroll
            for (int st = 0; st < 8; ++st) if (4 * st + gq == bj) key[st] = 0u;
        }
    }
    }
    float mrun[3], lrun[3]; f32x4 O[3][4];
    {
        const bf16* kw = P.kw + (size_t)(b * 2 + g) * SEQ * 64; const bf16* vwt = P.vwt + (size_t)(b * 2 + g) * 64 * SEQ;
        REP(32) {
#pragma unroll
        for (int h = 0; h < 3; ++h) { mrun[h] = -1e20f; lrun[h] = 0.f;
#pragma unroll
            for (int dt = 0; dt < 4; ++dt) O[h][dt] = (f32x4){0.f, 0.f, 0.f, 0.f}; }
        asm volatile("" ::: "memory");
        { const int T0 = t0 - 16 * wave; int klo = T0 - 511; klo = klo < 0 ? 0 : klo; klo &= ~63; const int klast = (T0 + 127) & ~63;
            nsa_coop_loop<0>(lds, kw, vwt, klo, (klast - klo) / 64 + 1, 0u, 0ull, t0, tq, selmask, ql, mrun, lrun, O, tid, c, gq); }
        }
#pragma unroll
        for (int h = 0; h < 3; ++h) { float lt = lrun[h]; lt += __shfl_xor(lt, 16); lt += __shfl_xor(lt, 32); const float inv = lt > 0.f ? NSA_GATE(2, h) * __builtin_amdgcn_rcpf(lt) : 0.f;
#pragma unroll
            for (int dt = 0; dt < 4; ++dt) { const v2u w0 = outl[64 * (4 * h + dt)]; const f32x4 o = (f32x4){bflo(w0.x), bfhi(w0.x), bflo(w0.y), bfhi(w0.y)} + O[h][dt] * inv;
                v2u w; w.x = cvtpk(o[0], o[1]); w.y = cvtpk(o[2], o[3]); outl[64 * (4 * h + dt)] = w; } }
        asm volatile("" ::: "memory");
    }
    {
        const bf16* ks = P.ks + (size_t)(b * 2 + g) * SEQ * 64; const bf16* vst = P.vst + (size_t)(b * 2 + g) * 64 * SEQ;
        REP(33) {
#pragma unroll
        for (int h = 0; h < 3; ++h) { mrun[h] = -1e20f; lrun[h] = 0.f;
#pragma unroll
            for (int dt = 0; dt < 4; ++dt) O[h][dt] = (f32x4){0.f, 0.f, 0.f, 0.f}; }
        {
            unsigned um = selmask;
#pragma unroll
            for (int off = 1; off < 64; off <<= 1) um |= (unsigned)__shfl_xor((int)um, off);
            um = (unsigned)__builtin_amdgcn_readfirstlane((int)um) & ((2u << cur) - 1u);
            unsigned long long x = um;
            x = (x | (x << 16)) & 0x0000FFFF0000FFFFull; x = (x | (x << 8)) & 0x00FF00FF00FF00FFull; x = (x | (x << 4)) & 0x0F0F0F0F0F0F0F0Full;
            x = (x | (x << 2)) & 0x3333333333333333ull; x = (x | (x << 1)) & 0x5555555555555555ull;
            unsigned long long hm = x | (x << 1);
            if (64 * cur + 32 > t0 + 15) hm &= ~(1ull << (2 * cur + 1));
            LAS unsigned* hmx = (LAS unsigned*)(lds + NSA_HMX);
            if (lane == 0) hmx[wave] = um;
            LDS_BAR();
            unsigned ub = 0u;
#pragma unroll
            for (int w8 = 0; w8 < 8; ++w8) ub |= hmx[w8];
            ub = (unsigned)__builtin_amdgcn_readfirstlane((int)ub);
            nsa_coop_loop<1>(lds, ks, vst, 0, __builtin_popcount(ub), ub, hm, t0, tq, selmask, ql, mrun, lrun, O, tid, c, gq);
        }
        }
        asm volatile("" ::: "memory");
#pragma unroll
        for (int h = 0; h < 3; ++h) { float lt = lrun[h]; lt += __shfl_xor(lt, 16); lt += __shfl_xor(lt, 32); const float inv = lt > 0.f ? NSA_GATE(1, h) * __builtin_amdgcn_rcpf(lt) : 0.f;
            bf16* orow = P.mix + ((size_t)b * SEQ + tq) * DM + 640 + g * 192 + h * 64;
#pragma unroll
            for (int dt = 0; dt < 4; ++dt) { const v2u w0 = outl[64 * (4 * h + dt)]; const f32x4 o = (f32x4){bflo(w0.x), bfhi(w0.x), bflo(w0.y), bfhi(w0.y)} + O[h][dt] * inv;
                v2u w; w.x = cvtpk(o[0], o[1]); w.y = cvtpk(o[2], o[3]); *(v2u*)(orow + 16 * dt + 4 * gq) = w; } }
    }
#undef NSA_GATE
}

typedef short bf16x4 __attribute__((ext_vector_type(4)));
#define MFMA16K(a, b, c) __builtin_amdgcn_mfma_f32_16x16x16bf16_1k((a), (b), (c), 0, 0, 0)
__device__ __forceinline__ bf16x4 pack4(const f32x4& a) { v2u w; w.x = cvtpk(a[0], a[1]); w.y = cvtpk(a[2], a[3]); return __builtin_bit_cast(bf16x4, w); }
constexpr int DNF_UNIT = 40960;
constexpr int DL_RAWB = 26880, DL_RAW = 0, DL_QS = 2 * DL_RAWB, DL_KS = DL_QS + 9216, DL_KT = DL_KS + 9216, DL_WL = DL_KT + 9216, DL_AII = DL_WL + 9216, DL_TINV = DL_AII + 4096, DL_VEC = DL_TINV + 4096, DL_END = DL_VEC + 2048;
static_assert(DL_END <= 131072, "DeltaNet chunk LDS map");
struct DnPre { v4u raw[4]; unsigned gb, ga; };
struct DnUnitId { int b, h, n, valid; };
__device__ __forceinline__ DnUnitId dn_unit_id(int u) { DnUnitId r; r.valid = u < BATCH * 6 * 32; const int uu = r.valid ? u : 0; r.n = uu & 31; const int bh = uu >> 5; r.b = bh / 6; r.h = bh % 6; return r; }
__device__ __forceinline__ void dn_prefetch(DnPre& P, const bf16* __restrict__ PROJ, const DnUnitId id, int tid, int lane, int wave) {
#pragma unroll
    for (int q = 0; q < 4; ++q) { const int e = tid + NTHR * q, rr = e / 24, pc = e % 24, part = pc >> 3, d0 = (pc & 7) * 8, t = 64 * id.n - 3 + rr;
        v4u val = {0u, 0u, 0u, 0u};
        if (id.valid && e < 67 * 24 && t >= 0) val = *(const v4u*)(PROJ + ((size_t)id.b * SEQ + t) * NINP + part * 384 + id.h * 64 + d0);
        P.raw[q] = val; }
    P.gb = 0u; P.ga = 0u;
    if (wave == 1 && id.valid) { const bf16* pr = PROJ + ((size_t)id.b * SEQ + 64 * id.n + lane) * NINP; P.gb = pr[PC_B + id.h]; P.ga = pr[PC_A + id.h]; }
}
__device__ __forceinline__ void dn_commit_raw(const DnPre& P, LAS unsigned char* L, int par, int tid) {
#pragma unroll
    for (int q = 0; q < 4; ++q) { const int e = tid + NTHR * q, rr = e / 24, pc = e % 24, part = pc >> 3, d0 = (pc & 7) * 8;
        if (e < 67 * 24) *(LAS v4u*)(L + DL_RAW + par * DL_RAWB + rr * 400 + (part * 64 + d0) * 2) = P.raw[q]; }
}
__device__ __forceinline__ void dn_commit_gates(const DnPre& P, LAS unsigned char* L, int par, float Aexp, float dtb, float* __restrict__ gt_out, bool valid, int lane, int wave) {
    if (wave == 1) { LAS float* vbeta = (LAS float*)(L + DL_VEC + par * 1024);
        const float beta = sigmoid_f(bf2f((bf16)P.gb)); const float z = bf2f((bf16)P.ga) + dtb; const float sp = z > 20.f ? z : log1pf(__expf(z)); float gv = -Aexp * sp;
#pragma unroll
        for (int off = 1; off < 64; off <<= 1) { const float t = __shfl_up(gv, off); if (lane >= off) gv += t; }
        const float glast = __shfl(gv, 63);
        vbeta[lane] = beta; vbeta[64 + lane] = gv; vbeta[128 + lane] = __expf(gv); vbeta[192 + lane] = __expf(glast - gv);
        if (lane == 63 && valid) *gt_out = __expf(gv); }
}
template <int PAR>
__device__ __forceinline__ void dn_chunk_unit(LAS unsigned char* L, const bf16* __restrict__ PROJ, const float* __restrict__ cw, const float* __restrict__ alog, const float* __restrict__ dtbp,
                                              unsigned char* __restrict__ dnf_all, float* __restrict__ gt_all, int u, int u_next, int tid, int lane, int wave) {
    LAS bf16* RAWs = (LAS bf16*)(L + DL_RAW + PAR * DL_RAWB); LAS bf16* QS = (LAS bf16*)(L + DL_QS); LAS bf16* KS = (LAS bf16*)(L + DL_KS); LAS bf16* KT = (LAS bf16*)(L + DL_KT); LAS bf16* WL = (LAS bf16*)(L + DL_WL);
    LAS float* AII = (LAS float*)(L + DL_AII); LAS float* TINV = (LAS float*)(L + DL_TINV);
    LAS float* vbeta = (LAS float*)(L + DL_VEC + PAR * 1024); LAS float* vgam = vbeta + 64; LAS float* vegam = vgam + 64; LAS float* vedec = vegam + 64;
    asm volatile("" : "+v"(tid), "+v"(lane), "+s"(wave));
    const int col = lane & 15, g = lane >> 4;
    const DnUnitId id = dn_unit_id(u), idn = dn_unit_id(u_next);
    const int h = id.h;
    unsigned char* dnf = dnf_all + (size_t)u * DNF_UNIT;
    LDS_BAR();
    DnPre P; dn_prefetch(P, PROJ, idn, tid, lane, wave);
    f32x4 R[4]; bf16x8 AF1, AF2, AF3a, AF3b; const f32x4 z4 = {0.f, 0.f, 0.f, 0.f};
    REP(24) {
    {
        const int part = wave >> 2, cr = 16 * (wave & 3) + (lane >> 2), d0 = 16 * (lane & 3);
        float y[16];
#pragma unroll
        for (int e = 0; e < 16; ++e) y[e] = 0.f;
#pragma unroll
        for (int j = 0; j < 4; ++j) { const LAS bf16* xr = RAWs + (cr + j) * 200 + part * 64 + d0; const v4u xa = *(const LAS v4u*)xr, xb2 = *(const LAS v4u*)(xr + 8);
            const float* wj = cw + j * 1152 + part * 384 + h * 64 + d0;
            const f32x4 w0 = *(const f32x4*)wj, w1 = *(const f32x4*)(wj + 4), w2 = *(const f32x4*)(wj + 8), w3 = *(const f32x4*)(wj + 12);
            y[0] += w0[0] * bflo(xa.x); y[1] += w0[1] * bfhi(xa.x); y[2] += w0[2] * bflo(xa.y); y[3] += w0[3] * bfhi(xa.y);
            y[4] += w1[0] * bflo(xa.z); y[5] += w1[1] * bfhi(xa.z); y[6] += w1[2] * bflo(xa.w); y[7] += w1[3] * bfhi(xa.w);
            y[8] += w2[0] * bflo(xb2.x); y[9] += w2[1] * bfhi(xb2.x); y[10] += w2[2] * bflo(xb2.y); y[11] += w2[3] * bfhi(xb2.y);
            y[12] += w3[0] * bflo(xb2.z); y[13] += w3[1] * bfhi(xb2.z); y[14] += w3[2] * bflo(xb2.w); y[15] += w3[3] * bfhi(xb2.w); }
        float ss = 0.f;
#pragma unroll
        for (int e = 0; e < 16; ++e) { y[e] = silu_f(y[e]); ss += y[e] * y[e]; }
        ss += __shfl_xor(ss, 1); ss += __shfl_xor(ss, 2);
        const float sc = rsqrtf(ss + EPS) * (part == 0 ? 0.125f : 1.0f);
        v4u o0, o1;
        o0.x = cvtpk(y[0] * sc, y[1] * sc); o0.y = cvtpk(y[2] * sc, y[3] * sc); o0.z = cvtpk(y[4] * sc, y[5] * sc); o0.w = cvtpk(y[6] * sc, y[7] * sc);
        o1.x = cvtpk(y[8] * sc, y[9] * sc); o1.y = cvtpk(y[10] * sc, y[11] * sc); o1.z = cvtpk(y[12] * sc, y[13] * sc); o1.w = cvtpk(y[14] * sc, y[15] * sc);
        LAS bf16* dst = (part == 0 ? QS : KS) + cr * 72 + d0;
        *(LAS v4u*)dst = o0; *(LAS v4u*)(dst + 8) = o1;
        if (part == 1) {
            const unsigned ow[8] = {o0.x, o0.y, o0.z, o0.w, o1.x, o1.y, o1.z, o1.w};
#pragma unroll
            for (int e2 = 0; e2 < 8; ++e2) { KT[(d0 + 2 * e2) * 72 + cr] = (bf16)(ow[e2] & 0xffffu); KT[(d0 + 2 * e2 + 1) * 72 + cr] = (bf16)(ow[e2] >> 16); } }
    }
    if (wave < 4) { const int d = 16 * wave + col; float cwv[4];
#pragma unroll
        for (int j = 0; j < 4; ++j) cwv[j] = cw[j * 1152 + 768 + h * 64 + d];
#pragma unroll
        for (int i = 0; i < 4; ++i) { float x7[7];
#pragma unroll
            for (int m = 0; m < 7; ++m) x7[m] = bf2f(RAWs[(16 * i + 4 * g + m) * 200 + 128 + d]);
#pragma unroll
            for (int r = 0; r < 4; ++r) { const float yv = (cwv[0] * x7[r] + cwv[1] * x7[r + 1]) + (cwv[2] * x7[r + 2] + cwv[3] * x7[r + 3]); R[i][r] = silu_f(yv) * vbeta[16 * i + 4 * g + r]; } } }
    LDS_BAR();
    if (wave >= 4) { const int kd = 16 * (wave - 4) + col;
#pragma unroll
        for (int i = 0; i < 4; ++i)
#pragma unroll
            for (int r = 0; r < 4; ++r) { const int c = 16 * i + 4 * g + r; R[i][r] = bf2f(KS[c * 72 + kd]) * vbeta[c] * vegam[c]; } }
    bf16x8 KF[4][2];
#pragma unroll
    for (int ct = 0; ct < 4; ++ct)
#pragma unroll
        for (int s = 0; s < 2; ++s) KF[ct][s] = *(const LAS bf16x8*)(KS + (16 * ct + col) * 72 + 32 * s + 8 * g);
#define DN_TILE(dst, ctp, ct) do { f32x4 t_ = z4; t_ = MFMA16(KF[ctp][0], KF[ct][0], t_); t_ = MFMA16(KF[ctp][1], KF[ct][1], t_); \
        const float bc_ = -vbeta[16 * (ct) + col], gc_ = vgam[16 * (ct) + col]; const f32x4 gp_ = *(const LAS f32x4*)(vgam + 16 * (ctp) + 4 * g); \
        _Pragma("unroll") for (int r_ = 0; r_ < 4; ++r_) t_[r_] = t_[r_] * bc_ * __expf(gc_ - gp_[r_]); dst = t_; } while (0)
    { f32x4 t01, t02, t12, t03, t13, t23; DN_TILE(t01, 0, 1); DN_TILE(t02, 0, 2); DN_TILE(t12, 1, 2); DN_TILE(t03, 0, 3); DN_TILE(t13, 1, 3); DN_TILE(t23, 2, 3);
        AF1 = pack8(t01, z4); AF2 = pack8(t02, t12); AF3a = pack8(t03, t13); AF3b = pack8(t23, z4); }
#undef DN_TILE
    if (wave < 4) {
        const bf16x8 kd0 = *(const LAS bf16x8*)(KS + (16 * wave + col) * 72 + 8 * g), kd1 = *(const LAS bf16x8*)(KS + (16 * wave + col) * 72 + 32 + 8 * g);
        f32x4 t = z4; t = MFMA16(kd0, kd0, t); t = MFMA16(kd1, kd1, t);
        const int cc = 16 * wave + col; const float bc = vbeta[cc], gc = vgam[cc]; const f32x4 gp = *(const LAS f32x4*)(vgam + 16 * wave + 4 * g);
#pragma unroll
        for (int r = 0; r < 4; ++r) t[r] = (col > 4 * g + r) ? t[r] * bc * __expf(gc - gp[r]) : 0.f;
        *(LAS f32x4*)(AII + wave * 256 + col * 16 + 4 * g) = t; }
    LDS_BAR();
    }
    REP(25) {
    if (wave == 1) dn_commit_gates(P, L, 1 - PAR, __expf(alog[idn.h]), dtbp[idn.h], gt_all + (idn.valid ? u_next : 0), idn.valid != 0, lane, wave);
    if (wave == 0) { const int i = g, cl = col; float t[16];
#pragma unroll
        for (int r = 0; r < 16; ++r) { float acc = (r == cl) ? 1.f : 0.f; f32x4 rowv[4];
#pragma unroll
            for (int q = 0; q < 4; ++q) if (4 * q < r) rowv[q] = *(const LAS f32x4*)(AII + i * 256 + r * 16 + 4 * q);
#pragma unroll
            for (int m = 0; m < r; ++m) acc -= rowv[m >> 2][m & 3] * t[m];
            t[r] = acc; }
#pragma unroll
        for (int r = 0; r < 16; ++r) TINV[i * 256 + r * 16 + cl] = t[r]; }
    LDS_BAR();
    }
    f32x4 X[4];
    { bf16x4 TF[4];
#pragma unroll
        for (int i = 0; i < 4; ++i) { const f32x4 tv = *(const LAS f32x4*)(TINV + i * 256 + col * 16 + 4 * g); TF[i] = pack4(tv); }
        X[0] = MFMA16K(TF[0], pack4(R[0]), z4);
        { const f32x4 y = MFMA16(AF1, pack8(X[0], z4), R[1]); X[1] = MFMA16K(TF[1], pack4(y), z4); }
        { const f32x4 y = MFMA16(AF2, pack8(X[0], X[1]), R[2]); X[2] = MFMA16K(TF[2], pack4(y), z4); }
        { f32x4 y = MFMA16(AF3a, pack8(X[0], X[1]), R[3]); y = MFMA16(AF3b, pack8(X[2], z4), y); X[3] = MFMA16K(TF[3], pack4(y), z4); } }
    if (wave >= 4) { const int kd = 16 * (wave - 4) + col;
#pragma unroll
        for (int i = 0; i < 4; ++i)
#pragma unroll
            for (int r = 0; r < 4; ++r) WL[(16 * i + 4 * g + r) * 72 + kd] = f2bf(X[i][r]); }
    dn_commit_raw(P, L, 1 - PAR, tid);
    LDS_BAR();
    if (wave < 4) {
#pragma unroll
        for (int ct = 0; ct < 4; ++ct) { v2u w; w.x = cvtpk(X[ct][0], X[ct][1]); w.y = cvtpk(X[ct][2], X[ct][3]); *(v2u*)(dnf + 32768 + (wave * 4 + ct) * 512 + lane * 8) = w; } }
    { const int ct = wave >> 1, s = wave & 1;
        { const v2u a = *(const LAS v2u*)(WL + (16 * ct + col) * 72 + 32 * s + 4 * g), bq = *(const LAS v2u*)(WL + (16 * ct + col) * 72 + 32 * s + 16 + 4 * g);
            v4u o; o.x = a.x ^ 0x80008000u; o.y = a.y ^ 0x80008000u; o.z = bq.x ^ 0x80008000u; o.w = bq.y ^ 0x80008000u;
            *(v4u*)(dnf + wave * 1024 + lane * 16) = o; }
        { const v2u a = *(const LAS v2u*)(QS + (16 * ct + col) * 72 + 32 * s + 4 * g), bq = *(const LAS v2u*)(QS + (16 * ct + col) * 72 + 32 * s + 16 + 4 * g); const float e = vegam[16 * ct + col];
            v4u o; o.x = cvtpk(bflo(a.x) * e, bfhi(a.x) * e); o.y = cvtpk(bflo(a.y) * e, bfhi(a.y) * e); o.z = cvtpk(bflo(bq.x) * e, bfhi(bq.x) * e); o.w = cvtpk(bflo(bq.y) * e, bfhi(bq.y) * e);
            *(v4u*)(dnf + 8192 + wave * 1024 + lane * 16) = o; }
        { const v2u a = *(const LAS v2u*)(KT + (16 * ct + col) * 72 + 32 * s + 4 * g), bq = *(const LAS v2u*)(KT + (16 * ct + col) * 72 + 32 * s + 16 + 4 * g);
            const f32x4 e1 = *(const LAS f32x4*)(vedec + 32 * s + 4 * g), e2 = *(const LAS f32x4*)(vedec + 32 * s + 16 + 4 * g);
            v4u o; o.x = cvtpk(bflo(a.x) * e1[0], bfhi(a.x) * e1[1]); o.y = cvtpk(bflo(a.y) * e1[2], bfhi(a.y) * e1[3]); o.z = cvtpk(bflo(bq.x) * e2[0], bfhi(bq.x) * e2[1]); o.w = cvtpk(bflo(bq.y) * e2[2], bfhi(bq.y) * e2[3]);
            *(v4u*)(dnf + 24576 + wave * 1024 + lane * 16) = o; }
        { const bf16x8 q0 = *(const LAS bf16x8*)(QS + (16 * ct + col) * 72 + 8 * g), q1 = *(const LAS bf16x8*)(QS + (16 * ct + col) * 72 + 32 + 8 * g);
            const int cc = 16 * ct + col; const float gc = vgam[cc]; f32x4 th[2];
#pragma unroll
            for (int hh = 0; hh < 2; ++hh) { const int ctp = 2 * s + hh; f32x4 t = z4;
                if (ctp <= ct) { const bf16x8 k0 = *(const LAS bf16x8*)(KS + (16 * ctp + col) * 72 + 8 * g), k1 = *(const LAS bf16x8*)(KS + (16 * ctp + col) * 72 + 32 + 8 * g);
                    t = MFMA16(k0, q0, t); t = MFMA16(k1, q1, t); const f32x4 gp = *(const LAS f32x4*)(vgam + 16 * ctp + 4 * g);
#pragma unroll
                    for (int r = 0; r < 4; ++r) t[r] = (cc >= 16 * ctp + 4 * g + r) ? t[r] * __expf(gc - gp[r]) : 0.f; }
                th[hh] = t; }
            *(bf16x8*)(dnf + 16384 + wave * 1024 + lane * 16) = pack8(th[0], th[1]); }
    }
}
constexpr int DW_RAW = 0, DW_AII = 9728, DW_VEC = DW_AII + 4096, DW_END = DW_VEC + 1024;
static_assert(DW_END <= 16384, "per-wave LDS of the wave-autonomous DeltaNet chunk unit");
__device__ __forceinline__ void dnw_stage_issue(v4u (&rg)[9], const bf16* __restrict__ PROJ, int b, int h, int n, int part, int lane) {
#pragma unroll
    for (int it = 0; it < 9; ++it) { const int e = lane + 64 * it, rr = e >> 3, ch = e & 7, t = 64 * n - 3 + rr; v4u val = {0u, 0u, 0u, 0u};
        if (e < 67 * 8 && t >= 0) val = *(const v4u*)(PROJ + ((size_t)b * SEQ + t) * NINP + part * 384 + h * 64 + ch * 8);
        rg[it] = val; }
}
__device__ __forceinline__ void dnw_stage_commit(const v4u (&rg)[9], LAS unsigned char* W, int lane) {
#pragma unroll
    for (int it = 0; it < 9; ++it) { const int e = lane + 64 * it, rr = e >> 3, ch = e & 7; if (e < 67 * 8) *(LAS v4u*)(W + DW_RAW + rr * 144 + ch * 16) = rg[it]; }
}
__device__ __forceinline__ void dnw_conv_qk(const LAS unsigned char* W, const float* __restrict__ cwp, float qscale, bf16x8 (&F)[4][2], int c, int g) {
    v4u Fp[4][2]; float ss[4] = {0.f, 0.f, 0.f, 0.f};
#pragma unroll
    for (int s = 0; s < 2; ++s) {
        f32x4 wa[4], wb[4];
#pragma unroll
        for (int tap = 0; tap < 4; ++tap) { wa[tap] = *(const f32x4*)(cwp + tap * 1152 + 32 * s + 4 * g); wb[tap] = *(const f32x4*)(cwp + tap * 1152 + 32 * s + 16 + 4 * g); }
#pragma unroll
        for (int ct = 0; ct < 4; ++ct) { f32x4 ya = {0.f, 0.f, 0.f, 0.f}, yb = ya;
#pragma unroll
            for (int tap = 0; tap < 4; ++tap) { const LAS unsigned char* rp = W + DW_RAW + (16 * ct + c + tap) * 144 + 64 * s + 8 * g;
                const v2u xa = *(const LAS v2u*)rp, xb = *(const LAS v2u*)(rp + 32);
                ya = ya + wa[tap] * (f32x4){bflo(xa.x), bfhi(xa.x), bflo(xa.y), bfhi(xa.y)}; yb = yb + wb[tap] * (f32x4){bflo(xb.x), bfhi(xb.x), bflo(xb.y), bfhi(xb.y)}; }
#pragma unroll
            for (int e = 0; e < 4; ++e) { ya[e] = silu_f(ya[e]); yb[e] = silu_f(yb[e]); ss[ct] += ya[e] * ya[e] + yb[e] * yb[e]; }
            v4u w; w.x = cvtpk(ya[0], ya[1]); w.y = cvtpk(ya[2], ya[3]); w.z = cvtpk(yb[0], yb[1]); w.w = cvtpk(yb[2], yb[3]); Fp[ct][s] = w; }
    }
#pragma unroll
    for (int ct = 0; ct < 4; ++ct) { float t = ss[ct]; t += __shfl_xor(t, 16); t += __shfl_xor(t, 32);
        const float sc = rsqrtf(t + EPS) * qscale;
#pragma unroll
        for (int s = 0; s < 2; ++s) { const v4u q = Fp[ct][s]; v4u w; w.x = cvtpk(bflo(q.x) * sc, bfhi(q.x) * sc); w.y = cvtpk(bflo(q.y) * sc, bfhi(q.y) * sc); w.z = cvtpk(bflo(q.z) * sc, bfhi(q.z) * sc); w.w = cvtpk(bflo(q.w) * sc, bfhi(q.w) * sc);
            F[ct][s] = __builtin_bit_cast(bf16x8, w); } }
}
__device__ __forceinline__ void dn_chunk_wave(LAS unsigned char* W, const bf16* __restrict__ PROJ, const float* __restrict__ cw, float Aexp, float dtb,
                                              unsigned char* __restrict__ dnf, float* __restrict__ gt_out, int b, int h, int n, int lane) {
    asm volatile("" : "+v"(lane));
    const int c = lane & 15, g = lane >> 4;
    LAS float* AII = (LAS float*)(W + DW_AII); LAS float* vbeta = (LAS float*)(W + DW_VEC); LAS float* vgam = vbeta + 64; LAS float* vegam = vgam + 64; LAS float* vedec = vegam + 64;
    const f32x4 z4 = {0.f, 0.f, 0.f, 0.f};
    v4u rg[9];
    dnw_stage_issue(rg, PROJ, b, h, n, 0, lane);
    { const bf16* pr = PROJ + ((size_t)b * SEQ + 64 * n + lane) * NINP; const float beta = sigmoid_f(bf2f(pr[PC_B + h]));
        const float z = bf2f(pr[PC_A + h]) + dtb; const float sp = z > 20.f ? z : log1pf(__expf(z)); float gv = -Aexp * sp;
#pragma unroll
        for (int off = 1; off < 64; off <<= 1) { const float t = __shfl_up(gv, off); if (lane >= off) gv += t; }
        const float glast = __shfl(gv, 63);
        vbeta[lane] = beta; vgam[lane] = gv; vegam[lane] = __expf(gv); vedec[lane] = __expf(glast - gv);
        if (lane == 63) *gt_out = __expf(gv); }
    bf16x8 KF[4][2];
    {
    bf16x8 QF[4][2];
    dnw_stage_commit(rg, W, lane); asm volatile("" ::: "memory");
    dnw_stage_issue(rg, PROJ, b, h, n, 1, lane);
    dnw_conv_qk(W, cw + h * 64, 0.125f, QF, c, g);
#pragma unroll
    for (int ct = 0; ct < 4; ++ct) { const float e = vegam[16 * ct + c];
#pragma unroll
        for (int s = 0; s < 2; ++s) { const v4u q = __builtin_bit_cast(v4u, QF[ct][s]);
            v4u o; o.x = cvtpk(bflo(q.x) * e, bfhi(q.x) * e); o.y = cvtpk(bflo(q.y) * e, bfhi(q.y) * e); o.z = cvtpk(bflo(q.z) * e, bfhi(q.z) * e); o.w = cvtpk(bflo(q.w) * e, bfhi(q.w) * e);
            *(v4u*)(dnf + 8192 + (2 * ct + s) * 1024 + lane * 16) = o; } }
    asm volatile("" ::: "memory");
    dnw_stage_commit(rg, W, lane); asm volatile("" ::: "memory");
    dnw_stage_issue(rg, PROJ, b, h, n, 2, lane);
    dnw_conv_qk(W, cw + 384 + h * 64, 1.0f, KF, c, g);
#pragma unroll
    for (int ct = 0; ct < 4; ++ct) { const float gc = vgam[16 * ct + c];
#pragma unroll
        for (int sp = 0; sp < 2; ++sp) { f32x4 th[2];
#pragma unroll
            for (int hh = 0; hh < 2; ++hh) { const int ctp = 2 * sp + hh; f32x4 t = z4;
                if (ctp <= ct) { t = MFMA16(KF[ctp][0], QF[ct][0], t); t = MFMA16(KF[ctp][1], QF[ct][1], t); const f32x4 gp = *(const LAS f32x4*)(vgam + 16 * ctp + 4 * g);
#pragma unroll
                    for (int r = 0; r < 4; ++r) t[r] = (16 * ct + c >= 16 * ctp + 4 * g + r) ? t[r] * __expf(gc - gp[r]) : 0.f; }
                th[hh] = t; }
            *(bf16x8*)(dnf + 16384 + (2 * ct + sp) * 1024 + lane * 16) = pack8(th[0], th[1]); } }
    }
    asm volatile("" ::: "memory");
    dnw_stage_commit(rg, W, lane); asm volatile("" ::: "memory");
#define DNW_TILE(dst, ctp, ct) do { f32x4 t_ = z4; t_ = MFMA16(KF[ctp][0], KF[ct][0], t_); t_ = MFMA16(KF[ctp][1], KF[ct][1], t_); \
        const float bc_ = -vbeta[16 * (ct) + c], gc_ = vgam[16 * (ct) + c]; const f32x4 gp_ = *(const LAS f32x4*)(vgam + 16 * (ctp) + 4 * g); \
        _Pragma("unroll") for (int r_ = 0; r_ < 4; ++r_) t_[r_] = t_[r_] * bc_ * __expf(gc_ - gp_[r_]); dst = t_; } while (0)
    bf16x8 AF1, AF2, AF3a, AF3b;
    { f32x4 t01, t02, t12, t03, t13, t23; DNW_TILE(t01, 0, 1); DNW_TILE(t02, 0, 2); DNW_TILE(t12, 1, 2); DNW_TILE(t03, 0, 3); DNW_TILE(t13, 1, 3); DNW_TILE(t23, 2, 3);
        AF1 = pack8(t01, z4); AF2 = pack8(t02, t12); AF3a = pack8(t03, t13); AF3b = pack8(t23, z4); }
#undef DNW_TILE
#pragma unroll
    for (int i = 0; i < 4; ++i) { f32x4 t = z4; t = MFMA16(KF[i][0], KF[i][0], t); t = MFMA16(KF[i][1], KF[i][1], t);
        const float bc = vbeta[16 * i + c], gc = vgam[16 * i + c]; const f32x4 gp = *(const LAS f32x4*)(vgam + 16 * i + 4 * g);
#pragma unroll
        for (int r = 0; r < 4; ++r) t[r] = (c > 4 * g + r) ? t[r] * bc * __expf(gc - gp[r]) : 0.f;
        *(LAS f32x4*)(AII + i * 256 + c * 16 + 4 * g) = t; }
    asm volatile("" ::: "memory");
    { const int i = g, cl = c; float t[16];
#pragma unroll
        for (int r = 0; r < 16; ++r) { float acc = (r == cl) ? 1.f : 0.f; f32x4 rowv[4];
#pragma unroll
            for (int q = 0; q < 4; ++q) if (4 * q < r) rowv[q] = *(const LAS f32x4*)(AII + i * 256 + r * 16 + 4 * q);
#pragma unroll
            for (int m = 0; m < r; ++m) acc -= rowv[m >> 2][m & 3] * t[m];
            t[r] = acc; }
        asm volatile("" ::: "memory");
#pragma unroll
        for (int r = 0; r < 16; ++r) AII[i * 256 + r * 16 + cl] = t[r]; }
    asm volatile("" ::: "memory");
    bf16x4 TF[4];
#pragma unroll
    for (int i = 0; i < 4; ++i) { const f32x4 tv = *(const LAS f32x4*)(AII + i * 256 + c * 16 + 4 * g); TF[i] = pack4(tv); }
#define DNW_SOLVE(X, R) do { X[0] = MFMA16K(TF[0], pack4(R[0]), z4); \
        { const f32x4 y_ = MFMA16(AF1, pack8(X[0], z4), R[1]); X[1] = MFMA16K(TF[1], pack4(y_), z4); } \
        { const f32x4 y_ = MFMA16(AF2, pack8(X[0], X[1]), R[2]); X[2] = MFMA16K(TF[2], pack4(y_), z4); } \
        { f32x4 y_ = MFMA16(AF3a, pack8(X[0], X[1]), R[3]); y_ = MFMA16(AF3b, pack8(X[2], z4), y_); X[3] = MFMA16K(TF[3], pack4(y_), z4); } } while (0)
#pragma unroll 1
    for (int vt = 0; vt < 4; ++vt) { const int d = 16 * vt + c; float cwv[4];
#pragma unroll
        for (int j = 0; j < 4; ++j) cwv[j] = cw[j * 1152 + 768 + h * 64 + d];
        f32x4 R[4], X[4];
#pragma unroll
        for (int i = 0; i < 4; ++i) { float x7[7];
#pragma unroll
            for (int m = 0; m < 7; ++m) x7[m] = bf2f(*(const LAS bf16*)(W + DW_RAW + (16 * i + 4 * g + m) * 144 + 2 * d));
            const f32x4 bt = *(const LAS f32x4*)(vbeta + 16 * i + 4 * g);
#pragma unroll
            for (int r = 0; r < 4; ++r) R[i][r] = silu_f((cwv[0] * x7[r] + cwv[1] * x7[r + 1]) + (cwv[2] * x7[r + 2] + cwv[3] * x7[r + 3])) * bt[r]; }
        DNW_SOLVE(X, R);
#pragma unroll
        for (int ct = 0; ct < 4; ++ct) { v2u w; w.x = cvtpk(X[ct][0], X[ct][1]); w.y = cvtpk(X[ct][2], X[ct][3]); *(v2u*)(dnf + 32768 + (vt * 4 + ct) * 512 + lane * 8) = w; } }
    bf16x4 I16; { v2u w; w.x = ((4 * g == c) ? 0x3F80u : 0u) | ((4 * g + 1 == c) ? 0x3F800000u : 0u); w.y = ((4 * g + 2 == c) ? 0x3F80u : 0u) | ((4 * g + 3 == c) ? 0x3F800000u : 0u); I16 = __builtin_bit_cast(bf16x4, w); }
#pragma unroll 1
    for (int s2 = 0; s2 < 2; ++s2) {
        f32x4 Xw[2][4];
#pragma unroll
        for (int hh = 0; hh < 2; ++hh) {
            v4u iw = {0u, 0u, 0u, 0u};
            if (g == (c >> 2)) { const int j = 4 * hh + (c & 3); const unsigned one = (j & 1) ? 0x3F800000u : 0x3F80u; const int wsel = j >> 1; iw.x = wsel == 0 ? one : 0u; iw.y = wsel == 1 ? one : 0u; iw.z = wsel == 2 ? one : 0u; iw.w = wsel == 3 ? one : 0u; }
            const bf16x8 Isel = __builtin_bit_cast(bf16x8, iw);
            const int kt = 2 * s2 + hh;
            f32x4 Kt[4], R[4];
#pragma unroll
            for (int i = 0; i < 4; ++i) { Kt[i] = (s2 == 0) ? MFMA16(KF[i][0], Isel, z4) : MFMA16(KF[i][1], Isel, z4);
                const f32x4 bt = *(const LAS f32x4*)(vbeta + 16 * i + 4 * g), eg = *(const LAS f32x4*)(vegam + 16 * i + 4 * g); R[i] = Kt[i] * bt * eg; }
            DNW_SOLVE(Xw[hh], R);
#pragma unroll
            for (int sp = 0; sp < 2; ++sp) { const f32x4 e1 = *(const LAS f32x4*)(vedec + 32 * sp + 4 * g), e2 = *(const LAS f32x4*)(vedec + 32 * sp + 16 + 4 * g);
                *(bf16x8*)(dnf + 24576 + (2 * kt + sp) * 1024 + lane * 16) = pack8(Kt[2 * sp] * e1, Kt[2 * sp + 1] * e2); }
        }
#pragma unroll
        for (int i = 0; i < 4; ++i) { const f32x4 D0 = MFMA16K(pack4(Xw[0][i]), I16, z4), D1 = MFMA16K(pack4(Xw[1][i]), I16, z4);
            *(bf16x8*)(dnf + (2 * i + s2) * 1024 + lane * 16) = pack8(D0 * -1.0f, D1 * -1.0f); }
    }
#undef DNW_SOLVE
}
__device__ __forceinline__ void dn_chunk_phase(LAS unsigned char* L, const bf16* __restrict__ PROJ, const float* __restrict__ cw, const float* __restrict__ alog, const float* __restrict__ dtbp,
                                               unsigned char* __restrict__ dnf_all, float* __restrict__ gt_all, int u0, int stride, int tid, int lane, int wave) {
    constexpr int NU = BATCH * 6 * 32;
    if (u0 >= NU) return;
    __syncthreads();
    { const DnUnitId id0 = dn_unit_id(u0); DnPre P; dn_prefetch(P, PROJ, id0, tid, lane, wave); dn_commit_raw(P, L, 0, tid); dn_commit_gates(P, L, 0, __expf(alog[id0.h]), dtbp[id0.h], gt_all + u0, true, lane, wave); }
    for (int u = u0;; u += 2 * stride) {
        dn_chunk_unit<0>(L, PROJ, cw, alog, dtbp, dnf_all, gt_all, u, u + stride, tid, lane, wave);
        if (u + stride >= NU) break;
        dn_chunk_unit<1>(L, PROJ, cw, alog, dtbp, dnf_all, gt_all, u + stride, u + 2 * stride, tid, lane, wave);
        if (u + 2 * stride >= NU) break;
    }
    asm volatile("s_waitcnt vmcnt(0) lgkmcnt(0)" ::: "memory");
    __syncthreads();
}
struct DnScanCtx { LAS unsigned char* fb; LAS float* ssq; LAS bf16* tz; const unsigned char* ubase; const float* GTp; const bf16* PROJ; bf16* MIX; float nw; int b, h, bh, vt, col, g, lane; };
struct DnScanState { f32x4 S[4]; bf16x8 Sb0, Sb1; f32x4 ua[4]; };
template <int PAR> __device__ __forceinline__ void dn_scan_chunk(const DnScanCtx& C, int n, DnScanState& T) {
    const int vt = C.vt, col = C.col, g = C.g, lane = C.lane, h = C.h;
    const f32x4 z4 = {0.f, 0.f, 0.f, 0.f};
    LDS_BAR();
    const size_t tok0 = (size_t)C.b * SEQ + 64 * n;
    v4u zl[2];
#pragma unroll
    for (int j = 0; j < 2; ++j) zl[j] = *(const v4u*)(C.PROJ + (tok0 + (lane >> 1) + 32 * j) * NINP + PC_Z + h * 64 + 16 * vt + 8 * (lane & 1));
    const bool more = n + 1 < 32;
    v4u fr[8]; v2u un[4]; float gtn = 0.f;
    { const unsigned char* nb = C.ubase + (size_t)(more ? n + 1 : n) * DNF_UNIT;
#pragma unroll
        for (int q = 0; q < 8; ++q) fr[q] = *(const v4u*)(nb + (vt * 8 + q) * 1024 + lane * 16);
#pragma unroll
        for (int ct = 0; ct < 4; ++ct) un[ct] = *(const v2u*)(nb + 32768 + (vt * 4 + ct) * 512 + lane * 8);
        gtn = C.GTp[C.bh * 32 + (more ? n + 1 : n)]; }
    const LAS unsigned char* F = C.fb + PAR * 32768 + lane * 16;
#define DN_FRAG(set, f) (*(const LAS bf16x8*)(F + (set) * 8192 + (f) * 1024))
    bf16x8 fw[8], fq[8];
#pragma unroll
    for (int f = 0; f < 8; ++f) fw[f] = DN_FRAG(0, f);
#pragma unroll
    for (int f = 0; f < 8; ++f) fq[f] = DN_FRAG(1, f);
    f32x4 vn[4];
#pragma unroll
    for (int ct = 0; ct < 4; ++ct) { f32x4 a = T.ua[ct]; a = MFMA16(fw[2 * ct], T.Sb0, a); a = MFMA16(fw[2 * ct + 1], T.Sb1, a); vn[ct] = a; }
#pragma unroll
    for (int f = 0; f < 8; ++f) fw[f] = DN_FRAG(2, f);
    f32x4 oo[4];
#pragma unroll
    for (int ct = 0; ct < 4; ++ct) { f32x4 a = z4; a = MFMA16(fq[2 * ct], T.Sb0, a); a = MFMA16(fq[2 * ct + 1], T.Sb1, a); oo[ct] = a; }
#pragma unroll
    for (int f = 0; f < 8; ++f) fq[f] = DN_FRAG(3, f);
    const bf16x8 Vb0 = pack8(vn[0], vn[1]), Vb1 = pack8(vn[2], vn[3]);
#pragma unroll
    for (int ct = 0; ct < 4; ++ct) { f32x4 a = oo[ct]; a = MFMA16(fw[2 * ct], Vb0, a); a = MFMA16(fw[2 * ct + 1], Vb1, a); oo[ct] = a; }
#pragma unroll
    for (int kt = 0; kt < 4; ++kt) { f32x4 a = T.S[kt]; a = MFMA16(fq[2 * kt], Vb0, a); a = MFMA16(fq[2 * kt + 1], Vb1, a); T.S[kt] = a; }
#undef DN_FRAG
    T.Sb0 = pack8(T.S[0], T.S[1]); T.Sb1 = pack8(T.S[2], T.S[3]);
#pragma unroll
    for (int kt = 0; kt < 4; ++kt) T.S[kt] = T.S[kt] * gtn;
#pragma unroll
    for (int ct = 0; ct < 4; ++ct) T.ua[ct] = (f32x4){bflo(un[ct].x), bfhi(un[ct].x), bflo(un[ct].y), bfhi(un[ct].y)};
    { LAS unsigned char* dst = C.fb + (1 - PAR) * 32768 + (vt * 8) * 1024 + lane * 16;
#pragma unroll
        for (int q = 0; q < 8; ++q) *(LAS v4u*)(dst + q * 1024) = fr[q]; }
#pragma unroll
    for (int ct = 0; ct < 4; ++ct) { f32x4 q = oo[ct] * oo[ct];
#pragma unroll
        for (int off = 1; off < 16; off <<= 1) { q[0] += __shfl_xor(q[0], off); q[1] += __shfl_xor(q[1], off); q[2] += __shfl_xor(q[2], off); q[3] += __shfl_xor(q[3], off); }
        if (col == 0) *(LAS f32x4*)(C.ssq + vt * 64 + 16 * ct + 4 * g) = q; }
    LAS bf16* tz = C.tz;
#pragma unroll
    for (int j = 0; j < 2; ++j) *(LAS v4u*)(tz + ((lane >> 1) + 32 * j) * 24 + 8 * (lane & 1)) = zl[j];
    LDS_BAR();
#pragma unroll
    for (int ct = 0; ct < 4; ++ct) { const f32x4 tot = (*(const LAS f32x4*)(C.ssq + 16 * ct + 4 * g) + *(const LAS f32x4*)(C.ssq + 64 + 16 * ct + 4 * g)) + (*(const LAS f32x4*)(C.ssq + 128 + 16 * ct + 4 * g) + *(const LAS f32x4*)(C.ssq + 192 + 16 * ct + 4 * g));
#pragma unroll
        for (int r = 0; r < 4; ++r) { LAS bf16* e = tz + (16 * ct + 4 * g + r) * 24 + col;
            *e = f2bf(oo[ct][r] * rsqrtf(tot[r] * (1.f / 64.f) + EPS) * C.nw * silu_f(bf2f(*e))); } }
    asm volatile("s_waitcnt lgkmcnt(0)" ::: "memory");
#pragma unroll
    for (int j = 0; j < 2; ++j) { const v4u o = *(const LAS v4u*)(tz + ((lane >> 1) + 32 * j) * 24 + 8 * (lane & 1));
        *(v4u*)(C.MIX + (tok0 + (lane >> 1) + 32 * j) * DM + h * 64 + 16 * vt + 8 * (lane & 1)) = o; }
}
__device__ __forceinline__ void dn_scan_pair(LAS unsigned char* lds, const unsigned char* __restrict__ DNFp, const float* __restrict__ GTp, const bf16* __restrict__ PROJ, bf16* __restrict__ MIX,
                                             const float* __restrict__ nrmw, int pair, int lane, int wave) {
    DnScanCtx C;
    C.vt = wave & 3; C.bh = pair; C.b = C.bh / 6; C.h = C.bh % 6; C.col = lane & 15; C.g = lane >> 4; C.lane = lane;
    C.fb = lds + RING_OFF;
    C.ssq = (LAS float*)(lds + LDSCTL_OFF + 1024);
    C.tz = (LAS bf16*)(lds + RING_OFF + 65536 + (wave & 3) * 3072);
    if (wave >= 4) {
        __syncthreads();
        for (int n = 0; n < 32; ++n) { LDS_BAR(); LDS_BAR(); }
        asm volatile("s_waitcnt vmcnt(0) lgkmcnt(0)" ::: "memory");
        __syncthreads();
        return; }
    C.ubase = DNFp + (size_t)C.bh * 32 * DNF_UNIT; C.GTp = GTp; C.PROJ = PROJ; C.MIX = MIX;
    C.nw = nrmw[16 * C.vt + C.col];
    const f32x4 z4 = {0.f, 0.f, 0.f, 0.f};
    DnScanState T;
#pragma unroll
    for (int kt = 0; kt < 4; ++kt) T.S[kt] = z4;
    T.Sb0 = pack8(z4, z4); T.Sb1 = T.Sb0;
    __syncthreads();
    { const unsigned char* nb = C.ubase;
#pragma unroll
        for (int q = 0; q < 8; ++q) *(LAS v4u*)(C.fb + (C.vt * 8 + q) * 1024 + lane * 16) = *(const v4u*)(nb + (C.vt * 8 + q) * 1024 + lane * 16);
#pragma unroll
        for (int ct = 0; ct < 4; ++ct) { const v2u w = *(const v2u*)(nb + 32768 + (C.vt * 4 + ct) * 512 + lane * 8); T.ua[ct] = (f32x4){bflo(w.x), bfhi(w.x), bflo(w.y), bfhi(w.y)}; } }
    for (int n = 0; n < 32; n += 2) { dn_scan_chunk<0>(C, n, T); dn_scan_chunk<1>(C, n + 1, T); }
    asm volatile("s_waitcnt vmcnt(0) lgkmcnt(0)" ::: "memory");
    __syncthreads();
}
__device__ __forceinline__ void cmp_mlp2_tiles(const bf16* __restrict__ HID, const bf16* __restrict__ W2T, bf16* __restrict__ KC, bf16* __restrict__ VCT, int T0, int T1, int stride, int first, int lane) {
    const int col = lane & 15, g4 = lane >> 4;
    for (int T = T0 + first; T < T1; T += stride) {
        const int row0 = 16 * T, kv = row0 >> 13, g = (row0 >> 7) & 1, b = (row0 >> 8) & 31, i0 = row0 & 127;
        bf16x8 af[4];
#pragma unroll
        for (int s4 = 0; s4 < 4; ++s4) af[s4] = *(const bf16x8*)(HID + (size_t)(row0 + col) * 256 + kv * 128 + 32 * s4 + 8 * g4);
#pragma unroll
        for (int dt = 0; dt < 4; ++dt) { f32x4 acc = {0.f, 0.f, 0.f, 0.f};
#pragma unroll
            for (int s4 = 0; s4 < 4; ++s4) { const bf16x8 bfr = *(const bf16x8*)(W2T + (size_t)(kv * 64 + 16 * dt + col) * 128 + 32 * s4 + 8 * g4); acc = MFMA16(af[s4], bfr, acc); }
            if (i0 + 4 * g4 + 3 == 127) acc[3] = 0.f;
            if (kv == 0) {
#pragma unroll
                for (int r = 0; r < 4; ++r) KC[((size_t)(b * 2 + g) * 128 + i0 + 4 * g4 + r) * 64 + 16 * dt + col] = f2bf(acc[r]);
            } else { const int pos0 = 32 * (i0 >> 5) + 8 * g4 + ((i0 & 16) ? 4 : 0);
                v2u w; w.x = cvtpk(acc[0], acc[1]); w.y = cvtpk(acc[2], acc[3]); *(v2u*)(VCT + ((size_t)(b * 2 + g) * 64 + 16 * dt + col) * 128 + pos0) = w; } }
    }
}
struct Args { const float* in[21]; float* out; unsigned char* ws; int pre, ph_lo, ph_hi, l_lo, l_hi, pad; };
typedef const Args __attribute__((address_space(4)))* ArgsP;
enum { I_X = 0, I_NORMW, I_WIN, I_DNCONV, I_DNALOG, I_DNDT, I_DNNORM, I_CFW, I_CFB, I_CFLNW, I_CFLNB, I_KPOS, I_VPOS, I_KW1, I_KW2, I_VW1, I_VW2, I_WOUT, I_WG, I_WU, I_WD };

template <unsigned PHM> __global__ void __launch_bounds__(NTHR, 2) fwd(Args args) {
    extern __shared__ __attribute__((aligned(16))) unsigned char lds_raw[];
    LAS unsigned char* lds = (LAS unsigned char*)lds_raw;
    volatile LAS unsigned* MISC = (volatile LAS unsigned*)(lds + MISC_OFF);
    for (int u = threadIdx.x; u < (LDS_BYTES - LDSCTL_OFF) / 4; u += NTHR) ((LAS unsigned*)(lds + LDSCTL_OFF))[u] = 0u;
    __syncthreads();
#if MK_ONE_LAUNCH
    XcdBarrier bar = xcd_barrier_post((unsigned*)(args.ws + WS_CTL) + CW_BAR, MISC + 8);
#define GRID_BAR() xcd_barrier(bar)
#else
#define GRID_BAR() do { } while (0)
#endif
    const int ph_lo = args.ph_lo, ph_hi = args.ph_hi;
#define PH_LOCALS() \
    int tid = threadIdx.x; asm volatile("" : "+v"(tid)); \
    const int lane = tid & 63, wave = __builtin_amdgcn_readfirstlane(tid >> 6); \
    int blk = blockIdx.x; asm volatile("" : "+s"(blk)); \
    const int G = gridDim.x, gw = blk * NWAVES + wave, NGW = G * NWAVES; \
    ArgsP ap = (ArgsP)__builtin_amdgcn_kernarg_segment_ptr(); asm volatile("" : "+s"(ap)); \
    unsigned char* const ws = ap->ws; \
    bf16* const Win_t = (bf16*)(ws + WS_WIN); bf16* const Wout_t = (bf16*)(ws + WS_WOUT); bf16* const Wgu_t = (bf16*)(ws + WS_WGU); bf16* const Wd_t = (bf16*)(ws + WS_WD); bf16* const Wc1_t = (bf16*)(ws + WS_WC1); \
    bf16* const KC = (bf16*)(ws + WS_KC); bf16* const VCT = (bf16*)(ws + WS_VCT); \
    bf16* const PROJ = (bf16*)(ws + WS_PROJ); bf16* const HFF = (bf16*)(ws + WS_PROJ); bf16* const MIX = (bf16*)(ws + WS_MIX); bf16* const MBUF = (bf16*)(ws + WS_MBUF); bf16* const XB = (bf16*)(ws + WS_XB); \
    bf16* const ACMP = (bf16*)(ws + WS_ACMP); bf16* const HID = (bf16*)(ws + WS_HID); \
    bf16* const KS = (bf16*)(ws + WS_KS); bf16* const KW = (bf16*)(ws + WS_KW); bf16* const VST = (bf16*)(ws + WS_VST); bf16* const VWT = (bf16*)(ws + WS_VWT); \
    const float* const x_in = ap->in[I_X]; float* const xres = ap->out; float* const RSTD = (float*)(ws + WS_RSTD); bf16* const XD = (bf16*)ap->out; bf16* const XM = (bf16*)(ws + WS_MIX); (void)RSTD; (void)XD; (void)XM; \
    (void)lane; (void)gw; (void)NGW; (void)Win_t; (void)Wout_t; (void)Wgu_t; (void)Wd_t; (void)Wc1_t; (void)KC; (void)VCT; (void)PROJ; (void)HFF; (void)MIX; (void)MBUF; (void)XB; (void)ACMP; (void)HID; (void)KS; (void)KW; (void)VST; (void)VWT; (void)x_in; (void)xres; (void)G;

    const int lo = ph_lo, hi = ph_hi;
#define IN(k) (((PHM >> (k)) & 1u) && lo <= (k) && (k) < hi)
    if ((PHM & 1u) && args.pre) REP(30) {
        PH_LOCALS();
        LAS float* scr = (LAS float*)(lds + RING_OFF + wave * 16384);
        constexpr int IT_IN = 16 * 104, IT_OUT = 16 * 32, IT_GU = 16 * 176, IT_D = 44 * 32, IT_C1 = 32 * 8, IT_L = IT_IN + IT_OUT + IT_GU + IT_D + IT_C1;
        for (int it = gw; it < DEPTH * IT_L; it += NGW) {
            const int l = it / IT_L; int r = it % IT_L;
            const float* nw = ap->in[I_NORMW] + (size_t)l * 4 * DM;
            if (r < IT_IN) { const float* W = ap->in[I_WIN] + (size_t)l * DM * NIN; const float* sc = nw;
                wprep_item([=](int k, int n) { const int col = win_src_col(n); return col >= 0 ? W[(size_t)k * NIN + col] * sc[k] : 0.f; }, DM, Win_t + (size_t)l * NINP * DM, scr, r, 104, lane); continue; } r -= IT_IN;
            if (r < IT_OUT) { const float* W = ap->in[I_WOUT] + (size_t)l * DM * DM;
                wprep_item([=](int k, int n) { return W[(size_t)k * DM + n]; }, DM, Wout_t + (size_t)l * DM * DM, scr, r, 32, lane); continue; } r -= IT_OUT;
            if (r < IT_GU) { const float* Wg = ap->in[I_WG] + (size_t)l * DM * DFF; const float* Wu = ap->in[I_WU] + (size_t)l * DM * DFF; const float* sc = nw + 2 * DM;
                wprep_item([=](int k, int n) { const int t = n >> 8, w = n & 255; const ptrdiff_t sel = w < 128 ? (ptrdiff_t)0 : (Wu - Wg); return Wg[sel + (ptrdiff_t)k * DFF + 128 * t + (w & 127)] * sc[k]; }, DM, Wgu_t + (size_t)l * NGU * DM, scr, r, 176, lane); continue; } r -= IT_GU;
            if (r < IT_D) { const float* W = ap->in[I_WD] + (size_t)l * DFF * DM;
                wprep_item([=](int k, int n) { return W[(size_t)k * DM + n]; }, DFF, Wd_t + (size_t)l * DM * DFF, scr, r, 32, lane); continue; } r -= IT_D;
            { const float* Wk = ap->in[I_KW1] + (size_t)l * CMP_K * 128; const float* Wv = ap->in[I_VW1] + (size_t)l * CMP_K * 128;
                wprep_item([=](int k, int n) { const ptrdiff_t sel = n < 128 ? (ptrdiff_t)0 : (Wv - Wk); return Wk[sel + (ptrdiff_t)k * 128 + (n & 127)]; }, CMP_K, Wc1_t + (size_t)l * 256 * CMP_K, scr, r, 8, lane); }
        }
        for (int e = blk * NTHR + tid; e < DEPTH * 2 * 64 * 128; e += G * NTHR) { const int n = e & 127, d = (e >> 7) & 63, kv = (e >> 13) & 1, ll = e >> 14;
            ((bf16*)(ws + WS_W2T))[e] = f2bf(ap->in[kv ? I_VW2 : I_KW2][((size_t)ll * 128 + n) * 64 + d]); }
        for (int m = gw; m < MTOK / 2; m += NGW) {
            const int m2 = m + MTOK / 2; const f32x4* xa = (const f32x4*)(x_in + (size_t)m * DM) + lane; const f32x4* xb2 = (const f32x4*)(x_in + (size_t)m2 * DM) + lane;
            f32x4 va[4], vb[4]; float sa = 0.f, sb = 0.f;
#pragma unroll
            for (int j = 0; j < 4; ++j) { va[j] = xa[64 * j]; vb[j] = xb2[64 * j]; }
#pragma unroll
            for (int j = 0; j < 4; ++j) { sa += (va[j].x * va[j].x + va[j].y * va[j].y) + (va[j].z * va[j].z + va[j].w * va[j].w); sb += (vb[j].x * vb[j].x + vb[j].y * vb[j].y) + (vb[j].z * vb[j].z + vb[j].w * vb[j].w); }
#pragma unroll
            for (int o = 1; o < 64; o <<= 1) { sa += __shfl_xor(sa, o); sb += __shfl_xor(sb, o); }
            if (lane == 0) { RSTD[m] = rsqrtf(sa * (1.f / DM) + EPS); RSTD[m2] = rsqrtf(sb * (1.f / DM) + EPS); }
            v2u* oa = (v2u*)(XB + (size_t)m * DM) + lane; v2u* ob = (v2u*)(XB + (size_t)m2 * DM) + lane;
#pragma unroll
            for (int j = 0; j < 4; ++j) { v2u w; w.x = cvtpk(va[j].x, va[j].y); w.y = cvtpk(va[j].z, va[j].w); oa[64 * j] = w; w.x = cvtpk(vb[j].x, vb[j].y); w.y = cvtpk(vb[j].z, vb[j].w); ob[64 * j] = w; }
        }
        GRID_BAR();
    }

    for (int l = args.l_lo, l_end = args.l_hi; l < l_end; ++l) {
        if (IN(1)) REP(1) {
            PH_LOCALS();
            pg8::Gemm g{l == 0 ? XB : XD, Win_t + (size_t)l * NINP * DM, MTOK, NINP, DM}; pg8::StaticOrder S; S.init(MTOK, NINP, G, blk);
            pg8::EpiBf16<0> E{PROJ, NINP, RSTD};
            pg8::gemm_phase<pg8::EpiBf16<0>, pg8::StaticOrder, true, true>(lds + RING_OFF, g, S, E);
            GRID_BAR();
        }
        if (IN(2)) REP(2) {
            PH_LOCALS();
            REP(21) {
            {
                const float* kpos = ap->in[I_KPOS] + (size_t)l * 32 * 64; const float* vpos = ap->in[I_VPOS] + (size_t)l * 32 * 64;
                for (int row = gw; row < CMP_ROWS; row += NGW) {
                    const int i = row & 127, g = (row >> 7) & 1, b = (row >> 8) & 31, kv = row >> 13;
                    const float* pos = kv ? vpos : kpos; const int pc = (kv ? PC_VC : PC_KC) + g * 64;
#pragma unroll
                    for (int cch = 0; cch < 4; ++cch) { const int ch = lane + 64 * cch, tl = ch >> 3, d0 = (ch & 7) * 8;
                        v4u o = {0u, 0u, 0u, 0u};
                        if (i < 127) { const v4u s = *(const v4u*)(PROJ + ((size_t)b * SEQ + 16 * i + tl) * NINP + pc + d0);
                            const f32x4 p0 = *(const f32x4*)(pos + tl * 64 + d0), p1 = *(const f32x4*)(pos + tl * 64 + d0 + 4);
                            o.x = cvtpk(bflo(s.x) + p0.x, bfhi(s.x) + p0.y); o.y = cvtpk(bflo(s.y) + p0.z, bfhi(s.y) + p0.w);
                            o.z = cvtpk(bflo(s.z) + p1.x, bfhi(s.z) + p1.y); o.w = cvtpk(bflo(s.w) + p1.z, bfhi(s.w) + p1.w); }
                        *(v4u*)(ACMP + (size_t)row * CMP_K + tl * 64 + d0) = o; }
                }
            }
            for (size_t ch = (size_t)blk * NTHR + tid; ch < (size_t)MTOK * 32; ch += (size_t)G * NTHR) {
                const int cc = (int)(ch & 31), which = cc >> 4, g = (cc >> 3) & 1, d0 = (cc & 7) * 8; const size_t tok = ch >> 5; const int b = (int)(tok >> 11), t = (int)(tok & 2047);
                const v4u s = *(const v4u*)(PROJ + tok * NINP + (which ? PC_KW : PC_KS) + g * 64 + d0);
                *(v4u*)((which ? KW : KS) + ((size_t)(b * 2 + g) * SEQ + t) * 64 + d0) = s;
            }
            {
                LAS bf16* tile = (LAS bf16*)(lds + RING_OFF + wave * 16384);
                for (int it = gw; it < 2 * BATCH * 2 * 32; it += NGW) {
                    const int tt = it & 31, g = (it >> 5) & 1, b = (it >> 6) & 31, which = it >> 11; const int t0 = tt * 64;
                    const bf16* src = PROJ + ((size_t)b * SEQ + t0) * NINP + (which ? PC_VW : PC_VS) + g * 64;
#pragma unroll
                    for (int q = 0; q < 8; ++q) { const int t = (lane >> 3) + 8 * q, d0 = (lane & 7) * 8; const v4u s = *(const v4u*)(src + (size_t)t * NINP + d0);
                        LAS unsigned* dst = (LAS unsigned*)(tile + t * 66 + d0); dst[0] = s.x; dst[1] = s.y; dst[2] = s.z; dst[3] = s.w; }
                    LDS_WAIT(); asm volatile("" ::: "memory");
                    bf16* dstb = (which ? VWT : VST) + (size_t)(b * 2 + g) * 64 * SEQ + t0;
#pragma unroll
                    for (int q = 0; q < 8; ++q) { const int d = (lane >> 3) + 8 * q, ck = lane & 7, gI = ck >> 2, gqq = ck & 3;
                        unsigned short e[8];
#pragma unroll
                        for (int j = 0; j < 8; ++j) { const int key = 32 * gI + (j < 4 ? 4 * gqq + j : 16 + 4 * gqq + (j - 4)); e[j] = tile[key * 66 + d]; }
                        v4u o; o.x = e[0] | ((unsigned)e[1] << 16); o.y = e[2] | ((unsigned)e[3] << 16); o.z = e[4] | ((unsigned)e[5] << 16); o.w = e[6] | ((unsigned)e[7] << 16);
                        *(v4u*)(dstb + (size_t)d * SEQ + 8 * ck) = o; }
                    LDS_WAIT(); asm volatile("" ::: "memory");
                }
            }
            }
            __syncthreads();
            REP(22) {
                LAS float* hb = (LAS float*)(lds + RING_OFF); LAS float* yb = hb + 62 * 256;
                const float* dw = ap->in[I_CFW] + (size_t)l * 31 * 256; const float* db = ap->in[I_CFB] + (size_t)l * 256;
                const float* lw = ap->in[I_CFLNW] + (size_t)l * 256; const float* lb = ap->in[I_CFLNB] + (size_t)l * 256;
                const int ch = tid & 255, half = tid >> 8; float wv[31];
#pragma unroll
                for (int j = 0; j < 31; ++j) wv[j] = dw[j * 256 + ch];
                const float bias = db[ch];
                float lwv[4], lbv[4];
#pragma unroll
                for (int k = 0; k < 4; ++k) { lwv[k] = lw[lane + 64 * k]; lbv[k] = lb[lane + 64 * k]; }
                for (int u = blk; u < BATCH * 64; u += G) {
                    const int b = u >> 6, t0 = (u & 63) * 32;
                    for (int e = tid; e < 62 * 32; e += NTHR) { const int rr = e >> 5, c8 = (e & 31) * 8, t = t0 - 30 + rr;
                        f32x4 o0 = {0.f, 0.f, 0.f, 0.f}, o1 = o0;
                        if (t >= 0) { const bf16* pr = PROJ + ((size_t)b * SEQ + t) * NINP + PC_CF + c8; const v4u a = *(const v4u*)pr, gg = *(const v4u*)(pr + 256);
                            o0 = (f32x4){bflo(a.x) * sigmoid_f(bflo(gg.x)), bfhi(a.x) * sigmoid_f(bfhi(gg.x)), bflo(a.y) * sigmoid_f(bflo(gg.y)), bfhi(a.y) * sigmoid_f(bfhi(gg.y))};
                            o1 = (f32x4){bflo(a.z) * sigmoid_f(bflo(gg.z)), bfhi(a.z) * sigmoid_f(bfhi(gg.z)), bflo(a.w) * sigmoid_f(bflo(gg.w)), bfhi(a.w) * sigmoid_f(bfhi(gg.w))}; }
                        *(LAS f32x4*)(hb + rr * 256 + c8) = o0; *(LAS f32x4*)(hb + rr * 256 + c8 + 4) = o1; }
                    __syncthreads();
                    { float hv[46];
#pragma unroll
                        for (int k = 0; k < 46; ++k) hv[k] = hb[(16 * half + k) * 256 + ch];
#pragma unroll
                        for (int i = 0; i < 16; ++i) { float acc = bias;
#pragma unroll
                            for (int j = 0; j < 31; ++j) acc += wv[j] * hv[i + j];
                            yb[(16 * half + i) * 256 + ch] = acc; } }
                    __syncthreads();
                    { float y[4][4], s1[4], s2[4];
#pragma unroll
                        for (int i4 = 0; i4 < 4; ++i4) { s1[i4] = 0.f; s2[i4] = 0.f;
#pragma unroll
                            for (int k = 0; k < 4; ++k) { const float v = yb[(wave * 4 + i4) * 256 + lane + 64 * k]; y[i4][k] = v; s1[i4] += v; s2[i4] += v * v; } }
#pragma unroll
                        for (int o = 1; o < 64; o <<= 1)
#pragma unroll
                            for (int i4 = 0; i4 < 4; ++i4) { s1[i4] += __shfl_xor(s1[i4], o); s2[i4] += __shfl_xor(s2[i4], o); }
#pragma unroll
                        for (int i4 = 0; i4 < 4; ++i4) { const float mean = s1[i4] * (1.f / 256.f); const float var = fmaxf(s2[i4] * (1.f / 256.f) - mean * mean, 0.f); const float rs = rsqrtf(var + EPS);
                            bf16* orow = MIX + ((size_t)b * SEQ + t0 + wave * 4 + i4) * DM + 384;
#pragma unroll
                            for (int k = 0; k < 4; ++k) orow[lane + 64 * k] = f2bf(silu_f((y[i4][k] - mean) * rs * lwv[k] + lbv[k])); } }
                    __syncthreads();
                }
            }
            REP(23) {
                { const float* cwl = ap->in[I_DNCONV] + (size_t)l * 4 * 1152; const float* alog = ap->in[I_DNALOG] + l * 6; const float* dtbp = ap->in[I_DNDT] + l * 6;
                    for (int u = gw; u < BATCH * 6 * 32; u += NGW) { const int n = u & 31, bh = u >> 5, b = bh / 6, h = bh % 6;
                        dn_chunk_wave(lds + RING_OFF + wave * 16384, PROJ, cwl, __expf(alog[h]), dtbp[h], ws + WS_DNF + (size_t)u * DNF_UNIT, (float*)(ws + WS_GT) + u, b, h, n, lane); } }
            }
            GRID_BAR();
        }
        if (IN(3)) REP(3) {
            PH_LOCALS();
            if (blk < 64) {
                pg8::Gemm g{ACMP, Wc1_t + (size_t)l * 256 * CMP_K, CMP_ROWS, 256, CMP_K}; pg8::StaticOrder S; S.init(CMP_ROWS, 256, 64, blk);
                pg8::EpiBf16<1> E{HID, 256, nullptr};
                pg8::gemm_phase<pg8::EpiBf16<1>, pg8::StaticOrder, true, true>(lds + RING_OFF, g, S, E);
                pg8::Unit un; if (S.next(0, un)) { asm volatile("s_waitcnt vmcnt(0)" ::: "memory"); __syncthreads();
                    cmp_mlp2_tiles(HID, (const bf16*)(ws + WS_W2T) + (size_t)l * 2 * 64 * 128, KC, VCT, 16 * un.pm, 16 * un.pm + 16, NWAVES, wave, lane); }
            }
        }
        if (IN(11)) REP(11) {
            PH_LOCALS();
            if (blk >= 64 && blk < 64 + BATCH * 6)
                dn_scan_pair(lds, ws + WS_DNF, (const float*)(ws + WS_GT), PROJ, MIX, ap->in[I_DNNORM] + (size_t)l * 64, blk - 64, lane, wave);
            GRID_BAR();
        }
        if (IN(5)) REP(5) {
            PH_LOCALS();
            NsaPtrs P{PROJ, KC, VCT, KS, VST, KW, VWT, MIX};
            for (int u = blk; u < 1024; u += G) {
                const int hi4 = u >> 8, lo8 = u & 255, b = lo8 >> 3, g = (lo8 >> 2) & 1, q4 = lo8 & 3;
                const int q8 = hi4 == 0 ? q4 : (hi4 == 1 ? 15 - q4 : (hi4 == 2 ? 4 + q4 : 11 - q4));
                __syncthreads();
                nsa_stage_cmp(lds, P, b, g, tid);
                __syncthreads();
                nsa_item(P, lds, wave, b, g, (q8 * 8 + wave) * 16, tid, lane);
            }
            GRID_BAR();
        }
        if (IN(6)) REP(6) {
            PH_LOCALS();
            pg8::Gemm g{MIX, Wout_t + (size_t)l * DM * DM, MTOK, DM, DM}; pg8::StaticOrder S; S.init(MTOK, DM, G, blk);
            pg8::EpiBf16<0> E{MBUF, DM, nullptr};
            pg8::gemm_phase<pg8::EpiBf16<0>, pg8::StaticOrder, true, true>(lds + RING_OFF, g, S, E);
            GRID_BAR();
        }
        if (IN(7)) REP(7) {
            PH_LOCALS();
            const float* wp = ap->in[I_NORMW] + ((size_t)l * 4 + 1) * DM; bf16* const xo = (l == DEPTH - 1) ? XM : XD;
            constexpr int HM = MTOK / 2;
            if (l == 0) { for (int m = gw; m < HM; m += NGW) resid_row2<true, false>(x_in + (size_t)m * DM, x_in + (size_t)(m + HM) * DM, MBUF + (size_t)m * DM, MBUF + (size_t)(m + HM) * DM, wp, xo + (size_t)m * DM, xo + (size_t)(m + HM) * DM, RSTD + m, RSTD + m + HM, lane); }
            else { for (int m = gw; m < HM; m += NGW) resid_row2<false, false>(XD + (size_t)m * DM, XD + (size_t)(m + HM) * DM, MBUF + (size_t)m * DM, MBUF + (size_t)(m + HM) * DM, wp, xo + (size_t)m * DM, xo + (size_t)(m + HM) * DM, RSTD + m, RSTD + m + HM, lane); }
            GRID_BAR();
        }
        if (IN(8)) REP(8) {
            PH_LOCALS();
            pg8::Gemm g{(l == DEPTH - 1) ? XM : XD, Wgu_t + (size_t)l * NGU * DM, MTOK, NGU, DM}; pg8::StaticOrder S; S.init(MTOK, NGU, G, blk);
            pg8::EpiSwiGLU E{HFF, DFF, RSTD};
            pg8::gemm_phase<pg8::EpiSwiGLU, pg8::StaticOrder, true, true>(lds + RING_OFF, g, S, E);
            GRID_BAR();
        }
        if (IN(9)) REP(9) {
            PH_LOCALS();
            pg8::Gemm g{HFF, Wd_t + (size_t)l * DM * DFF, MTOK, DM, DFF}; pg8::StaticOrder S; S.init(MTOK, DM, G, blk);
            pg8::EpiBf16<0> E{MBUF, DM, nullptr};
            pg8::gemm_phase<pg8::EpiBf16<0>, pg8::StaticOrder, true, true>(lds + RING_OFF, g, S, E);
            GRID_BAR();
        }
        if (IN(10)) REP(10) {
            PH_LOCALS();
            const float* wp = ap->in[I_NORMW] + ((size_t)l * 4 + 3) * DM;
            constexpr int HM = MTOK / 2;
            if (l == DEPTH - 1) { for (int m = gw; m < HM; m += NGW) resid_row2<false, true>(XM + (size_t)m * DM, XM + (size_t)(m + HM) * DM, MBUF + (size_t)m * DM, MBUF + (size_t)(m + HM) * DM, wp, xres + (size_t)m * DM, xres + (size_t)(m + HM) * DM, RSTD + m, RSTD + m + HM, lane); }
            else { for (int m = gw; m < HM; m += NGW) resid_row2<false, false>(XD + (size_t)m * DM, XD + (size_t)(m + HM) * DM, MBUF + (size_t)m * DM, MBUF + (size_t)(m + HM) * DM, wp, XD + (size_t)m * DM, XD + (size_t)(m + HM) * DM, RSTD + m, RSTD + m + HM, lane); }
            if (l + 1 < ap->l_hi) GRID_BAR();
        }
    }
#undef IN
}

template <unsigned PHM> static int setup_kernel() {
    if (hipFuncSetAttribute((const void*)fwd<PHM>, hipFuncAttributeMaxDynamicSharedMemorySize, LDS_BYTES) != hipSuccess) { fprintf(stderr, "kernel_launch: hipFuncSetAttribute failed (mask %x)\n", PHM); return -1; }
    int per_cu = 0;
    if (hipOccupancyMaxActiveBlocksPerMultiprocessor(&per_cu, (const void*)fwd<PHM>, NTHR, LDS_BYTES) != hipSuccess || per_cu < 1) fprintf(stderr, "kernel_launch: occupancy query reports %d (mask %x)\n", per_cu, PHM);
    (void)hipGetLastError();
    return 0;
}
template <unsigned PHM> static void launch_ph(int grid, hipStream_t stream, const Args& a) { hipLaunchKernelGGL(fwd<PHM>, dim3(grid), dim3(NTHR), LDS_BYTES, stream, a); }
#ifndef PH_ALL_MASK
#define PH_ALL_MASK 0xfffu
#endif
constexpr unsigned PH_ALL = PH_ALL_MASK;
extern "C" void kernel_launch(void* const* d_in, const int* in_sizes, int n_in, void* d_out, int out_size, void* d_ws, size_t ws_size, hipStream_t stream) {
    static int grid = 0;
    if (grid == 0) {
        if (n_in != 21 || in_sizes[0] != MTOK * DM || out_size != MTOK * DM || ws_size < WS_END) { fprintf(stderr, "kernel_launch: unexpected shapes (n_in %d, in0 %d, out %d, ws %zu); nothing launched\n", n_in, n_in > 0 ? in_sizes[0] : -1, out_size, ws_size); grid = -1; return; }
        int dev = 0, cus = 0;
        if (hipGetDevice(&dev) != hipSuccess || hipDeviceGetAttribute(&cus, hipDeviceAttributeMultiprocessorCount, dev) != hipSuccess) { grid = -1; return; }
        int rc = 0;
#if MK_ONE_LAUNCH
        rc |= setup_kernel<PH_ALL>();
#else
        rc |= setup_kernel<1u << 0>(); rc |= setup_kernel<1u << 1>(); rc |= setup_kernel<1u << 2>(); rc |= setup_kernel<1u << 3>(); rc |= setup_kernel<1u << 4>(); rc |= setup_kernel<1u << 5>();
        rc |= setup_kernel<1u << 6>(); rc |= setup_kernel<1u << 7>(); rc |= setup_kernel<1u << 8>(); rc |= setup_kernel<1u << 9>(); rc |= setup_kernel<1u << 10>(); rc |= setup_kernel<1u << 11>();
#endif
        if (rc) { grid = -1; return; }
        grid = cus;
        if (grid < 128) { fprintf(stderr, "kernel_launch: needs >= 128 CUs\n"); grid = -1; return; }
    }
    if (grid < 0) return;
    if (hipMemsetAsync((char*)d_ws + WS_CTL, 0, CTL_ZERO_BYTES, stream) != hipSuccess) return;
    Args a{};
    for (int i = 0; i < 21; ++i) a.in[i] = (const float*)d_in[i];
    a.out = (float*)d_out; a.ws = (unsigned char*)d_ws;
#if MK_ONE_LAUNCH
    a.pre = 1; a.ph_lo = 1; a.ph_hi = 12; a.l_lo = 0; a.l_hi = DEPTH;
    launch_ph<PH_ALL>(grid, stream, a);
#else
    a.pre = 1; a.ph_lo = 0; a.ph_hi = 0; a.l_lo = 0; a.l_hi = 0;
    launch_ph<1u << 0>(grid, stream, a);
    for (int l = 0; l < DEPTH; ++l) {
        a.pre = 0; a.l_lo = l; a.l_hi = l + 1;
#define LP(p) do { a.ph_lo = (p); a.ph_hi = (p) + 1; launch_ph<1u << (p)>(grid, stream, a); } while (0)
        LP(1); LP(2); LP(3); LP(11); LP(4); LP(5); LP(6); LP(7); LP(8); LP(9); LP(10);
#undef LP
    }
#endif
}
```

```cpp
#include <hip/hip_runtime.h>
#include <cstdio>
#include <cstdint>

#ifndef PROBE_PH
#define PROBE_PH 0
#define PROBE_N 1
#endif
#define REP(k) for (int rep_ = 0; rep_ < ((k) == PROBE_PH ? PROBE_N : 1); ++rep_)
#ifndef MK_ONE_LAUNCH
#define MK_ONE_LAUNCH 1
#endif

namespace pg8 {
#define PG8_LAS __attribute__((address_space(3)))
typedef unsigned short bf16_t;
typedef short bf16x8 __attribute__((ext_vector_type(8)));
typedef float f32x4 __attribute__((ext_vector_type(4)));
typedef unsigned u32x4 __attribute__((ext_vector_type(4)));
constexpr int BM = 256, BK = 64, HALF = 128, HTB = HALF * BK * 2  , STAGE_BYTES = 8 * HTB, NXCD = 8, WGM = 4;

__host__ __device__ __forceinline__ int lds_byte(int r, int c) { const int st = (r >> 4) * 2 + (c >> 5), rr = r & 15, cc = c & 31, ob = rr * 64 + cc * 2; return st * 1024 + (ob ^ (((ob >> 9) & 1) << 5)); }
__host__ __device__ __forceinline__ void stage_rc(int b, int& R, int& C) { const int st = b / 1024, sb = b % 1024, swz = sb ^ (((sb >> 9) & 1) << 5); R = (st >> 1) * 16 + swz / 64; C = (st & 1) * 32 + (swz % 64) / 2; }
__host__ __device__ __forceinline__ int perm32(int rho) { const int n = rho >> 4, i = rho & 15; return 8 * (i >> 2) + 4 * n + (i & 3); }

struct Unit { int pm, pn; };
struct Gemm { const bf16_t* A; const bf16_t* Bt; int M, N, K; };

struct StaticOrder {
    int nM, nN, nwg, G, c;
    __host__ __device__ void init(int M, int N, int G_, int c_) { nM = M / BM; nN = N / BM; nwg = nM * nN; G = G_; c = c_; }
    __host__ __device__ bool next(int i, Unit& u) const {
        const long L = (long)i * G + c; if (L >= nwg) return false;
        int wgid = (int)L; { const int q = nwg / NXCD, r = nwg % NXCD, xcd = wgid % NXCD, off = wgid / NXCD; wgid = (xcd < r ? xcd * (q + 1) : r * (q + 1) + (xcd - r) * q) + off; }
        const int nig = WGM * nN, gid = wgid / nig, fm = gid * WGM, gsz = (nM - fm) < WGM ? (nM - fm) : WGM;
        u.pm = fm + ((wgid % nig) % gsz); u.pn = (wgid % nig) / gsz; return true;
    }
    __device__ __forceinline__ void a_ready(const Unit&) const {}
    __device__ __forceinline__ void done(const Unit&) const {}
};

__device__ __forceinline__ unsigned cvt_pk_bf16(float lo, float hi) { unsigned r; asm volatile("v_cvt_pk_bf16_f32 %0, %1, %2" : "=v"(r) : "v"(lo), "v"(hi)); return r; }
typedef float f32x2 __attribute__((ext_vector_type(2)));
__device__ __forceinline__ float silu_f(float v) { return v / (1.0f + __expf(-v)); }
template <int ACT> struct EpiBf16 {
    static constexpr bool PERM = true, AFTER_DRAIN = false;
    bf16_t* O; int ldc; const float* rs;
    __device__ __forceinline__ void operator()(const f32x4 (&acc)[2][2][4][2], const Unit& u, int wr, int wc, int fr, int fq) const {
        const int row0 = u.pm * BM + wr * 64 + fr; const int col0 = u.pn * BM + wc * 32 + 8 * fq;
#pragma unroll
        for (int ai = 0; ai < 2; ++ai)
#pragma unroll
            for (int m = 0; m < 4; ++m) { bf16_t* rowp = O + (size_t)(row0 + ai * HALF + m * 16) * ldc + col0; const float sc = rs ? rs[row0 + ai * HALF + m * 16] : 1.0f;
#pragma unroll
                for (int bj = 0; bj < 2; ++bj) { f32x4 v0 = acc[ai][bj][m][0] * sc, v1 = acc[ai][bj][m][1] * sc;
                    if (ACT == 1) {
#pragma unroll
                        for (int j = 0; j < 4; ++j) { v0[j] = silu_f(v0[j]); v1[j] = silu_f(v1[j]); } }
                    u32x4 w; w.x = cvt_pk_bf16(v0[0], v0[1]); w.y = cvt_pk_bf16(v0[2], v0[3]); w.z = cvt_pk_bf16(v1[0], v1[1]); w.w = cvt_pk_bf16(v1[2], v1[3]);
                    *(u32x4*)(rowp + bj * HALF) = w; } }
    }
};
struct EpiSwiGLU {
    static constexpr bool PERM = true, AFTER_DRAIN = false;
    bf16_t* O; int ldc; const float* rs;
    __device__ __forceinline__ void operator()(const f32x4 (&acc)[2][2][4][2], const Unit& u, int wr, int wc, int fr, int fq) const {
        const int row0 = u.pm * BM + wr * 64 + fr; const int col0 = u.pn * HALF + wc * 32 + 8 * fq;
#pragma unroll
        for (int ai = 0; ai < 2; ++ai)
#pragma unroll
            for (int m = 0; m < 4; ++m) { bf16_t* rowp = O + (size_t)(row0 + ai * HALF + m * 16) * ldc + col0; const float sc = rs[row0 + ai * HALF + m * 16];
                f32x4 g0 = acc[ai][0][m][0] * sc, g1 = acc[ai][0][m][1] * sc; const f32x4 u0 = acc[ai][1][m][0] * sc, u1 = acc[ai][1][m][1] * sc;
#pragma unroll
                for (int j = 0; j < 4; ++j) { g0[j] = silu_f(g0[j]) * u0[j]; g1[j] = silu_f(g1[j]) * u1[j]; }
                u32x4 w; w.x = cvt_pk_bf16(g0[0], g0[1]); w.y = cvt_pk_bf16(g0[2], g0[3]); w.z = cvt_pk_bf16(g1[0], g1[1]); w.w = cvt_pk_bf16(g1[2], g1[3]);
                *(u32x4*)rowp = w; }
    }
};

template <class Epi, class Sched, bool ALIGN_EPI = false, bool SP2 = false>
__device__ __forceinline__ void gemm_phase(PG8_LAS unsigned char* lds, const Gemm g, const Sched& S, const Epi& E) {
    int tid = threadIdx.x; asm volatile("" : "+v"(tid));
    const int wid = __builtin_amdgcn_readfirstlane(tid >> 6), lane = tid & 63, wr = wid >> 2, wc = wid & 3, fr = lane & 15, fq = lane >> 4;
    const int K = g.K, nt = K / BK;
    unsigned voffA[2], voffB[2];
#pragma unroll
    for (int i = 0; i < 2; ++i) { int R, C; stage_rc(tid * 16 + i * 8192, R, C); const int Rb = Epi::PERM ? ((R & ~31) + perm32(R & 31)) : R;
        voffA[i] = (unsigned)(R * K + C) * 2u; voffB[i] = (unsigned)(Rb * K + C) * 2u; }
    const size_t kstep = (size_t)(BK * 2);
    const size_t hstep = (size_t)HALF * K * 2;
    const size_t tstep = 2 * hstep;
    const unsigned ldsw = (unsigned)wid * 1024u;
    const int aoff = lds_byte(wr * 64 + fr, fq * 8), boff = lds_byte(wc * 32 + fr, fq * 8);
#define PG8_SA(b, h) (((b) * 2 + (h)) * HTB)
#define PG8_SB(b, h) ((4 + (b) * 2 + (h)) * HTB)
#define PG8_STAGE(bufoff, gbase, voff) do { _Pragma("unroll") for (int _i = 0; _i < 2; ++_i) \
        __builtin_amdgcn_global_load_lds((const unsigned*)((const char*)(gbase) + (voff)[_i]), (PG8_LAS unsigned*)(lds + (bufoff) + ldsw + _i * 8192), 16, 0, 0); } while (0)
#define PG8_LDA(dst, b, h) do { _Pragma("unroll") for (int m = 0; m < 4; ++m) _Pragma("unroll") for (int k = 0; k < 2; ++k) dst[m][k] = *(const PG8_LAS bf16x8*)(lds + PG8_SA(b, h) + aoff + m * 2048 + k * 1024); } while (0)
#define PG8_LDB(dst, b, h) do { _Pragma("unroll") for (int n = 0; n < 2; ++n) _Pragma("unroll") for (int k = 0; k < 2; ++k) dst[n][k] = *(const PG8_LAS bf16x8*)(lds + PG8_SB(b, h) + boff + n * 2048 + k * 1024); } while (0)
#define PG8_MMA(ai, bj, At, Bt) do { __builtin_amdgcn_s_setprio(1); _Pragma("unroll") for (int m = 0; m < 4; ++m) _Pragma("unroll") for (int n = 0; n < 2; ++n) _Pragma("unroll") for (int k = 0; k < 2; ++k) \
        acc[ai][bj][m][n] = __builtin_amdgcn_mfma_f32_16x16x32_bf16(Bt[n][k], At[m][k], acc[ai][bj][m][n], 0, 0, 0); __builtin_amdgcn_s_setprio(0); } while (0)
#define PG8_WAIT_V(n) asm volatile("s_waitcnt vmcnt(" #n ")" ::: "memory")
#define PG8_WAIT_L(n) asm volatile("s_waitcnt lgkmcnt(" #n ")" ::: "memory")
#define PG8_BAR __builtin_amdgcn_s_barrier()
#define PG8_SCHED __builtin_amdgcn_sched_barrier(0)
    Unit cur, nxt; int ui = 0;
    if (!S.next(0, cur)) return;
    f32x4 acc[2][2][4][2];
#pragma unroll
    for (int a = 0; a < 2; ++a)
#pragma unroll
        for (int b = 0; b < 2; ++b)
#pragma unroll
            for (int m = 0; m < 4; ++m)
#pragma unroll
                for (int n = 0; n < 2; ++n) acc[a][b][m][n] = (f32x4){0.f, 0.f, 0.f, 0.f};
    bf16x8 At[4][2], B0[2][2], B1[2][2];
    const char* cA = (const char*)g.A + (size_t)cur.pm * tstep; const char* cB = (const char*)g.Bt + (size_t)cur.pn * tstep;
    S.a_ready(cur);
    if constexpr (SP2) {
        PG8_STAGE(PG8_SB(0, 0), cB, voffB); PG8_STAGE(PG8_SB(0, 1), cB + hstep, voffB); PG8_STAGE(PG8_SA(0, 0), cA, voffA); PG8_STAGE(PG8_SA(0, 1), cA + hstep, voffA);
        if (wr == 1) PG8_BAR;
        PG8_WAIT_V(2); PG8_BAR;
        PG8_STAGE(PG8_SB(1, 0), cB + kstep, voffB); PG8_STAGE(PG8_SA(1, 0), cA + kstep, voffA); PG8_STAGE(PG8_SB(1, 1), cB + hstep + kstep, voffB);
        PG8_WAIT_V(6); PG8_BAR;
    } else {
        PG8_STAGE(PG8_SB(0, 0), cB, voffB); PG8_STAGE(PG8_SA(0, 0), cA, voffA); PG8_STAGE(PG8_SB(0, 1), cB + hstep, voffB); PG8_STAGE(PG8_SA(0, 1), cA + hstep, voffA);
        if (wr == 1) PG8_BAR;
        PG8_WAIT_V(4); PG8_BAR;
        PG8_STAGE(PG8_SB(1, 0), cB + kstep, voffB); PG8_STAGE(PG8_SA(1, 0), cA + kstep, voffA); PG8_STAGE(PG8_SB(1, 1), cB + hstep + kstep, voffB);
        PG8_WAIT_V(6); PG8_BAR;
    }
    for (;;) {
        const bool has_next = S.next(ui + 1, nxt);
        const char* nA = has_next ? (const char*)g.A + (size_t)nxt.pm * tstep : cA; const char* nB = has_next ? (const char*)g.Bt + (size_t)nxt.pn * tstep : cB;
        for (int t = 0; t < nt; t += 2) {
            const bool last = (t == nt - 2);
            const char* a1 = cA + (size_t)(t + 1) * kstep;
            const char* a2 = last ? nA : cA + (size_t)(t + 2) * kstep; const char* b2 = last ? nB : cB + (size_t)(t + 2) * kstep;
            const char* a3 = a2 + kstep; const char* b3 = b2 + kstep;
            if (last && has_next) S.a_ready(nxt);
            if constexpr (SP2) {
            PG8_LDB(B0, 0, 0); PG8_LDB(B1, 0, 1); PG8_SCHED; PG8_LDA(At, 0, 0); PG8_STAGE(PG8_SA(1, 1), a1 + hstep, voffA);
            PG8_WAIT_V(8); PG8_WAIT_L(0); PG8_BAR; PG8_MMA(0, 0, At, B0); PG8_MMA(0, 1, At, B1); PG8_BAR; PG8_SCHED;
            PG8_LDA(At, 0, 1); PG8_STAGE(PG8_SB(0, 0), b2, voffB); PG8_STAGE(PG8_SB(0, 1), b2 + hstep, voffB); PG8_STAGE(PG8_SA(0, 0), a2, voffA);
            PG8_WAIT_V(8); PG8_WAIT_L(0); PG8_BAR; PG8_MMA(1, 0, At, B0); PG8_MMA(1, 1, At, B1); PG8_BAR; PG8_SCHED;
            PG8_LDB(B0, 1, 0); PG8_LDB(B1, 1, 1); PG8_SCHED; PG8_LDA(At, 1, 0); PG8_STAGE(PG8_SA(0, 1), a2 + hstep, voffA);
            PG8_WAIT_V(8); PG8_WAIT_L(0); PG8_BAR; PG8_MMA(0, 0, At, B0); PG8_MMA(0, 1, At, B1); PG8_BAR; PG8_SCHED;
            PG8_LDA(At, 1, 1); PG8_STAGE(PG8_SB(1, 0), b3, voffB); PG8_STAGE(PG8_SB(1, 1), b3 + hstep, voffB); PG8_STAGE(PG8_SA(1, 0), a3, voffA);
            PG8_WAIT_V(8); PG8_WAIT_L(0); PG8_BAR; PG8_MMA(1, 0, At, B0); PG8_MMA(1, 1, At, B1); PG8_BAR; PG8_SCHED;
            } else {
            PG8_LDB(B0, 0, 0); PG8_SCHED; PG8_LDA(At, 0, 0); PG8_STAGE(PG8_SA(1, 1), a1 + hstep, voffA);
            PG8_WAIT_L(8); PG8_BAR; PG8_WAIT_L(0); PG8_MMA(0, 0, At, B0); PG8_BAR; PG8_SCHED;
            PG8_LDB(B1, 0, 1); PG8_STAGE(PG8_SB(0, 0), b2, voffB);
            PG8_BAR; PG8_WAIT_L(0); PG8_MMA(0, 1, At, B1); PG8_BAR;
            PG8_LDA(At, 0, 1); PG8_STAGE(PG8_SA(0, 0), a2, voffA);
            PG8_BAR; PG8_WAIT_L(0); PG8_MMA(1, 0, At, B0); PG8_BAR; PG8_SCHED;
            PG8_STAGE(PG8_SB(0, 1), b2 + hstep, voffB);
            PG8_WAIT_V(6); PG8_BAR; PG8_MMA(1, 1, At, B1); PG8_BAR;
            PG8_LDB(B0, 1, 0); PG8_SCHED; PG8_LDA(At, 1, 0); PG8_STAGE(PG8_SA(0, 1), a2 + hstep, voffA);
            PG8_WAIT_L(8); PG8_BAR; PG8_WAIT_L(0); PG8_MMA(0, 0, At, B0); PG8_BAR; PG8_SCHED;
            PG8_LDB(B1, 1, 1); PG8_STAGE(PG8_SB(1, 0), b3, voffB);
            PG8_BAR; PG8_WAIT_L(0); PG8_MMA(0, 1, At, B1); PG8_BAR;
            PG8_LDA(At, 1, 1); PG8_STAGE(PG8_SA(1, 0), a3, voffA);
            PG8_BAR; PG8_WAIT_L(0); PG8_MMA(1, 0, At, B0); PG8_BAR; PG8_SCHED;
            PG8_STAGE(PG8_SB(1, 1), b3 + hstep, voffB);
            PG8_WAIT_V(6); PG8_BAR; PG8_MMA(1, 1, At, B1); PG8_BAR;
            }
        }
        if constexpr (ALIGN_EPI) { if (wr == 0) PG8_BAR; }
        if constexpr (!Epi::AFTER_DRAIN) { E(acc, cur, wr, wc, fr, fq); S.done(cur); }
        if (!has_next) break;
#pragma unroll
        for (int a = 0; a < 2; ++a)
#pragma unroll
            for (int b = 0; b < 2; ++b)
#pragma unroll
                for (int m = 0; m < 4; ++m)
#pragma unroll
                    for (int n = 0; n < 2; ++n) acc[a][b][m][n] = (f32x4){0.f, 0.f, 0.f, 0.f};
        cur = nxt; cA = nA; cB = nB; ++ui;
        if constexpr (ALIGN_EPI) { if (wr == 1) PG8_BAR; }
    }
    PG8_WAIT_V(0);
    if constexpr (!ALIGN_EPI) { if (wr == 0) PG8_BAR; }
    PG8_BAR;
    if constexpr (Epi::AFTER_DRAIN) { E.fused(acc, cur, wr, wc, fr, fq, lds, wid, lane); S.done(cur); }
#undef PG8_SA
#undef PG8_SB
#undef PG8_STAGE
#undef PG8_LDA
#undef PG8_LDB
#undef PG8_MMA
#undef PG8_WAIT_V
#undef PG8_WAIT_L
#undef PG8_BAR
#undef PG8_SCHED
}
}

constexpr int NWAVES = 8, NTHR = 512;
constexpr int BATCH = 32, SEQ = 2048, DM = 1024, DEPTH = 2, MTOK = BATCH * SEQ;
constexpr int NIN = 3230, NINP = 3328, DFF = 2816, NGU = 2 * DFF;
constexpr int PC_QKV = 0, PC_Z = 1152, PC_CF = 1536, PC_NQ = 2048, PC_KC = 2432, PC_VC = 2560, PC_KS = 2688, PC_VS = 2816, PC_KW = 2944, PC_VW = 3072, PC_B = 3200, PC_A = 3206, PC_GATE = 3212;
constexpr float EPS = 1e-6f;
constexpr int CMP_ROWS = 16384, CMP_K = 2048;
constexpr int NPH = 10;

constexpr size_t MiB = 1u << 20;
constexpr size_t WS_CTL = 0, CTL_ZERO_BYTES = 1 * MiB;
constexpr size_t WS_WIN = 2 * MiB;
constexpr size_t WS_WOUT = 16 * MiB;
constexpr size_t WS_WGU = 20 * MiB;
constexpr size_t WS_WD = 42 * MiB;
constexpr size_t WS_WC1 = 53 * MiB;
constexpr size_t WS_W2T = 55 * MiB;
constexpr size_t WS_KC = 56 * MiB;
constexpr size_t WS_VCT = 57 * MiB;
constexpr size_t WS_PROJ = 64 * MiB;
constexpr size_t WS_MIX = 480 * MiB;
constexpr size_t WS_MBUF = 608 * MiB;
constexpr size_t WS_XB = 736 * MiB;
constexpr size_t WS_ACMP = 864 * MiB;
constexpr size_t WS_HID = 928 * MiB;
constexpr size_t WS_KS = 936 * MiB, WS_KW = 952 * MiB, WS_VST = 968 * MiB, WS_VWT = 984 * MiB;
constexpr size_t WS_DNF = WS_MBUF;
constexpr size_t WS_GT = 1000 * MiB;
constexpr size_t WS_RSTD = 1001 * MiB;
constexpr size_t WS_END = 1002 * MiB;
constexpr int CW_TMO = 0, CW_BAR = 4096;

constexpr int RING_OFF = 0, RING_BYTES = 131072, XTRA_OFF = 147456;
constexpr int LDSCTL_OFF = RING_BYTES, MISC_OFF = LDSCTL_OFF + 320;
constexpr int LDS_BYTES = 163840;

#define GAS __attribute__((address_space(1)))
#define LAS __attribute__((address_space(3)))
typedef unsigned short bf16;
typedef unsigned v4u __attribute__((ext_vector_type(4)));
typedef unsigned v2u __attribute__((ext_vector_type(2)));
typedef float f32x4 __attribute__((ext_vector_type(4)));
typedef float f32x2 __attribute__((ext_vector_type(2)));
typedef short bf16x8 __attribute__((ext_vector_type(8)));
struct Args;
typedef __bf16 bf16x2_t __attribute__((ext_vector_type(2)));
#define LDS_WAIT() asm volatile("s_waitcnt lgkmcnt(0)" ::: "memory")
#define VM_WAIT() asm volatile("s_waitcnt vmcnt(0)" ::: "memory")
__device__ __forceinline__ unsigned cvtpk(float lo, float hi) { f32x2 v = {lo, hi}; bf16x2_t b = __builtin_convertvector(v, bf16x2_t); return __builtin_bit_cast(unsigned, b); }
__device__ __forceinline__ bf16 f2bf(float f) { return (bf16)(cvtpk(f, 0.f) & 0xffffu); }
__device__ __forceinline__ float bf2f(bf16 v) { return __uint_as_float(((unsigned)v) << 16); }
__device__ __forceinline__ float bflo(unsigned w) { return __uint_as_float(w << 16); }
__device__ __forceinline__ float bfhi(unsigned w) { return __uint_as_float(w & 0xffff0000u); }
__device__ __forceinline__ float sigmoid_f(float v) { return __builtin_amdgcn_rcpf(1.0f + __builtin_amdgcn_exp2f(-1.4426950408889634f * v)); }
__device__ __forceinline__ float silu_f(float v) { return v * sigmoid_f(v); }
__device__ __forceinline__ float wave_sum(float v) {
#pragma unroll
    for (int o = 1; o < 64; o <<= 1) v += __shfl_xor(v, o);
    return v;
}

#define XB_TMO      128
#define XB_XCNT(j)  (256  + 64 * (j))
#define XB_XSUB(j)  (1280 + 64 * (j))
#define XB_XGEN(j)  (2304 + 64 * (j))
#define XB_TOP      3328
#define XB_TOPGEN   3392
#define XCD_BAR_WORDS 3456
#define XB_SPIN_CAP (1u << 18)
__device__ __forceinline__ unsigned xb_ld(unsigned* p)              { return __hip_atomic_load(p, __ATOMIC_RELAXED, __HIP_MEMORY_SCOPE_AGENT); }
__device__ __forceinline__ unsigned xb_add(unsigned* p, unsigned v) { return __hip_atomic_fetch_add(p, v, __ATOMIC_RELAXED, __HIP_MEMORY_SCOPE_AGENT); }
__device__ __forceinline__ unsigned xb_xcc_id() { return (unsigned)__builtin_amdgcn_s_getreg((3 << 11) | 20) & 0xFu; }
#define XB_SPIN(cond, bar) do { unsigned _sp = 0; while (cond) { __builtin_amdgcn_s_sleep(1); \
    if ((++_sp & 255u) == 0u) { if (xb_ld(&(bar)[XB_TMO])) break; if (_sp > XB_SPIN_CAP) { atomicAdd(&(bar)[XB_TMO], 1u); break; } } } } while (0)
struct XcdBarrier { unsigned* bar; unsigned x; volatile LAS unsigned* st; };
__device__ __forceinline__ XcdBarrier xcd_barrier_post(unsigned* bar, volatile LAS unsigned* st) {
    XcdBarrier b; b.bar = bar; b.x = xb_xcc_id(); b.st = st;
    if (threadIdx.x == 0) (void)xb_add(&bar[XB_XCNT(b.x)], 1u);
    return b;
}
__device__ __forceinline__ void xcd_barrier_complete(unsigned* bar, unsigned x, unsigned& nloc, unsigned& nx) {
    const unsigned G = gridDim.x * gridDim.y * gridDim.z;
    unsigned sum, cnt, mine, sp = 0u;
    for (;;) {
        sum = 0u; cnt = 0u; mine = 0u;
#pragma unroll
        for (unsigned j = 0; j < 16; ++j) { const unsigned c = xb_ld(&bar[XB_XCNT(j)]); sum += c; cnt += (c > 0u) ? 1u : 0u; mine = (j == x) ? c : mine; }
        if (sum == G) break;
        __builtin_amdgcn_s_sleep(1);
        if ((++sp & 255u) == 0u) { if (xb_ld(&bar[XB_TMO])) break; if (sp > XB_SPIN_CAP) { atomicAdd(&bar[XB_TMO], 1u); break; } }
    }
    nloc = mine > 0u ? mine : 1u; nx = cnt > 0u ? cnt : 1u;
}
__device__ __forceinline__ void xcd_barrier(const XcdBarrier& b) {
    asm volatile("s_waitcnt vmcnt(0)" ::: "memory");
    __syncthreads();
    if (threadIdx.x == 0) {
        unsigned* bar = b.bar;
        __builtin_amdgcn_s_waitcnt(0);
        unsigned nloc = b.st[0], nx = b.st[1];
        if (nloc == 0u) { xcd_barrier_complete(bar, b.x, nloc, nx); b.st[0] = nloc; b.st[1] = nx; }
        const unsigned old = xb_add(&bar[XB_XSUB(b.x)], 1u);
        const unsigned gen = old / nloc;
        if (old + 1u == (gen + 1u) * nloc) {
            __builtin_amdgcn_fence(__ATOMIC_RELEASE, "agent");
            asm volatile("s_waitcnt vmcnt(0)" ::: "memory");
            const unsigned og = xb_add(&bar[XB_TOP], 1u);
            const unsigned tg = og / nx;
            if (og + 1u == (tg + 1u) * nx) xb_add(&bar[XB_TOPGEN], 1u);
            else XB_SPIN(xb_ld(&bar[XB_TOPGEN]) == tg, bar);
            __builtin_amdgcn_fence(__ATOMIC_ACQUIRE, "agent");
            xb_add(&bar[XB_XGEN(b.x)], 1u);
            asm volatile("s_waitcnt vmcnt(0)" ::: "memory");
        } else {
            XB_SPIN(xb_ld(&bar[XB_XGEN(b.x)]) == gen, bar);
            __builtin_amdgcn_fence(__ATOMIC_ACQUIRE, "agent");
            asm volatile("s_waitcnt vmcnt(0)" ::: "memory");
        }
    }
    __syncthreads();
}

template <class SrcFn>
__device__ __forceinline__ void wprep_item(const SrcFn& src, int K, bf16* WT, LAS float* scr, int item, int nblk, int lane) {
    const int kb = item / nblk, nb = item % nblk, k0 = 64 * kb, n0 = 32 * nb;
#pragma unroll 8
    for (int i = 0; i < 32; ++i) { const int kk = 2 * i + (lane >> 5); scr[kk * 33 + (lane & 31)] = src(k0 + kk, n0 + (lane & 31)); }
    LDS_WAIT(); asm volatile("" ::: "memory");
    const int c = lane & 7;
#pragma unroll
    for (int j = 0; j < 4; ++j) { const int n = (lane >> 3) + 8 * j; const LAS float* s = scr + (8 * c) * 33 + n;
        v4u o; o.x = cvtpk(s[0 * 33], s[1 * 33]); o.y = cvtpk(s[2 * 33], s[3 * 33]); o.z = cvtpk(s[4 * 33], s[5 * 33]); o.w = cvtpk(s[6 * 33], s[7 * 33]);
        *(v4u*)(WT + (size_t)(n0 + n) * K + k0 + 8 * c) = o; }
    LDS_WAIT(); asm volatile("" ::: "memory");
}
__device__ __forceinline__ int win_src_col(int n) {
    return n < 1536 ? n : (n < 3200 ? n + 12 : (n < 3212 ? n - 3200 + 1536 : (n < NIN ? n : -1)));
}
__device__ __forceinline__ void x_row_to_bf16(const float* xrow, bf16* orow, float* rstd, int lane) {
    const f32x4* xr = (const f32x4*)xrow + lane;
    f32x4 v[4]; float s = 0.f;
#pragma unroll
    for (int j = 0; j < 4; ++j) { v[j] = xr[64 * j]; s += (v[j].x * v[j].x + v[j].y * v[j].y) + (v[j].z * v[j].z + v[j].w * v[j].w); }
    const float r = rsqrtf(wave_sum(s) * (1.f / DM) + EPS);
    if (lane == 0) *rstd = r;
    v2u* o8 = (v2u*)orow + lane;
#pragma unroll
    for (int j = 0; j < 4; ++j) { v2u w; w.x = cvtpk(v[j].x, v[j].y); w.y = cvtpk(v[j].z, v[j].w); o8[64 * j] = w; }
}
template <bool XIN_F32, bool FINAL, int NR>
__device__ __forceinline__ void resid_rows(const void* xbase, const bf16* mbase, const float* wpost, void* obase, float* rstd, size_t m0, size_t rstride, int lane) {
    const f32x4* wr = (const f32x4*)wpost + lane;
    f32x4 xv[NR][4], mv[NR][4]; float ss[NR];
#pragma unroll
    for (int k = 0; k < NR; ++k) { const size_t m = m0 + k * rstride;
#pragma unroll
        for (int j = 0; j < 4; ++j) {
            if (XIN_F32) xv[k][j] = ((const f32x4*)((const float*)xbase + m * DM) + lane)[64 * j];
            else { const v2u w = ((const v2u*)((const bf16*)xbase + m * DM) + lane)[64 * j]; xv[k][j] = (f32x4){bflo(w.x), bfhi(w.x), bflo(w.y), bfhi(w.y)}; }
            const v2u w = ((const v2u*)(mbase + m * DM) + lane)[64 * j]; mv[k][j] = (f32x4){bflo(w.x), bfhi(w.x), bflo(w.y), bfhi(w.y)}; } }
#pragma unroll
    for (int k = 0; k < NR; ++k) { ss[k] = 0.f;
#pragma unroll
        for (int j = 0; j < 4; ++j) ss[k] += (mv[k][j].x * mv[k][j].x + mv[k][j].y * mv[k][j].y) + (mv[k][j].z * mv[k][j].z + mv[k][j].w * mv[k][j].w); }
#pragma unroll
    for (int o = 1; o < 64; o <<= 1)
#pragma unroll
        for (int k = 0; k < NR; ++k) ss[k] += __shfl_xor(ss[k], o);
    float s2[NR];
#pragma unroll
    for (int k = 0; k < NR; ++k) { const float r = rsqrtf(ss[k] * (1.f / DM) + EPS); s2[k] = 0.f;
#pragma unroll
        for (int j = 0; j < 4; ++j) { const f32x4 w = wr[64 * j]; xv[k][j] = xv[k][j] + mv[k][j] * r * w;
            s2[k] += (xv[k][j].x * xv[k][j].x + xv[k][j].y * xv[k][j].y) + (xv[k][j].z * xv[k][j].z + xv[k][j].w * xv[k][j].w); } }
    if (FINAL) {
#pragma unroll
        for (int k = 0; k < NR; ++k) { f32x4* o = (f32x4*)((float*)obase + (m0 + k * rstride) * DM) + lane;
#pragma unroll
            for (int j = 0; j < 4; ++j) o[64 * j] = xv[k][j]; }
    } else {
#pragma unroll
        for (int o = 1; o < 64; o <<= 1)
#pragma unroll
            for (int k = 0; k < NR; ++k) s2[k] += __shfl_xor(s2[k], o);
#pragma unroll
        for (int k = 0; k < NR; ++k) { const size_t m = m0 + k * rstride; if (lane == 0) rstd[m] = rsqrtf(s2[k] * (1.f / DM) + EPS);
            v2u* o = (v2u*)((bf16*)obase + m * DM) + lane;
#pragma unroll
            for (int j = 0; j < 4; ++j) { v2u w; w.x = cvtpk(xv[k][j].x, xv[k][j].y); w.y = cvtpk(xv[k][j].z, xv[k][j].w); o[64 * j] = w; } } }
}

#define MFMA16(a, b, c) __builtin_amdgcn_mfma_f32_16x16x32_bf16((a), (b), (c), 0, 0, 0)
__device__ __forceinline__ bf16x8 pack8(const f32x4& a, const f32x4& b) {
    v4u w; w.x = cvtpk(a[0], a[1]); w.y = cvtpk(a[2], a[3]); w.z = cvtpk(b[0], b[1]); w.w = cvtpk(b[2], b[3]); return __builtin_bit_cast(bf16x8, w);
}
constexpr float NSA_SC = 0.125f * 1.4426950408889634f;
__device__ __forceinline__ void nsa_load(const bf16* __restrict__ kbase, const bf16* __restrict__ vtbase, int vt_ld, int key0, bf16x8 (&ka)[2][2], bf16x8 (&va)[4], int c, int gq) {
#pragma unroll
    for (int sub = 0; sub < 2; ++sub)
#pragma unroll
        for (int s = 0; s < 2; ++s) ka[sub][s] = *(const bf16x8*)(kbase + (size_t)(key0 + 16 * sub + c) * 64 + 32 * s + 8 * gq);
#pragma unroll
    for (int dt = 0; dt < 4; ++dt) va[dt] = *(const bf16x8*)(vtbase + (size_t)(16 * dt + c) * vt_ld + key0 + 8 * gq);
}
__device__ __forceinline__ float max3f(float a, float b, float c) { float r; asm("v_max3_f32 %0, %1, %2, %3" : "=v"(r) : "v"(a), "v"(b), "v"(c)); return r; }
template <int MODE>
__device__ __forceinline__ void nsa_step(const bf16x8 (&ka)[2][2], const bf16x8 (&va)[4], int key0, int tq, bool selbit, bool masked  ,
                                         const LAS bf16x8* ql, float (&mrun)[3], float (&lrun)[3], f32x4 (&O)[3][4], int gq) {
    const int kA = key0 + 4 * gq;
#pragma unroll
    for (int h = 0; h < 3; ++h) {
        const bf16x8 q0 = ql[64 * (2 * h)], q1 = ql[64 * (2 * h + 1)];
        const bool fresh = mrun[h] < -1e19f; const float base = fresh ? 0.f : mrun[h];
        f32x4 sA = {-base, -base, -base, -base}, sB = sA;
        sA = MFMA16(ka[0][0], q0, sA); sA = MFMA16(ka[0][1], q1, sA);
        sB = MFMA16(ka[1][0], q0, sB); sB = MFMA16(ka[1][1], q1, sB);
        float v[8];
#pragma unroll
        for (int r = 0; r < 4; ++r) { v[r] = sA[r]; v[4 + r] = sB[r]; }
        if (masked) {
#pragma unroll
            for (int r = 0; r < 4; ++r) { const int k1 = kA + r, k2 = kA + 16 + r;
                const bool ok1 = (MODE == 0) ? (k1 <= tq && k1 > tq - 512) : (selbit && k1 <= tq);
                const bool ok2 = (MODE == 0) ? (k2 <= tq && k2 > tq - 512) : (selbit && k2 <= tq);
                v[r] = ok1 ? v[r] : -1e30f; v[4 + r] = ok2 ? v[4 + r] : -1e30f; } }
        const float lm = max3f(max3f(v[0], v[1], v[2]), max3f(v[3], v[4], v[5]), fmaxf(v[6], v[7]));
        if (__any(fresh ? (lm > -1e29f) : (lm > 8.0f))) {
            float mx = fmaxf(lm, __shfl_xor(lm, 16)); mx = fmaxf(mx, __shfl_xor(mx, 32));
            const float d = fresh ? (mx > -1e29f ? mx : 0.f) : fmaxf(mx, 0.f);
            if (!(fresh && !(mx > -1e29f))) mrun[h] = base + d;
            const float alpha = __builtin_amdgcn_exp2f(-d) ; lrun[h] *= fresh ? 1.f : alpha;
#pragma unroll
            for (int dt = 0; dt < 4; ++dt) O[h][dt] = O[h][dt] * (fresh ? 1.f : alpha);
#pragma unroll
            for (int i = 0; i < 8; ++i) v[i] -= d; }
        float p[8]; float ps = 0.f;
#pragma unroll
        for (int i = 0; i < 8; ++i) { p[i] = __builtin_amdgcn_exp2f(v[i]); ps += p[i]; }
        lrun[h] += ps;
        const bf16x8 pf = pack8((f32x4){p[0], p[1], p[2], p[3]}, (f32x4){p[4], p[5], p[6], p[7]});
#pragma unroll
        for (int dt = 0; dt < 4; ++dt) O[h][dt] = MFMA16(va[dt], pf, O[h][dt]);
    }
}
#define LDS_BAR() do { asm volatile("s_waitcnt lgkmcnt(0)" ::: "memory"); __builtin_amdgcn_s_barrier(); asm volatile("" ::: "memory"); } while (0)
constexpr int NSA_WSTRIDE = 12288, NSA_VCT = 98304, NSA_KC = 133120;
static_assert(8 * NSA_WSTRIDE <= NSA_VCT && NSA_VCT + 64 * 272 <= 131072 && NSA_KC >= LDSCTL_OFF + 2048 && NSA_KC + 128 * 144 <= LDS_BYTES, "NSA LDS map");
constexpr int NSA_SLOT0 = NSA_VCT, NSA_SLOT1 = NSA_KC, NSA_HMX = LDSCTL_OFF + 1024;
static_assert(NSA_SLOT0 + 18432 <= 131072 && NSA_SLOT1 + 18432 <= LDS_BYTES, "NSA tile ring");
template <int MODE>
__device__ __forceinline__ void nsa_coop_loop(LAS unsigned char* lds, const bf16* __restrict__ kbase, const bf16* __restrict__ vtbase, int klo, int ntile, unsigned um_blk, unsigned long long hm_wave,
                                              int t0, int tq, unsigned selmask, const LAS bf16x8* ql, float (&mrun)[3], float (&lrun)[3], f32x4 (&O)[3][4], int tid, int c, int gq) {
    const bf16* tbk = kbase + (tid >> 3) * 64 + (tid & 7) * 8; const bf16* tbv = vtbase + (size_t)(tid >> 3) * SEQ + (tid & 7) * 8;
    const int ldst = (tid >> 3) * 144 + (tid & 7) * 16;
    int keyP = klo; unsigned umP = um_blk, umC = um_blk;
#define NSA_NEXTP(dk, dv) do { int k_; if (MODE == 0) { k_ = keyP; keyP += 64; } else { k_ = 64 * __builtin_ctz(umP); umP &= umP - 1u; } dk = *(const v4u*)(tbk + (size_t)k_ * 64); dv = *(const v4u*)(tbv + k_); } while (0)
#define NSA_COMMIT(sk, sv, slot) do { *(LAS v4u*)(lds + (slot) + ldst) = (sk); *(LAS v4u*)(lds + (slot) + 9216 + ldst) = (sv); } while (0)
#define NSA_COMPUTE(slot, sidx) do { int keyt_; if (MODE == 0) keyt_ = klo + 64 * (sidx); else { keyt_ = 64 * __builtin_ctz(umC); umC &= umC - 1u; } \
        _Pragma("unroll") for (int hf_ = 0; hf_ < 2; ++hf_) { const int key0_ = keyt_ + 32 * hf_; \
        const bool rel_ = (MODE == 0) ? (key0_ <= t0 + 15 && key0_ + 31 >= t0 - 511) : (bool)((hm_wave >> (key0_ >> 5)) & 1ull); \
        if (rel_) { bf16x8 ka_[2][2], va_[4]; \
            _Pragma("unroll") for (int sub_ = 0; sub_ < 2; ++sub_) _Pragma("unroll") for (int s_ = 0; s_ < 2; ++s_) ka_[sub_][s_] = *(const LAS bf16x8*)(lds + (slot) + (32 * hf_ + 16 * sub_ + c) * 144 + 64 * s_ + 16 * gq); \
            _Pragma("unroll") for (int dt_ = 0; dt_ < 4; ++dt_) va_[dt_] = *(const LAS bf16x8*)(lds + (slot) + 9216 + (16 * dt_ + c) * 144 + 64 * hf_ + 16 * gq); \
            if (MODE == 0) nsa_step<0>(ka_, va_, key0_, tq, true, !(key0_ + 31 <= t0 && key0_ > t0 + 15 - 512), ql, mrun, lrun, O, gq); \
            else { const bool sb_ = (selmask >> (key0_ >> 6)) & 1u; nsa_step<1>(ka_, va_, key0_, tq, sb_, !(key0_ + 31 <= t0 && __all(sb_)), ql, mrun, lrun, O, gq); } } } } while (0)
    v4u K0 = {0u, 0u, 0u, 0u}, V0 = K0, K1 = K0, V1 = K0;
    if (ntile > 0) NSA_NEXTP(K0, V0);
    LDS_BAR();
    if (ntile > 0) NSA_COMMIT(K0, V0, NSA_SLOT0);
    if (ntile > 1) NSA_NEXTP(K0, V0);
    if (ntile > 2) NSA_NEXTP(K1, V1);
    LDS_BAR();
    for (int s = 0; s < ntile; s += 2) {
        if (s + 1 < ntile) NSA_COMMIT(K0, V0, NSA_SLOT1);
        if (s + 3 < ntile) NSA_NEXTP(K0, V0);
        NSA_COMPUTE(NSA_SLOT0, s);
        LDS_BAR();
        if (s + 1 >= ntile) break;
        if (s + 2 < ntile) NSA_COMMIT(K1, V1, NSA_SLOT0);
        if (s + 4 < ntile) NSA_NEXTP(K1, V1);
        NSA_COMPUTE(NSA_SLOT1, s + 1);
        LDS_BAR();
    }
#undef NSA_NEXTP
#undef NSA_COMMIT
#undef NSA_COMPUTE
}
struct NsaPtrs { const bf16* proj; const bf16* kc; const bf16* vct; const bf16* ks; const bf16* vst; const bf16* kw; const bf16* vwt; bf16* mix; };
__device__ __forceinline__ void nsa_stage_cmp(LAS unsigned char* lds, const NsaPtrs& P, int b, int g, int tid) {
    const bf16* kc = P.kc + (size_t)(b * 2 + g) * 128 * 64; const bf16* vct = P.vct + (size_t)(b * 2 + g) * 64 * 128;
#pragma unroll
    for (int q = 0; q < 2; ++q) { const int e = tid + NTHR * q;
        *(LAS v4u*)(lds + NSA_KC + (e >> 3) * 144 + (e & 7) * 16) = *(const v4u*)(kc + (e >> 3) * 64 + (e & 7) * 8);
        *(LAS v4u*)(lds + NSA_VCT + (e >> 4) * 272 + (e & 15) * 16) = *(const v4u*)(vct + (e >> 4) * 128 + (e & 15) * 8); }
}
__device__ __forceinline__ void nsa_item(const NsaPtrs& P, LAS unsigned char* lds, int wave, int b, int g, int t0, int tid, int lane) {
    asm volatile("" : "+v"(lane));
    const int c = lane & 15, gq = lane >> 4;
    const int tq = t0 + c, cur = t0 >> 6;
    const bf16* prow = P.proj + ((size_t)b * SEQ + tq) * NINP;
    LAS v2u* outl = (LAS v2u*)(lds + wave * NSA_WSTRIDE) + lane;
    LAS bf16x8* ql = (LAS bf16x8*)(lds + wave * NSA_WSTRIDE + 6144) + lane;
    unsigned graw[9];
    {
        v4u qr[6];
#pragma unroll
        for (int f = 0; f < 6; ++f) qr[f] = *(const v4u*)(prow + PC_NQ + (g * 3 + (f >> 1)) * 64 + 32 * (f & 1) + 8 * gq);
#pragma unroll
        for (int k = 0; k < 9; ++k) graw[k] = prow[PC_GATE + (k / 3) * 6 + g * 3 + (k % 3)];
#pragma unroll
        for (int f = 0; f < 6; ++f) { v4u qs; qs.x = cvtpk(bflo(qr[f].x) * NSA_SC, bfhi(qr[f].x) * NSA_SC); qs.y = cvtpk(bflo(qr[f].y) * NSA_SC, bfhi(qr[f].y) * NSA_SC);
            qs.z = cvtpk(bflo(qr[f].z) * NSA_SC, bfhi(qr[f].z) * NSA_SC); qs.w = cvtpk(bflo(qr[f].w) * NSA_SC, bfhi(qr[f].w) * NSA_SC);
            ql[64 * f] = __builtin_bit_cast(bf16x8, qs); }
    }
#define NSA_GATE(br, h) sigmoid_f(bf2f((bf16)graw[(br) * 3 + (h)]))
    asm volatile("" ::: "memory");
    float imp[8]; unsigned selmask = 0u;
    REP(31) {
#pragma unroll
    for (int st = 0; st < 8; ++st) imp[st] = 0.f;
    selmask = 0u;
    const int nvis = tq >= 31 ? ((tq - 31) >> 4) + 1 : 0;
#pragma unroll 1
    for (int h = 0; h < 3; ++h) {
        asm volatile("" ::: "memory");
        const bf16x8 qh0 = ql[64 * (2 * h)], qh1 = ql[64 * (2 * h + 1)];
        f32x4 s[8];
#pragma unroll
        for (int st = 0; st < 8; ++st) { const LAS unsigned char* kr = lds + NSA_KC + (16 * st + c) * 144 + 16 * gq;
            const bf16x8 a0 = *(const LAS bf16x8*)kr, a1 = *(const LAS bf16x8*)(kr + 64);
            f32x4 z = {0.f, 0.f, 0.f, 0.f}; z = MFMA16(a0, qh0, z); z = MFMA16(a1, qh1, z); s[st] = z; }
        float mx = -1e30f;
#pragma unroll
        for (int st = 0; st < 8; ++st)
#pragma unroll
            for (int r = 0; r < 4; ++r) { const int i = 16 * st + 4 * gq + r; const float v = (i < nvis) ? s[st][r] : -1e30f; s[st][r] = v; mx = fmaxf(mx, v); }
        mx = fmaxf(mx, __shfl_xor(mx, 16)); mx = fmaxf(mx, __shfl_xor(mx, 32)); mx = fmaxf(mx, -1e20f);
        float sum = 0.f;
#pragma unroll
        for (int st = 0; st < 8; ++st)
#pragma unroll
            for (int r = 0; r < 4; ++r) { const float p = __builtin_amdgcn_exp2f(s[st][r] - mx); s[st][r] = p; sum += p; }
        sum += __shfl_xor(sum, 16); sum += __shfl_xor(sum, 32);
        const float inv = sum > 0.f ? __builtin_amdgcn_rcpf(sum) : 0.f;
#pragma unroll
        for (int st = 0; st < 8; ++st) s[st] = s[st] * inv;
        float sh[8];
#pragma unroll
        for (int st = 0; st < 8; ++st) sh[st] = __shfl(s[st][3], (lane + 48) & 63);
#pragma unroll
        for (int st = 0; st < 8; ++st) { const float prev = gq > 0 ? sh[st] : (st > 0 ? sh[st > 0 ? st - 1 : 0] : 0.f);
            imp[st] += (s[st][0] + s[st][1]) + (s[st][2] + s[st][3]) + prev; }
        f32x4 Oc[4];
#pragma unroll
        for (int dt = 0; dt < 4; ++dt) Oc[dt] = (f32x4){0.f, 0.f, 0.f, 0.f};
#pragma unroll
        for (int ks = 0; ks < 4; ++ks) { const bf16x8 pf = pack8(s[2 * ks], s[2 * ks + 1]);
#pragma unroll
            for (int dt = 0; dt < 4; ++dt) { const bf16x8 vf = *(const LAS bf16x8*)(lds + NSA_VCT + (16 * dt + c) * 272 + 64 * ks + 16 * gq); Oc[dt] = MFMA16(vf, pf, Oc[dt]); } }
        { const float gt = sigmoid_f(bf2f((bf16)(h == 0 ? graw[0] : (h == 1 ? graw[1] : graw[2]))));
#pragma unroll
            for (int dt = 0; dt < 4; ++dt) { const f32x4 o = Oc[dt] * gt; v2u w; w.x = cvtpk(o[0], o[1]); w.y = cvtpk(o[2], o[3]); outl[64 * (4 * h + dt)] = w; } }
    }
    {
        unsigned key[8];
#pragma unroll
        for (int st = 0; st < 8; ++st) { const int j = 4 * st + gq; const bool elig = j <= cur, forced = (j == 0) || (j == cur) || (j == cur - 1);
            const float sc = elig ? (imp[st] + (forced ? 1e4f : 0.f)) : -1e4f; const unsigned u = __float_as_uint(sc);
            key[st] = (((u & 0x80000000u) ? ~u : (u | 0x80000000u)) & ~31u) | (unsigned)(31 - j); }
#pragma unroll
        for (int it = 0; it < 8; ++it) {
            unsigned bk = key[0];
#pragma unroll
            for (int st = 1; st < 8; ++st) bk = bk > key[st] ? bk : key[st];
            { const unsigned o = (unsigned)__shfl_xor((int)bk, 16); bk = bk > o ? bk : o; }
            { const unsigned o = (unsigned)__shfl_xor((int)bk, 32); bk = bk > o ? bk : o; }
            const int bj = 31 - (int)(bk & 31u);
            selmask |= 1u << bj;
#pragma unroll
            for (int st = 0; st < 8; ++st) if (4 * st + gq == bj) key[st] = 0u;
        }
    }
    }
    float mrun[3], lrun[3]; f32x4 O[3][4];
    {
        const bf16* kw = P.kw + (size_t)(b * 2 + g) * SEQ * 64; const bf16* vwt = P.vwt + (size_t)(b * 2 + g) * 64 * SEQ;
        REP(32) {
#pragma unroll
        for (int h = 0; h < 3; ++h) { mrun[h] = -1e20f; lrun[h] = 0.f;
#pragma unroll
            for (int dt = 0; dt < 4; ++dt) O[h][dt] = (f32x4){0.f, 0.f, 0.f, 0.f}; }
        asm volatile("" ::: "memory");
        { const int T0 = t0 - 16 * wave; int klo = T0 - 511; klo = klo < 0 ? 0 : klo; klo &= ~63; const int klast = (T0 + 127) & ~63;
            nsa_coop_loop<0>(lds, kw, vwt, klo, (klast - klo) / 64 + 1, 0u, 0ull, t0, tq, selmask, ql, mrun, lrun, O, tid, c, gq); }
        }
#pragma unroll
        for (int h = 0; h < 3; ++h) { float lt = lrun[h]; lt += __shfl_xor(lt, 16); lt += __shfl_xor(lt, 32); const float inv = lt > 0.f ? NSA_GATE(2, h) * __builtin_amdgcn_rcpf(lt) : 0.f;
#pragma unroll
            for (int dt = 0; dt < 4; ++dt) { const v2u w0 = outl[64 * (4 * h + dt)]; const f32x4 o = (f32x4){bflo(w0.x), bfhi(w0.x), bflo(w0.y), bfhi(w0.y)} + O[h][dt] * inv;
                v2u w; w.x = cvtpk(o[0], o[1]); w.y = cvtpk(o[2], o[3]); outl[64 * (4 * h + dt)] = w; } }
        asm volatile("" ::: "memory");
    }
    {
        const bf16* ks = P.ks + (size_t)(b * 2 + g) * SEQ * 64; const bf16* vst = P.vst + (size_t)(b * 2 + g) * 64 * SEQ;
        REP(33) {
#pragma unroll
        for (int h = 0; h < 3; ++h) { mrun[h] = -1e20f; lrun[h] = 0.f;
#pragma unroll
            for (int dt = 0; dt < 4; ++dt) O[h][dt] = (f32x4){0.f, 0.f, 0.f, 0.f}; }
        {
            unsigned um = selmask;
#pragma unroll
            for (int off = 1; off < 64; off <<= 1) um |= (unsigned)__shfl_xor((int)um, off);
            um = (unsigned)__builtin_amdgcn_readfirstlane((int)um) & ((2u << cur) - 1u);
            unsigned long long x = um;
            x = (x | (x << 16)) & 0x0000FFFF0000FFFFull; x = (x | (x << 8)) & 0x00FF00FF00FF00FFull; x = (x | (x << 4)) & 0x0F0F0F0F0F0F0F0Full;
            x = (x | (x << 2)) & 0x3333333333333333ull; x = (x | (x << 1)) & 0x5555555555555555ull;
            unsigned long long hm = x | (x << 1);
            if (64 * cur + 32 > t0 + 15) hm &= ~(1ull << (2 * cur + 1));
            LAS unsigned* hmx = (LAS unsigned*)(lds + NSA_HMX);
            if (lane == 0) hmx[wave] = um;
            LDS_BAR();
            unsigned ub = 0u;
#pragma unroll
            for (int w8 = 0; w8 < 8; ++w8) ub |= hmx[w8];
            ub = (unsigned)__builtin_amdgcn_readfirstlane((int)ub);
            nsa_coop_loop<1>(lds, ks, vst, 0, __builtin_popcount(ub), ub, hm, t0, tq, selmask, ql, mrun, lrun, O, tid, c, gq);
        }
        }
        asm volatile("" ::: "memory");
#pragma unroll
        for (int h = 0; h < 3; ++h) { float lt = lrun[h]; lt += __shfl_xor(lt, 16); lt += __shfl_xor(lt, 32); const float inv = lt > 0.f ? NSA_GATE(1, h) * __builtin_amdgcn_rcpf(lt) : 0.f;
            bf16* orow = P.mix + ((size_t)b * SEQ + tq) * DM + 640 + g * 192 + h * 64;
#pragma unroll
            for (int dt = 0; dt < 4; ++dt) { const v2u w0 = outl[64 * (4 * h + dt)]; const f32x4 o = (f32x4){bflo(w0.x), bfhi(w0.x), bflo(w0.y), bfhi(w0.y)} + O[h][dt] * inv;
                v2u w; w.x = cvtpk(o[0], o[1]); w.y = cvtpk(o[2], o[3]); *(v2u*)(orow + 16 * dt + 4 * gq) = w; } }
    }
#undef NSA_GATE
}

typedef short bf16x4 __attribute__((ext_vector_type(4)));
#define MFMA16K(a, b, c) __builtin_amdgcn_mfma_f32_16x16x16bf16_1k((a), (b), (c), 0, 0, 0)
__device__ __forceinline__ bf16x4 pack4(const f32x4& a) { v2u w; w.x = cvtpk(a[0], a[1]); w.y = cvtpk(a[2], a[3]); return __builtin_bit_cast(bf16x4, w); }
constexpr int DNF_UNIT = 40960;
constexpr int DL_RAWB = 26880, DL_RAW = 0, DL_QS = 2 * DL_RAWB, DL_KS = DL_QS + 9216, DL_KT = DL_KS + 9216, DL_WL = DL_KT + 9216, DL_AII = DL_WL + 9216, DL_TINV = DL_AII + 4096, DL_VEC = DL_TINV + 4096, DL_END = DL_VEC + 2048;
static_assert(DL_END <= 131072, "DeltaNet chunk LDS map");
struct DnPre { v4u raw[4]; unsigned gb, ga; };
struct DnUnitId { int b, h, n, valid; };
__device__ __forceinline__ DnUnitId dn_unit_id(int u) { DnUnitId r; r.valid = u < BATCH * 6 * 32; const int uu = r.valid ? u : 0; r.n = uu & 31; const int bh = uu >> 5; r.b = bh / 6; r.h = bh % 6; return r; }
__device__ __forceinline__ void dn_prefetch(DnPre& P, const bf16* __restrict__ PROJ, const DnUnitId id, int tid, int lane, int wave) {
#pragma unroll
    for (int q = 0; q < 4; ++q) { const int e = tid + NTHR * q, rr = e / 24, pc = e % 24, part = pc >> 3, d0 = (pc & 7) * 8, t = 64 * id.n - 3 + rr;
        v4u val = {0u, 0u, 0u, 0u};
        if (id.valid && e < 67 * 24 && t >= 0) val = *(const v4u*)(PROJ + ((size_t)id.b * SEQ + t) * NINP + part * 384 + id.h * 64 + d0);
        P.raw[q] = val; }
    P.gb = 0u; P.ga = 0u;
    if (wave == 1 && id.valid) { const bf16* pr = PROJ + ((size_t)id.b * SEQ + 64 * id.n + lane) * NINP; P.gb = pr[PC_B + id.h]; P.ga = pr[PC_A + id.h]; }
}
__device__ __forceinline__ void dn_commit_raw(const DnPre& P, LAS unsigned char* L, int par, int tid) {
#pragma unroll
    for (int q = 0; q < 4; ++q) { const int e = tid + NTHR * q, rr = e / 24, pc = e % 24, part = pc >> 3, d0 = (pc & 7) * 8;
        if (e < 67 * 24) *(LAS v4u*)(L + DL_RAW + par * DL_RAWB + rr * 400 + (part * 64 + d0) * 2) = P.raw[q]; }
}
__device__ __forceinline__ void dn_commit_gates(const DnPre& P, LAS unsigned char* L, int par, float Aexp, float dtb, float* __restrict__ gt_out, bool valid, int lane, int wave) {
    if (wave == 1) { LAS float* vbeta = (LAS float*)(L + DL_VEC + par * 1024);
        const float beta = sigmoid_f(bf2f((bf16)P.gb)); const float z = bf2f((bf16)P.ga) + dtb; const float sp = z > 20.f ? z : log1pf(__expf(z)); float gv = -Aexp * sp;
#pragma unroll
        for (int off = 1; off < 64; off <<= 1) { const float t = __shfl_up(gv, off); if (lane >= off) gv += t; }
        const float glast = __shfl(gv, 63);
        vbeta[lane] = beta; vbeta[64 + lane] = gv; vbeta[128 + lane] = __expf(gv); vbeta[192 + lane] = __expf(glast - gv);
        if (lane == 63 && valid) *gt_out = __expf(gv); }
}
template <int PAR>
__device__ __forceinline__ void dn_chunk_unit(LAS unsigned char* L, const bf16* __restrict__ PROJ, const float* __restrict__ cw, const float* __restrict__ alog, const float* __restrict__ dtbp,
                                              unsigned char* __restrict__ dnf_all, float* __restrict__ gt_all, int u, int u_next, int tid, int lane, int wave) {
    LAS bf16* RAWs = (LAS bf16*)(L + DL_RAW + PAR * DL_RAWB); LAS bf16* QS = (LAS bf16*)(L + DL_QS); LAS bf16* KS = (LAS bf16*)(L + DL_KS); LAS bf16* KT = (LAS bf16*)(L + DL_KT); LAS bf16* WL = (LAS bf16*)(L + DL_WL);
    LAS float* AII = (LAS float*)(L + DL_AII); LAS float* TINV = (LAS float*)(L + DL_TINV);
    LAS float* vbeta = (LAS float*)(L + DL_VEC + PAR * 1024); LAS float* vgam = vbeta + 64; LAS float* vegam = vgam + 64; LAS float* vedec = vegam + 64;
    asm volatile("" : "+v"(tid), "+v"(lane), "+s"(wave));
    const int col = lane & 15, g = lane >> 4;
    const DnUnitId id = dn_unit_id(u), idn = dn_unit_id(u_next);
    const int h = id.h;
    unsigned char* dnf = dnf_all + (size_t)u * DNF_UNIT;
    LDS_BAR();
    DnPre P; dn_prefetch(P, PROJ, idn, tid, lane, wave);
    f32x4 R[4]; bf16x8 AF1, AF2, AF3a, AF3b; const f32x4 z4 = {0.f, 0.f, 0.f, 0.f};
    REP(24) {
    {
        const int part = wave >> 2, cr = 16 * (wave & 3) + (lane >> 2), d0 = 16 * (lane & 3);
        float y[16];
#pragma unroll
        for (int e = 0; e < 16; ++e) y[e] = 0.f;
#pragma unroll
        for (int j = 0; j < 4; ++j) { const LAS bf16* xr = RAWs + (cr + j) * 200 + part * 64 + d0; const v4u xa = *(const LAS v4u*)xr, xb2 = *(const LAS v4u*)(xr + 8);
            const float* wj = cw + j * 1152 + part * 384 + h * 64 + d0;
            const f32x4 w0 = *(const f32x4*)wj, w1 = *(const f32x4*)(wj + 4), w2 = *(const f32x4*)(wj + 8), w3 = *(const f32x4*)(wj + 12);
            y[0] += w0[0] * bflo(xa.x); y[1] += w0[1] * bfhi(xa.x); y[2] += w0[2] * bflo(xa.y); y[3] += w0[3] * bfhi(xa.y);
            y[4] += w1[0] * bflo(xa.z); y[5] += w1[1] * bfhi(xa.z); y[6] += w1[2] * bflo(xa.w); y[7] += w1[3] * bfhi(xa.w);
            y[8] += w2[0] * bflo(xb2.x); y[9] += w2[1] * bfhi(xb2.x); y[10] += w2[2] * bflo(xb2.y); y[11] += w2[3] * bfhi(xb2.y);
            y[12] += w3[0] * bflo(xb2.z); y[13] += w3[1] * bfhi(xb2.z); y[14] += w3[2] * bflo(xb2.w); y[15] += w3[3] * bfhi(xb2.w); }
        float ss = 0.f;
#pragma unroll
        for (int e = 0; e < 16; ++e) { y[e] = silu_f(y[e]); ss += y[e] * y[e]; }
        ss += __shfl_xor(ss, 1); ss += __shfl_xor(ss, 2);
        const float sc = rsqrtf(ss + EPS) * (part == 0 ? 0.125f : 1.0f);
        v4u o0, o1;
        o0.x = cvtpk(y[0] * sc, y[1] * sc); o0.y = cvtpk(y[2] * sc, y[3] * sc); o0.z = cvtpk(y[4] * sc, y[5] * sc); o0.w = cvtpk(y[6] * sc, y[7] * sc);
        o1.x = cvtpk(y[8] * sc, y[9] * sc); o1.y = cvtpk(y[10] * sc, y[11] * sc); o1.z = cvtpk(y[12] * sc, y[13] * sc); o1.w = cvtpk(y[14] * sc, y[15] * sc);
        LAS bf16* dst = (part == 0 ? QS : KS) + cr * 72 + d0;
        *(LAS v4u*)dst = o0; *(LAS v4u*)(dst + 8) = o1;
        if (part == 1) {
            const unsigned ow[8] = {o0.x, o0.y, o0.z, o0.w, o1.x, o1.y, o1.z, o1.w};
#pragma unroll
            for (int e2 = 0; e2 < 8; ++e2) { KT[(d0 + 2 * e2) * 72 + cr] = (bf16)(ow[e2] & 0xffffu); KT[(d0 + 2 * e2 + 1) * 72 + cr] = (bf16)(ow[e2] >> 16); } }
    }
    if (wave < 4) { const int d = 16 * wave + col; float cwv[4];
#pragma unroll
        for (int j = 0; j < 4; ++j) cwv[j] = cw[j * 1152 + 768 + h * 64 + d];
#pragma unroll
        for (int i = 0; i < 4; ++i) { float x7[7];
#pragma unroll
            for (int m = 0; m < 7; ++m) x7[m] = bf2f(RAWs[(16 * i + 4 * g + m) * 200 + 128 + d]);
#pragma unroll
            for (int r = 0; r < 4; ++r) { const float yv = (cwv[0] * x7[r] + cwv[1] * x7[r + 1]) + (cwv[2] * x7[r + 2] + cwv[3] * x7[r + 3]); R[i][r] = silu_f(yv) * vbeta[16 * i + 4 * g + r]; } } }
    LDS_BAR();
    if (wave >= 4) { const int kd = 16 * (wave - 4) + col;
#pragma unroll
        for (int i = 0; i < 4; ++i)
#pragma unroll
            for (int r = 0; r < 4; ++r) { const int c = 16 * i + 4 * g + r; R[i][r] = bf2f(KS[c * 72 + kd]) * vbeta[c] * vegam[c]; } }
    bf16x8 KF[4][2];
#pragma unroll
    for (int ct = 0; ct < 4; ++ct)
#pragma unroll
        for (int s = 0; s < 2; ++s) KF[ct][s] = *(const LAS bf16x8*)(KS + (16 * ct + col) * 72 + 32 * s + 8 * g);
#define DN_TILE(dst, ctp, ct) do { f32x4 t_ = z4; t_ = MFMA16(KF[ctp][0], KF[ct][0], t_); t_ = MFMA16(KF[ctp][1], KF[ct][1], t_); \
        const float bc_ = -vbeta[16 * (ct) + col], gc_ = vgam[16 * (ct) + col]; const f32x4 gp_ = *(const LAS f32x4*)(vgam + 16 * (ctp) + 4 * g); \
        _Pragma("unroll") for (int r_ = 0; r_ < 4; ++r_) t_[r_] = t_[r_] * bc_ * __expf(gc_ - gp_[r_]); dst = t_; } while (0)
    { f32x4 t01, t02, t12, t03, t13, t23; DN_TILE(t01, 0, 1); DN_TILE(t02, 0, 2); DN_TILE(t12, 1, 2); DN_TILE(t03, 0, 3); DN_TILE(t13, 1, 3); DN_TILE(t23, 2, 3);
        AF1 = pack8(t01, z4); AF2 = pack8(t02, t12); AF3a = pack8(t03, t13); AF3b = pack8(t23, z4); }
#undef DN_TILE
    if (wave < 4) {
        const bf16x8 kd0 = *(const LAS bf16x8*)(KS + (16 * wave + col) * 72 + 8 * g), kd1 = *(const LAS bf16x8*)(KS + (16 * wave + col) * 72 + 32 + 8 * g);
        f32x4 t = z4; t = MFMA16(kd0, kd0, t); t = MFMA16(kd1, kd1, t);
        const int cc = 16 * wave + col; const float bc = vbeta[cc], gc = vgam[cc]; const f32x4 gp = *(const LAS f32x4*)(vgam + 16 * wave + 4 * g);
#pragma unroll
        for (int r = 0; r < 4; ++r) t[r] = (col > 4 * g + r) ? t[r] * bc * __expf(gc - gp[r]) : 0.f;
        *(LAS f32x4*)(AII + wave * 256 + col * 16 + 4 * g) = t; }
    LDS_BAR();
    }
    REP(25) {
    if (wave == 1) dn_commit_gates(P, L, 1 - PAR, __expf(alog[idn.h]), dtbp[idn.h], gt_all + (idn.valid ? u_next : 0), idn.valid != 0, lane, wave);
    if (wave == 0) { const int i = g, cl = col; float t[16];
#pragma unroll
        for (int r = 0; r < 16; ++r) { float acc = (r == cl) ? 1.f : 0.f; f32x4 rowv[4];
#pragma unroll
            for (int q = 0; q < 4; ++q) if (4 * q < r) rowv[q] = *(const LAS f32x4*)(AII + i * 256 + r * 16 + 4 * q);
#pragma unroll
            for (int m = 0; m < r; ++m) acc -= rowv[m >> 2][m & 3] * t[m];
            t[r] = acc; }
#pragma unroll
        for (int r = 0; r < 16; ++r) TINV[i * 256 + r * 16 + cl] = t[r]; }
    LDS_BAR();
    }
    f32x4 X[4];
    { bf16x4 TF[4];
#pragma unroll
        for (int i = 0; i < 4; ++i) { const f32x4 tv = *(const LAS f32x4*)(TINV + i * 256 + col * 16 + 4 * g); TF[i] = pack4(tv); }
        X[0] = MFMA16K(TF[0], pack4(R[0]), z4);
        { const f32x4 y = MFMA16(AF1, pack8(X[0], z4), R[1]); X[1] = MFMA16K(TF[1], pack4(y), z4); }
        { const f32x4 y = MFMA16(AF2, pack8(X[0], X[1]), R[2]); X[2] = MFMA16K(TF[2], pack4(y), z4); }
        { f32x4 y = MFMA16(AF3a, pack8(X[0], X[1]), R[3]); y = MFMA16(AF3b, pack8(X[2], z4), y); X[3] = MFMA16K(TF[3], pack4(y), z4); } }
    if (wave >= 4) { const int kd = 16 * (wave - 4) + col;
#pragma unroll
        for (int i = 0; i < 4; ++i)
#pragma unroll
            for (int r = 0; r < 4; ++r) WL[(16 * i + 4 * g + r) * 72 + kd] = f2bf(X[i][r]); }
    dn_commit_raw(P, L, 1 - PAR, tid);
    LDS_BAR();
    if (wave < 4) {
#pragma unroll
        for (int ct = 0; ct < 4; ++ct) { v2u w; w.x = cvtpk(X[ct][0], X[ct][1]); w.y = cvtpk(X[ct][2], X[ct][3]); *(v2u*)(dnf + 32768 + (wave * 4 + ct) * 512 + lane * 8) = w; } }
    { const int ct = wave >> 1, s = wave & 1;
        { const v2u a = *(const LAS v2u*)(WL + (16 * ct + col) * 72 + 32 * s + 4 * g), bq = *(const LAS v2u*)(WL + (16 * ct + col) * 72 + 32 * s + 16 + 4 * g);
            v4u o; o.x = a.x ^ 0x80008000u; o.y = a.y ^ 0x80008000u; o.z = bq.x ^ 0x80008000u; o.w = bq.y ^ 0x80008000u;
            *(v4u*)(dnf + wave * 1024 + lane * 16) = o; }
        { const v2u a = *(const LAS v2u*)(QS + (16 * ct + col) * 72 + 32 * s + 4 * g), bq = *(const LAS v2u*)(QS + (16 * ct + col) * 72 + 32 * s + 16 + 4 * g); const float e = vegam[16 * ct + col];
            v4u o; o.x = cvtpk(bflo(a.x) * e, bfhi(a.x) * e); o.y = cvtpk(bflo(a.y) * e, bfhi(a.y) * e); o.z = cvtpk(bflo(bq.x) * e, bfhi(bq.x) * e); o.w = cvtpk(bflo(bq.y) * e, bfhi(bq.y) * e);
            *(v4u*)(dnf + 8192 + wave * 1024 + lane * 16) = o; }
        { const v2u a = *(const LAS v2u*)(KT + (16 * ct + col) * 72 + 32 * s + 4 * g), bq = *(const LAS v2u*)(KT + (16 * ct + col) * 72 + 32 * s + 16 + 4 * g);
            const f32x4 e1 = *(const LAS f32x4*)(vedec + 32 * s + 4 * g), e2 = *(const LAS f32x4*)(vedec + 32 * s + 16 + 4 * g);
            v4u o; o.x = cvtpk(bflo(a.x) * e1[0], bfhi(a.x) * e1[1]); o.y = cvtpk(bflo(a.y) * e1[2], bfhi(a.y) * e1[3]); o.z = cvtpk(bflo(bq.x) * e2[0], bfhi(bq.x) * e2[1]); o.w = cvtpk(bflo(bq.y) * e2[2], bfhi(bq.y) * e2[3]);
            *(v4u*)(dnf + 24576 + wave * 1024 + lane * 16) = o; }
        { const bf16x8 q0 = *(const LAS bf16x8*)(QS + (16 * ct + col) * 72 + 8 * g), q1 = *(const LAS bf16x8*)(QS + (16 * ct + col) * 72 + 32 + 8 * g);
            const int cc = 16 * ct + col; const float gc = vgam[cc]; f32x4 th[2];
#pragma unroll
            for (int hh = 0; hh < 2; ++hh) { const int ctp = 2 * s + hh; f32x4 t = z4;
                if (ctp <= ct) { const bf16x8 k0 = *(const LAS bf16x8*)(KS + (16 * ctp + col) * 72 + 8 * g), k1 = *(const LAS bf16x8*)(KS + (16 * ctp + col) * 72 + 32 + 8 * g);
                    t = MFMA16(k0, q0, t); t = MFMA16(k1, q1, t); const f32x4 gp = *(const LAS f32x4*)(vgam + 16 * ctp + 4 * g);
#pragma unroll
                    for (int r = 0; r < 4; ++r) t[r] = (cc >= 16 * ctp + 4 * g + r) ? t[r] * __expf(gc - gp[r]) : 0.f; }
                th[hh] = t; }
            *(bf16x8*)(dnf + 16384 + wave * 1024 + lane * 16) = pack8(th[0], th[1]); }
    }
}
constexpr int DW_RAW = 0, DW_AII = 9728, DW_VEC = DW_AII + 4096, DW_END = DW_VEC + 1024;
static_assert(DW_END <= 16384, "per-wave LDS of the wave-autonomous DeltaNet chunk unit");
__device__ __forceinline__ void dnw_stage_issue(v4u (&rg)[9], const bf16* __restrict__ PROJ, int b, int h, int n, int part, int lane) {
#pragma unroll
    for (int it = 0; it < 9; ++it) { const int e = lane + 64 * it, rr = e >> 3, ch = e & 7, t = 64 * n - 3 + rr; v4u val = {0u, 0u, 0u, 0u};
        if (e < 67 * 8 && t >= 0) val = *(const v4u*)(PROJ + ((size_t)b * SEQ + t) * NINP + part * 384 + h * 64 + ch * 8);
        rg[it] = val; }
}
__device__ __forceinline__ void dnw_stage_commit(const v4u (&rg)[9], LAS unsigned char* W, int lane) {
#pragma unroll
    for (int it = 0; it < 9; ++it) { const int e = lane + 64 * it, rr = e >> 3, ch = e & 7; if (e < 67 * 8) *(LAS v4u*)(W + DW_RAW + rr * 144 + ch * 16) = rg[it]; }
}
__device__ __forceinline__ void dnw_conv_qk(const LAS unsigned char* W, const float* __restrict__ cwp, float qscale, bf16x8 (&F)[4][2], int c, int g) {
    v4u Fp[4][2]; float ss[4] = {0.f, 0.f, 0.f, 0.f};
#pragma unroll
    for (int s = 0; s < 2; ++s) {
        f32x4 wa[4], wb[4];
#pragma unroll
        for (int tap = 0; tap < 4; ++tap) { wa[tap] = *(const f32x4*)(cwp + tap * 1152 + 32 * s + 4 * g); wb[tap] = *(const f32x4*)(cwp + tap * 1152 + 32 * s + 16 + 4 * g); }
#pragma unroll
        for (int ct = 0; ct < 4; ++ct) { f32x4 ya = {0.f, 0.f, 0.f, 0.f}, yb = ya;
#pragma unroll
            for (int tap = 0; tap < 4; ++tap) { const LAS unsigned char* rp = W + DW_RAW + (16 * ct + c + tap) * 144 + 64 * s + 8 * g;
                const v2u xa = *(const LAS v2u*)rp, xb = *(const LAS v2u*)(rp + 32);
                ya = ya + wa[tap] * (f32x4){bflo(xa.x), bfhi(xa.x), bflo(xa.y), bfhi(xa.y)}; yb = yb + wb[tap] * (f32x4){bflo(xb.x), bfhi(xb.x), bflo(xb.y), bfhi(xb.y)}; }
#pragma unroll
            for (int e = 0; e < 4; ++e) { ya[e] = silu_f(ya[e]); yb[e] = silu_f(yb[e]); ss[ct] += ya[e] * ya[e] + yb[e] * yb[e]; }
            v4u w; w.x = cvtpk(ya[0], ya[1]); w.y = cvtpk(ya[2], ya[3]); w.z = cvtpk(yb[0], yb[1]); w.w = cvtpk(yb[2], yb[3]); Fp[ct][s] = w; }
    }
#pragma unroll
    for (int ct = 0; ct < 4; ++ct) { float t = ss[ct]; t += __shfl_xor(t, 16); t += __shfl_xor(t, 32);
        const float sc = rsqrtf(t + EPS) * qscale;
#pragma unroll
        for (int s = 0; s < 2; ++s) { const v4u q = Fp[ct][s]; v4u w; w.x = cvtpk(bflo(q.x) * sc, bfhi(q.x) * sc); w.y = cvtpk(bflo(q.y) * sc, bfhi(q.y) * sc); w.z = cvtpk(bflo(q.z) * sc, bfhi(q.z) * sc); w.w = cvtpk(bflo(q.w) * sc, bfhi(q.w) * sc);
            F[ct][s] = __builtin_bit_cast(bf16x8, w); } }
}
__device__ __forceinline__ void dn_chunk_wave(LAS unsigned char* W, const bf16* __restrict__ PROJ, const float* __restrict__ cw, float Aexp, float dtb,
                                              unsigned char* __restrict__ dnf, float* __restrict__ gt_out, int b, int h, int n, int lane) {
    asm volatile("" : "+v"(lane));
    const int c = lane & 15, g = lane >> 4;
    LAS float* AII = (LAS float*)(W + DW_AII); LAS float* vbeta = (LAS float*)(W + DW_VEC); LAS float* vgam = vbeta + 64; LAS float* vegam = vgam + 64; LAS float* vedec = vegam + 64;
    const f32x4 z4 = {0.f, 0.f, 0.f, 0.f};
    v4u rg[9];
    dnw_stage_issue(rg, PROJ, b, h, n, 0, lane);
    { const bf16* pr = PROJ + ((size_t)b * SEQ + 64 * n + lane) * NINP; const float beta = sigmoid_f(bf2f(pr[PC_B + h]));
        const float z = bf2f(pr[PC_A + h]) + dtb; const float sp = z > 20.f ? z : log1pf(__expf(z)); float gv = -Aexp * sp;
#pragma unroll
        for (int off = 1; off < 64; off <<= 1) { const float t = __shfl_up(gv, off); if (lane >= off) gv += t; }
        const float glast = __shfl(gv, 63);
        vbeta[lane] = beta; vgam[lane] = gv; vegam[lane] = __expf(gv); vedec[lane] = __expf(glast - gv);
        if (lane == 63) *gt_out = __expf(gv); }
    bf16x8 KF[4][2];
    {
    bf16x8 QF[4][2];
    dnw_stage_commit(rg, W, lane); asm volatile("" ::: "memory");
    dnw_stage_issue(rg, PROJ, b, h, n, 1, lane);
    dnw_conv_qk(W, cw + h * 64, 0.125f, QF, c, g);
#pragma unroll
    for (int ct = 0; ct < 4; ++ct) { const float e = vegam[16 * ct + c];
#pragma unroll
        for (int s = 0; s < 2; ++s) { const v4u q = __builtin_bit_cast(v4u, QF[ct][s]);
            v4u o; o.x = cvtpk(bflo(q.x) * e, bfhi(q.x) * e); o.y = cvtpk(bflo(q.y) * e, bfhi(q.y) * e); o.z = cvtpk(bflo(q.z) * e, bfhi(q.z) * e); o.w = cvtpk(bflo(q.w) * e, bfhi(q.w) * e);
            *(v4u*)(dnf + 8192 + (2 * ct + s) * 1024 + lane * 16) = o; } }
    asm volatile("" ::: "memory");
    dnw_stage_commit(rg, W, lane); asm volatile("" ::: "memory");
    dnw_stage_issue(rg, PROJ, b, h, n, 2, lane);
    dnw_conv_qk(W, cw + 384 + h * 64, 1.0f, KF, c, g);
#pragma unroll
    for (int ct = 0; ct < 4; ++ct) { const float gc = vgam[16 * ct + c];
#pragma unroll
        for (int sp = 0; sp < 2; ++sp) { f32x4 th[2];
#pragma unroll
            for (int hh = 0; hh < 2; ++hh) { const int ctp = 2 * sp + hh; f32x4 t = z4;
                if (ctp <= ct) { t = MFMA16(KF[ctp][0], QF[ct][0], t); t = MFMA16(KF[ctp][1], QF[ct][1], t); const f32x4 gp = *(const LAS f32x4*)(vgam + 16 * ctp + 4 * g);
#pragma unroll
                    for (int r = 0; r < 4; ++r) t[r] = (16 * ct + c >= 16 * ctp + 4 * g + r) ? t[r] * __expf(gc - gp[r]) : 0.f; }
                th[hh] = t; }
            *(bf16x8*)(dnf + 16384 + (2 * ct + sp) * 1024 + lane * 16) = pack8(th[0], th[1]); } }
    }
    asm volatile("" ::: "memory");
    dnw_stage_commit(rg, W, lane); asm volatile("" ::: "memory");
#define DNW_TILE(dst, ctp, ct) do { f32x4 t_ = z4; t_ = MFMA16(KF[ctp][0], KF[ct][0], t_); t_ = MFMA16(KF[ctp][1], KF[ct][1], t_); \
        const float bc_ = -vbeta[16 * (ct) + c], gc_ = vgam[16 * (ct) + c]; const f32x4 gp_ = *(const LAS f32x4*)(vgam + 16 * (ctp) + 4 * g); \
        _Pragma("unroll") for (int r_ = 0; r_ < 4; ++r_) t_[r_] = t_[r_] * bc_ * __expf(gc_ - gp_[r_]); dst = t_; } while (0)
    bf16x8 AF1, AF2, AF3a, AF3b;
    { f32x4 t01, t02, t12, t03, t13, t23; DNW_TILE(t01, 0, 1); DNW_TILE(t02, 0, 2); DNW_TILE(t12, 1, 2); DNW_TILE(t03, 0, 3); DNW_TILE(t13, 1, 3); DNW_TILE(t23, 2, 3);
        AF1 = pack8(t01, z4); AF2 = pack8(t02, t12); AF3a = pack8(t03, t13); AF3b = pack8(t23, z4); }
#undef DNW_TILE
#pragma unroll
    for (int i = 0; i < 4; ++i) { f32x4 t = z4; t = MFMA16(KF[i][0], KF[i][0], t); t = MFMA16(KF[i][1], KF[i][1], t);
        const float bc = vbeta[16 * i + c], gc = vgam[16 * i + c]; const f32x4 gp = *(const LAS f32x4*)(vgam + 16 * i + 4 * g);
#pragma unroll
        for (int r = 0; r < 4; ++r) t[r] = (c > 4 * g + r) ? t[r] * bc * __expf(gc - gp[r]) : 0.f;
        *(LAS f32x4*)(AII + i * 256 + c * 16 + 4 * g) = t; }
    asm volatile("" ::: "memory");
    { const int i = g, cl = c; float t[16];
#pragma unroll
        for (int r = 0; r < 16; ++r) { float acc = (r == cl) ? 1.f : 0.f; f32x4 rowv[4];
#pragma unroll
            for (int q = 0; q < 4; ++q) if (4 * q < r) rowv[q] = *(const LAS f32x4*)(AII + i * 256 + r * 16 + 4 * q);
#pragma unroll
            for (int m = 0; m < r; ++m) acc -= rowv[m >> 2][m & 3] * t[m];
            t[r] = acc; }
        asm volatile("" ::: "memory");
#pragma unroll
        for (int r = 0; r < 16; ++r) AII[i * 256 + r * 16 + cl] = t[r]; }
    asm volatile("" ::: "memory");
    bf16x4 TF[4];
#pragma unroll
    for (int i = 0; i < 4; ++i) { const f32x4 tv = *(const LAS f32x4*)(AII + i * 256 + c * 16 + 4 * g); TF[i] = pack4(tv); }
#define DNW_SOLVE(X, R) do { X[0] = MFMA16K(TF[0], pack4(R[0]), z4); \
        { const f32x4 y_ = MFMA16(AF1, pack8(X[0], z4), R[1]); X[1] = MFMA16K(TF[1], pack4(y_), z4); } \
        { const f32x4 y_ = MFMA16(AF2, pack8(X[0], X[1]), R[2]); X[2] = MFMA16K(TF[2], pack4(y_), z4); } \
        { f32x4 y_ = MFMA16(AF3a, pack8(X[0], X[1]), R[3]); y_ = MFMA16(AF3b, pack8(X[2], z4), y_); X[3] = MFMA16K(TF[3], pack4(y_), z4); } } while (0)
#pragma unroll 1
    for (int vt = 0; vt < 4; ++vt) { const int d = 16 * vt + c; float cwv[4];
#pragma unroll
        for (int j = 0; j < 4; ++j) cwv[j] = cw[j * 1152 + 768 + h * 64 + d];
        f32x4 R[4], X[4];
#pragma unroll
        for (int i = 0; i < 4; ++i) { float x7[7];
#pragma unroll
            for (int m = 0; m < 7; ++m) x7[m] = bf2f(*(const LAS bf16*)(W + DW_RAW + (16 * i + 4 * g + m) * 144 + 2 * d));
            const f32x4 bt = *(const LAS f32x4*)(vbeta + 16 * i + 4 * g);
#pragma unroll
            for (int r = 0; r < 4; ++r) R[i][r] = silu_f((cwv[0] * x7[r] + cwv[1] * x7[r + 1]) + (cwv[2] * x7[r + 2] + cwv[3] * x7[r + 3])) * bt[r]; }
        DNW_SOLVE(X, R);
#pragma unroll
        for (int ct = 0; ct < 4; ++ct) { v2u w; w.x = cvtpk(X[ct][0], X[ct][1]); w.y = cvtpk(X[ct][2], X[ct][3]); *(v2u*)(dnf + 32768 + (vt * 4 + ct) * 512 + lane * 8) = w; } }
    bf16x4 I16; { v2u w; w.x = ((4 * g == c) ? 0x3F80u : 0u) | ((4 * g + 1 == c) ? 0x3F800000u : 0u); w.y = ((4 * g + 2 == c) ? 0x3F80u : 0u) | ((4 * g + 3 == c) ? 0x3F800000u : 0u); I16 = __builtin_bit_cast(bf16x4, w); }
#pragma unroll 1
    for (int s2 = 0; s2 < 2; ++s2) {
        f32x4 Xw[2][4];
#pragma unroll
        for (int hh = 0; hh < 2; ++hh) {
            v4u iw = {0u, 0u, 0u, 0u};
            if (g == (c >> 2)) { const int j = 4 * hh + (c & 3); const unsigned one = (j & 1) ? 0x3F800000u : 0x3F80u; const int wsel = j >> 1; iw.x = wsel == 0 ? one : 0u; iw.y = wsel == 1 ? one : 0u; iw.z = wsel == 2 ? one : 0u; iw.w = wsel == 3 ? one : 0u; }
            const bf16x8 Isel = __builtin_bit_cast(bf16x8, iw);
            const int kt = 2 * s2 + hh;
            f32x4 Kt[4], R[4];
#pragma unroll
            for (int i = 0; i < 4; ++i) { Kt[i] = (s2 == 0) ? MFMA16(KF[i][0], Isel, z4) : MFMA16(KF[i][1], Isel, z4);
                const f32x4 bt = *(const LAS f32x4*)(vbeta + 16 * i + 4 * g), eg = *(const LAS f32x4*)(vegam + 16 * i + 4 * g); R[i] = Kt[i] * bt * eg; }
            DNW_SOLVE(Xw[hh], R);
#pragma unroll
            for (int sp = 0; sp < 2; ++sp) { const f32x4 e1 = *(const LAS f32x4*)(vedec + 32 * sp + 4 * g), e2 = *(const LAS f32x4*)(vedec + 32 * sp + 16 + 4 * g);
                *(bf16x8*)(dnf + 24576 + (2 * kt + sp) * 1024 + lane * 16) = pack8(Kt[2 * sp] * e1, Kt[2 * sp + 1] * e2); }
        }
#pragma unroll
        for (int i = 0; i < 4; ++i) { const f32x4 D0 = MFMA16K(pack4(Xw[0][i]), I16, z4), D1 = MFMA16K(pack4(Xw[1][i]), I16, z4);
            *(bf16x8*)(dnf + (2 * i + s2) * 1024 + lane * 16) = pack8(D0 * -1.0f, D1 * -1.0f); }
    }
#undef DNW_SOLVE
}
__device__ __forceinline__ void dn_chunk_phase(LAS unsigned char* L, const bf16* __restrict__ PROJ, const float* __restrict__ cw, const float* __restrict__ alog, const float* __restrict__ dtbp,
                                               unsigned char* __restrict__ dnf_all, float* __restrict__ gt_all, int u0, int stride, int tid, int lane, int wave) {
    constexpr int NU = BATCH * 6 * 32;
    if (u0 >= NU) return;
    __syncthreads();
    { const DnUnitId id0 = dn_unit_id(u0); DnPre P; dn_prefetch(P, PROJ, id0, tid, lane, wave); dn_commit_raw(P, L, 0, tid); dn_commit_gates(P, L, 0, __expf(alog[id0.h]), dtbp[id0.h], gt_all + u0, true, lane, wave); }
    for (int u = u0;; u += 2 * stride) {
        dn_chunk_unit<0>(L, PROJ, cw, alog, dtbp, dnf_all, gt_all, u, u + stride, tid, lane, wave);
        if (u + stride >= NU) break;
        dn_chunk_unit<1>(L, PROJ, cw, alog, dtbp, dnf_all, gt_all, u + stride, u + 2 * stride, tid, lane, wave);
        if (u + 2 * stride >= NU) break;
    }
    asm volatile("s_waitcnt vmcnt(0) lgkmcnt(0)" ::: "memory");
    __syncthreads();
}
struct DnScanCtx { LAS unsigned char* fb; LAS float* ssq; LAS bf16* tz; const unsigned char* ubase; const float* GTp; const bf16* PROJ; bf16* MIX; float nw; int b, h, bh, vt, col, g, lane; };
struct DnScanState { f32x4 S[4]; bf16x8 Sb0, Sb1; f32x4 ua[4]; };
template <int PAR> __device__ __forceinline__ void dn_scan_chunk(const DnScanCtx& C, int n, DnScanState& T) {
    const int vt = C.vt, col = C.col, g = C.g, lane = C.lane, h = C.h;
    const f32x4 z4 = {0.f, 0.f, 0.f, 0.f};
    LDS_BAR();
    const size_t tok0 = (size_t)C.b * SEQ + 64 * n;
    v4u zl[2];
#pragma unroll
    for (int j = 0; j < 2; ++j) zl[j] = *(const v4u*)(C.PROJ + (tok0 + (lane >> 1) + 32 * j) * NINP + PC_Z + h * 64 + 16 * vt + 8 * (lane & 1));
    const bool more = n + 1 < 32;
    v4u fr[8]; v2u un[4]; float gtn = 0.f;
    { const unsigned char* nb = C.ubase + (size_t)(more ? n + 1 : n) * DNF_UNIT;
#pragma unroll
        for (int q = 0; q < 8; ++q) fr[q] = *(const v4u*)(nb + (vt * 8 + q) * 1024 + lane * 16);
#pragma unroll
        for (int ct = 0; ct < 4; ++ct) un[ct] = *(const v2u*)(nb + 32768 + (vt * 4 + ct) * 512 + lane * 8);
        gtn = C.GTp[C.bh * 32 + (more ? n + 1 : n)]; }
    const LAS unsigned char* F = C.fb + PAR * 32768 + lane * 16;
#define DN_FRAG(set, f) (*(const LAS bf16x8*)(F + (set) * 8192 + (f) * 1024))
    bf16x8 fw[8], fq[8];
#pragma unroll
    for (int f = 0; f < 8; ++f) fw[f] = DN_FRAG(0, f);
#pragma unroll
    for (int f = 0; f < 8; ++f) fq[f] = DN_FRAG(1, f);
    f32x4 vn[4];
#pragma unroll
    for (int ct = 0; ct < 4; ++ct) { f32x4 a = T.ua[ct]; a = MFMA16(fw[2 * ct], T.Sb0, a); a = MFMA16(fw[2 * ct + 1], T.Sb1, a); vn[ct] = a; }
#pragma unroll
    for (int f = 0; f < 8; ++f) fw[f] = DN_FRAG(2, f);
    f32x4 oo[4];
#pragma unroll
    for (int ct = 0; ct < 4; ++ct) { f32x4 a = z4; a = MFMA16(fq[2 * ct], T.Sb0, a); a = MFMA16(fq[2 * ct + 1], T.Sb1, a); oo[ct] = a; }
#pragma unroll
    for (int f = 0; f < 8; ++f) fq[f] = DN_FRAG(3, f);
    const bf16x8 Vb0 = pack8(vn[0], vn[1]), Vb1 = pack8(vn[2], vn[3]);
#pragma unroll
    for (int ct = 0; ct < 4; ++ct) { f32x4 a = oo[ct]; a = MFMA16(fw[2 * ct], Vb0, a); a = MFMA16(fw[2 * ct + 1], Vb1, a); oo[ct] = a; }
#pragma unroll
    for (int kt = 0; kt < 4; ++kt) { f32x4 a = T.S[kt]; a = MFMA16(fq[2 * kt], Vb0, a); a = MFMA16(fq[2 * kt + 1], Vb1, a); T.S[kt] = a; }
#undef DN_FRAG
    T.Sb0 = pack8(T.S[0], T.S[1]); T.Sb1 = pack8(T.S[2], T.S[3]);
#pragma unroll
    for (int kt = 0; kt < 4; ++kt) T.S[kt] = T.S[kt] * gtn;
#pragma unroll
    for (int ct = 0; ct < 4; ++ct) T.ua[ct] = (f32x4){bflo(un[ct].x), bfhi(un[ct].x), bflo(un[ct].y), bfhi(un[ct].y)};
    { LAS unsigned char* dst = C.fb + (1 - PAR) * 32768 + (vt * 8) * 1024 + lane * 16;
#pragma unroll
        for (int q = 0; q < 8; ++q) *(LAS v4u*)(dst + q * 1024) = fr[q]; }
#pragma unroll
    for (int ct = 0; ct < 4; ++ct) { f32x4 q = oo[ct] * oo[ct];
#pragma unroll
        for (int off = 1; off < 16; off <<= 1) { q[0] += __shfl_xor(q[0], off); q[1] += __shfl_xor(q[1], off); q[2] += __shfl_xor(q[2], off); q[3] += __shfl_xor(q[3], off); }
        if (col == 0) *(LAS f32x4*)(C.ssq + vt * 64 + 16 * ct + 4 * g) = q; }
    LAS bf16* tz = C.tz;
#pragma unroll
    for (int j = 0; j < 2; ++j) *(LAS v4u*)(tz + ((lane >> 1) + 32 * j) * 24 + 8 * (lane & 1)) = zl[j];
    LDS_BAR();
#pragma unroll
    for (int ct = 0; ct < 4; ++ct) { const f32x4 tot = (*(const LAS f32x4*)(C.ssq + 16 * ct + 4 * g) + *(const LAS f32x4*)(C.ssq + 64 + 16 * ct + 4 * g)) + (*(const LAS f32x4*)(C.ssq + 128 + 16 * ct + 4 * g) + *(const LAS f32x4*)(C.ssq + 192 + 16 * ct + 4 * g));
#pragma unroll
        for (int r = 0; r < 4; ++r) { LAS bf16* e = tz + (16 * ct + 4 * g + r) * 24 + col;
            *e = f2bf(oo[ct][r] * rsqrtf(tot[r] * (1.f / 64.f) + EPS) * C.nw * silu_f(bf2f(*e))); } }
    asm volatile("s_waitcnt lgkmcnt(0)" ::: "memory");
#pragma unroll
    for (int j = 0; j < 2; ++j) { const v4u o = *(const LAS v4u*)(tz + ((lane >> 1) + 32 * j) * 24 + 8 * (lane & 1));
        *(v4u*)(C.MIX + (tok0 + (lane >> 1) + 32 * j) * DM + h * 64 + 16 * vt + 8 * (lane & 1)) = o; }
}
__device__ __forceinline__ void dn_scan_pair(LAS unsigned char* lds, const unsigned char* __restrict__ DNFp, const float* __restrict__ GTp, const bf16* __restrict__ PROJ, bf16* __restrict__ MIX,
                                             const float* __restrict__ nrmw, int pair, int lane, int wave) {
    DnScanCtx C;
    C.vt = wave & 3; C.bh = pair; C.b = C.bh / 6; C.h = C.bh % 6; C.col = lane & 15; C.g = lane >> 4; C.lane = lane;
    C.fb = lds + RING_OFF;
    C.ssq = (LAS float*)(lds + LDSCTL_OFF + 1024);
    C.tz = (LAS bf16*)(lds + RING_OFF + 65536 + (wave & 3) * 3072);
    if (wave >= 4) {
        __syncthreads();
        for (int n = 0; n < 32; ++n) { LDS_BAR(); LDS_BAR(); }
        asm volatile("s_waitcnt vmcnt(0) lgkmcnt(0)" ::: "memory");
        __syncthreads();
        return; }
    C.ubase = DNFp + (size_t)C.bh * 32 * DNF_UNIT; C.GTp = GTp; C.PROJ = PROJ; C.MIX = MIX;
    C.nw = nrmw[16 * C.vt + C.col];
    const f32x4 z4 = {0.f, 0.f, 0.f, 0.f};
    DnScanState T;
#pragma unroll
    for (int kt = 0; kt < 4; ++kt) T.S[kt] = z4;
    T.Sb0 = pack8(z4, z4); T.Sb1 = T.Sb0;
    __syncthreads();
    { const unsigned char* nb = C.ubase;
#pragma unroll
        for (int q = 0; q < 8; ++q) *(LAS v4u*)(C.fb + (C.vt * 8 + q) * 1024 + lane * 16) = *(const v4u*)(nb + (C.vt * 8 + q) * 1024 + lane * 16);
#pragma unroll
        for (int ct = 0; ct < 4; ++ct) { const v2u w = *(const v2u*)(nb + 32768 + (C.vt * 4 + ct) * 512 + lane * 8); T.ua[ct] = (f32x4){bflo(w.x), bfhi(w.x), bflo(w.y), bfhi(w.y)}; } }
    for (int n = 0; n < 32; n += 2) { dn_scan_chunk<0>(C, n, T); dn_scan_chunk<1>(C, n + 1, T); }
    asm volatile("s_waitcnt vmcnt(0) lgkmcnt(0)" ::: "memory");
    __syncthreads();
}
__device__ __forceinline__ void cmp_mlp2_tiles(const bf16* __restrict__ HID, const bf16* __restrict__ W2T, bf16* __restrict__ KC, bf16* __restrict__ VCT, int T0, int T1, int stride, int first, int lane) {
    const int col = lane & 15, g4 = lane >> 4;
    for (int T = T0 + first; T < T1; T += stride) {
        const int row0 = 16 * T, kv = row0 >> 13, g = (row0 >> 7) & 1, b = (row0 >> 8) & 31, i0 = row0 & 127;
        bf16x8 af[4];
#pragma unroll
        for (int s4 = 0; s4 < 4; ++s4) af[s4] = *(const bf16x8*)(HID + (size_t)(row0 + col) * 256 + kv * 128 + 32 * s4 + 8 * g4);
#pragma unroll
        for (int dt = 0; dt < 4; ++dt) { f32x4 acc = {0.f, 0.f, 0.f, 0.f};
#pragma unroll
            for (int s4 = 0; s4 < 4; ++s4) { const bf16x8 bfr = *(const bf16x8*)(W2T + (size_t)(kv * 64 + 16 * dt + col) * 128 + 32 * s4 + 8 * g4); acc = MFMA16(af[s4], bfr, acc); }
            if (i0 + 4 * g4 + 3 == 127) acc[3] = 0.f;
            if (kv == 0) {
#pragma unroll
                for (int r = 0; r < 4; ++r) KC[((size_t)(b * 2 + g) * 128 + i0 + 4 * g4 + r) * 64 + 16 * dt + col] = f2bf(acc[r]);
            } else { const int pos0 = 32 * (i0 >> 5) + 8 * g4 + ((i0 & 16) ? 4 : 0);
                v2u w; w.x = cvtpk(acc[0], acc[1]); w.y = cvtpk(acc[2], acc[3]); *(v2u*)(VCT + ((size_t)(b * 2 + g) * 64 + 16 * dt + col) * 128 + pos0) = w; } }
    }
}
struct Args { const float* in[21]; float* out; unsigned char* ws; int pre, ph_lo, ph_hi, l_lo, l_hi, pad; };
typedef const Args __attribute__((address_space(4)))* ArgsP;
enum { I_X = 0, I_NORMW, I_WIN, I_DNCONV, I_DNALOG, I_DNDT, I_DNNORM, I_CFW, I_CFB, I_CFLNW, I_CFLNB, I_KPOS, I_VPOS, I_KW1, I_KW2, I_VW1, I_VW2, I_WOUT, I_WG, I_WU, I_WD };

template <unsigned PHM> __global__ void __launch_bounds__(NTHR, 2) fwd(Args args) {
    extern __shared__ __attribute__((aligned(16))) unsigned char lds_raw[];
    LAS unsigned char* lds = (LAS unsigned char*)lds_raw;
    volatile LAS unsigned* MISC = (volatile LAS unsigned*)(lds + MISC_OFF);
    for (int u = threadIdx.x; u < (LDS_BYTES - LDSCTL_OFF) / 4; u += NTHR) ((LAS unsigned*)(lds + LDSCTL_OFF))[u] = 0u;
    __syncthreads();
#if MK_ONE_LAUNCH
    XcdBarrier bar = xcd_barrier_post((unsigned*)(args.ws + WS_CTL) + CW_BAR, MISC + 8);
#define GRID_BAR() xcd_barrier(bar)
#else
#define GRID_BAR() do { } while (0)
#endif
    const int ph_lo = args.ph_lo, ph_hi = args.ph_hi;
#define PH_LOCALS() \
    int tid = threadIdx.x; asm volatile("" : "+v"(tid)); \
    const int lane = tid & 63, wave = __builtin_amdgcn_readfirstlane(tid >> 6); \
    int blk = blockIdx.x; asm volatile("" : "+s"(blk)); \
    const int G = gridDim.x, gw = blk * NWAVES + wave, NGW = G * NWAVES; \
    ArgsP ap = (ArgsP)__builtin_amdgcn_kernarg_segment_ptr(); asm volatile("" : "+s"(ap)); \
    unsigned char* const ws = ap->ws; \
    bf16* const Win_t = (bf16*)(ws + WS_WIN); bf16* const Wout_t = (bf16*)(ws + WS_WOUT); bf16* const Wgu_t = (bf16*)(ws + WS_WGU); bf16* const Wd_t = (bf16*)(ws + WS_WD); bf16* const Wc1_t = (bf16*)(ws + WS_WC1); \
    bf16* const KC = (bf16*)(ws + WS_KC); bf16* const VCT = (bf16*)(ws + WS_VCT); \
    bf16* const PROJ = (bf16*)(ws + WS_PROJ); bf16* const HFF = (bf16*)(ws + WS_PROJ); bf16* const MIX = (bf16*)(ws + WS_MIX); bf16* const MBUF = (bf16*)(ws + WS_MBUF); bf16* const XB = (bf16*)(ws + WS_XB); \
    bf16* const ACMP = (bf16*)(ws + WS_ACMP); bf16* const HID = (bf16*)(ws + WS_HID); \
    bf16* const KS = (bf16*)(ws + WS_KS); bf16* const KW = (bf16*)(ws + WS_KW); bf16* const VST = (bf16*)(ws + WS_VST); bf16* const VWT = (bf16*)(ws + WS_VWT); \
    const float* const x_in = ap->in[I_X]; float* const xres = ap->out; float* const RSTD = (float*)(ws + WS_RSTD); bf16* const XD = (bf16*)ap->out; bf16* const XM = (bf16*)(ws + WS_MIX); (void)RSTD; (void)XD; (void)XM; \
    (void)lane; (void)gw; (void)NGW; (void)Win_t; (void)Wout_t; (void)Wgu_t; (void)Wd_t; (void)Wc1_t; (void)KC; (void)VCT; (void)PROJ; (void)HFF; (void)MIX; (void)MBUF; (void)XB; (void)ACMP; (void)HID; (void)KS; (void)KW; (void)VST; (void)VWT; (void)x_in; (void)xres; (void)G;

    const int lo = ph_lo, hi = ph_hi;
#define IN(k) (((PHM >> (k)) & 1u) && lo <= (k) && (k) < hi)
    if ((PHM & 1u) && args.pre) REP(30) {
        PH_LOCALS();
        LAS float* scr = (LAS float*)(lds + RING_OFF + wave * 16384);
        constexpr int IT_IN = 16 * 104, IT_OUT = 16 * 32, IT_GU = 16 * 176, IT_D = 44 * 32, IT_C1 = 32 * 8, IT_L = IT_IN + IT_OUT + IT_GU + IT_D + IT_C1;
        for (int it = gw; it < DEPTH * IT_L; it += NGW) {
            const int l = it / IT_L; int r = it % IT_L;
            const float* nw = ap->in[I_NORMW] + (size_t)l * 4 * DM;
            if (r < IT_IN) { const float* W = ap->in[I_WIN] + (size_t)l * DM * NIN; const float* sc = nw;
                wprep_item([=](int k, int n) { const int col = win_src_col(n); return col >= 0 ? W[(size_t)k * NIN + col] * sc[k] : 0.f; }, DM, Win_t + (size_t)l * NINP * DM, scr, r, 104, lane); continue; } r -= IT_IN;
            if (r < IT_OUT) { const float* W = ap->in[I_WOUT] + (size_t)l * DM * DM;
                wprep_item([=](int k, int n) { return W[(size_t)k * DM + n]; }, DM, Wout_t + (size_t)l * DM * DM, scr, r, 32, lane); continue; } r -= IT_OUT;
            if (r < IT_GU) { const float* Wg = ap->in[I_WG] + (size_t)l * DM * DFF; const float* Wu = ap->in[I_WU] + (size_t)l * DM * DFF; const float* sc = nw + 2 * DM;
                wprep_item([=](int k, int n) { const int t = n >> 8, w = n & 255; const ptrdiff_t sel = w < 128 ? (ptrdiff_t)0 : (Wu - Wg); return Wg[sel + (ptrdiff_t)k * DFF + 128 * t + (w & 127)] * sc[k]; }, DM, Wgu_t + (size_t)l * NGU * DM, scr, r, 176, lane); continue; } r -= IT_GU;
            if (r < IT_D) { const float* W = ap->in[I_WD] + (size_t)l * DFF * DM;
                wprep_item([=](int k, int n) { return W[(size_t)k * DM + n]; }, DFF, Wd_t + (size_t)l * DM * DFF, scr, r, 32, lane); continue; } r -= IT_D;
            { const float* Wk = ap->in[I_KW1] + (size_t)l * CMP_K * 128; const float* Wv = ap->in[I_VW1] + (size_t)l * CMP_K * 128;
                wprep_item([=](int k, int n) { const ptrdiff_t sel = n < 128 ? (ptrdiff_t)0 : (Wv - Wk); return Wk[sel + (ptrdiff_t)k * 128 + (n & 127)]; }, CMP_K, Wc1_t + (size_t)l * 256 * CMP_K, scr, r, 8, lane); }
        }
        for (int e = blk * NTHR + tid; e < DEPTH * 2 * 64 * 128; e += G * NTHR) { const int n = e & 127, d = (e >> 7) & 63, kv = (e >> 13) & 1, ll = e >> 14;
            ((bf16*)(ws + WS_W2T))[e] = f2bf(ap->in[kv ? I_VW2 : I_KW2][((size_t)ll * 128 + n) * 64 + d]); }
        for (int m = gw; m < MTOK / 2; m += NGW) {
            const int m2 = m + MTOK / 2; const f32x4* xa = (const f32x4*)(x_in + (size_t)m * DM) + lane; const f32x4* xb2 = (const f32x4*)(x_in + (size_t)m2 * DM) + lane;
            f32x4 va[4], vb[4]; float sa = 0.f, sb = 0.f;
#pragma unroll
            for (int j = 0; j < 4; ++j) { va[j] = xa[64 * j]; vb[j] = xb2[64 * j]; }
#pragma unroll
            for (int j = 0; j < 4; ++j) { sa += (va[j].x * va[j].x + va[j].y * va[j].y) + (va[j].z * va[j].z + va[j].w * va[j].w); sb += (vb[j].x * vb[j].x + vb[j].y * vb[j].y) + (vb[j].z * vb[j].z + vb[j].w * vb[j].w); }
#pragma unroll
            for (int o = 1; o < 64; o <<= 1) { sa += __shfl_xor(sa, o); sb += __shfl_xor(sb, o); }
            if (lane == 0) { RSTD[m] = rsqrtf(sa * (1.f / DM) + EPS); RSTD[m2] = rsqrtf(sb * (1.f / DM) + EPS); }
            v2u* oa = (v2u*)(XB + (size_t)m * DM) + lane; v2u* ob = (v2u*)(XB + (size_t)m2 * DM) + lane;
#pragma unroll
            for (int j = 0; j < 4; ++j) { v2u w; w.x = cvtpk(va[j].x, va[j].y); w.y = cvtpk(va[j].z, va[j].w); oa[64 * j] = w; w.x = cvtpk(vb[j].x, vb[j].y); w.y = cvtpk(vb[j].z, vb[j].w); ob[64 * j] = w; }
        }
        GRID_BAR();
    }

    for (int l = args.l_lo, l_end = args.l_hi; l < l_end; ++l) {
        if (IN(1)) REP(1) {
            PH_LOCALS();
            pg8::Gemm g{l == 0 ? XB : XD, Win_t + (size_t)l * NINP * DM, MTOK, NINP, DM}; pg8::StaticOrder S; S.init(MTOK, NINP, G, blk);
            pg8::EpiBf16<0> E{PROJ, NINP, RSTD};
            pg8::gemm_phase<pg8::EpiBf16<0>, pg8::StaticOrder, true, true>(lds + RING_OFF, g, S, E);
            GRID_BAR();
        }
        if (IN(2)) REP(2) {
            PH_LOCALS();
            REP(21) {
            {
                const float* kpos = ap->in[I_KPOS] + (size_t)l * 32 * 64; const float* vpos = ap->in[I_VPOS] + (size_t)l * 32 * 64;
                for (int row = gw; row < CMP_ROWS; row += NGW) {
                    const int i = row & 127, g = (row >> 7) & 1, b = (row >> 8) & 31, kv = row >> 13;
                    const float* pos = kv ? vpos : kpos; const int pc = (kv ? PC_VC : PC_KC) + g * 64;
#pragma unroll
                    for (int cch = 0; cch < 4; ++cch) { const int ch = lane + 64 * cch, tl = ch >> 3, d0 = (ch & 7) * 8;
                        v4u o = {0u, 0u, 0u, 0u};
                        if (i < 127) { const v4u s = *(const v4u*)(PROJ + ((size_t)b * SEQ + 16 * i + tl) * NINP + pc + d0);
                            const f32x4 p0 = *(const f32x4*)(pos + tl * 64 + d0), p1 = *(const f32x4*)(pos + tl * 64 + d0 + 4);
                            o.x = cvtpk(bflo(s.x) + p0.x, bfhi(s.x) + p0.y); o.y = cvtpk(bflo(s.y) + p0.z, bfhi(s.y) + p0.w);
                            o.z = cvtpk(bflo(s.z) + p1.x, bfhi(s.z) + p1.y); o.w = cvtpk(bflo(s.w) + p1.z, bfhi(s.w) + p1.w); }
                        *(v4u*)(ACMP + (size_t)row * CMP_K + tl * 64 + d0) = o; }
                }
            }
            for (size_t ch = (size_t)blk * NTHR + tid; ch < (size_t)MTOK * 32; ch += (size_t)G * NTHR) {
                const int cc = (int)(ch & 31), which = cc >> 4, g = (cc >> 3) & 1, d0 = (cc & 7) * 8; const size_t tok = ch >> 5; const int b = (int)(tok >> 11), t = (int)(tok & 2047);
                const v4u s = *(const v4u*)(PROJ + tok * NINP + (which ? PC_KW : PC_KS) + g * 64 + d0);
                *(v4u*)((which ? KW : KS) + ((size_t)(b * 2 + g) * SEQ + t) * 64 + d0) = s;
            }
            {
                LAS bf16* tile = (LAS bf16*)(lds + RING_OFF + wave * 16384);
                for (int it = gw; it < 2 * BATCH * 2 * 32; it += NGW) {
                    const int tt = it & 31, g = (it >> 5) & 1, b = (it >> 6) & 31, which = it >> 11; const int t0 = tt * 64;
                    const bf16* src = PROJ + ((size_t)b * SEQ + t0) * NINP + (which ? PC_VW : PC_VS) + g * 64;
#pragma unroll
                    for (int q = 0; q < 8; ++q) { const int t = (lane >> 3) + 8 * q, d0 = (lane & 7) * 8; const v4u s = *(const v4u*)(src + (size_t)t * NINP + d0);
                        LAS unsigned* dst = (LAS unsigned*)(tile + t * 66 + d0); dst[0] = s.x; dst[1] = s.y; dst[2] = s.z; dst[3] = s.w; }
                    LDS_WAIT(); asm volatile("" ::: "memory");
                    bf16* dstb = (which ? VWT : VST) + (size_t)(b * 2 + g) * 64 * SEQ + t0;
#pragma unroll
                    for (int q = 0; q < 8; ++q) { const int d = (lane >> 3) + 8 * q, ck = lane & 7, gI = ck >> 2, gqq = ck & 3;
                        unsigned short e[8];
#pragma unroll
                        for (int j = 0; j < 8; ++j) { const int key = 32 * gI + (j < 4 ? 4 * gqq + j : 16 + 4 * gqq + (j - 4)); e[j] = tile[key * 66 + d]; }
                        v4u o; o.x = e[0] | ((unsigned)e[1] << 16); o.y = e[2] | ((unsigned)e[3] << 16); o.z = e[4] | ((unsigned)e[5] << 16); o.w = e[6] | ((unsigned)e[7] << 16);
                        *(v4u*)(dstb + (size_t)d * SEQ + 8 * ck) = o; }
                    LDS_WAIT(); asm volatile("" ::: "memory");
                }
            }
            }
            __syncthreads();
            REP(22) {
                LAS float* hb = (LAS float*)(lds + RING_OFF); LAS float* yb = hb + 62 * 256;
                const float* dw = ap->in[I_CFW] + (size_t)l * 31 * 256; const float* db = ap->in[I_CFB] + (size_t)l * 256;
                const float* lw = ap->in[I_CFLNW] + (size_t)l * 256; const float* lb = ap->in[I_CFLNB] + (size_t)l * 256;
                const int ch = tid & 255, half = tid >> 8; float wv[31];
#pragma unroll
                for (int j = 0; j < 31; ++j) wv[j] = dw[j * 256 + ch];
                const float bias = db[ch];
                float lwv[4], lbv[4];
#pragma unroll
                for (int k = 0; k < 4; ++k) { lwv[k] = lw[lane + 64 * k]; lbv[k] = lb[lane + 64 * k]; }
                for (int u = blk; u < BATCH * 64; u += G) {
                    const int b = u >> 6, t0 = (u & 63) * 32;
                    for (int e = tid; e < 62 * 32; e += NTHR) { const int rr = e >> 5, c8 = (e & 31) * 8, t = t0 - 30 + rr;
                        f32x4 o0 = {0.f, 0.f, 0.f, 0.f}, o1 = o0;
                        if (t >= 0) { const bf16* pr = PROJ + ((size_t)b * SEQ + t) * NINP + PC_CF + c8; const v4u a = *(const v4u*)pr, gg = *(const v4u*)(pr + 256);
                            o0 = (f32x4){bflo(a.x) * sigmoid_f(bflo(gg.x)), bfhi(a.x) * sigmoid_f(bfhi(gg.x)), bflo(a.y) * sigmoid_f(bflo(gg.y)), bfhi(a.y) * sigmoid_f(bfhi(gg.y))};
                            o1 = (f32x4){bflo(a.z) * sigmoid_f(bflo(gg.z)), bfhi(a.z) * sigmoid_f(bfhi(gg.z)), bflo(a.w) * sigmoid_f(bflo(gg.w)), bfhi(a.w) * sigmoid_f(bfhi(gg.w))}; }
                        *(LAS f32x4*)(hb + rr * 256 + c8) = o0; *(LAS f32x4*)(hb + rr * 256 + c8 + 4) = o1; }
                    __syncthreads();
                    { float hv[46];
#pragma unroll
                        for (int k = 0; k < 46; ++k) hv[k] = hb[(16 * half + k) * 256 + ch];
#pragma unroll
                        for (int i = 0; i < 16; ++i) { float acc = bias;
#pragma unroll
                            for (int j = 0; j < 31; ++j) acc += wv[j] * hv[i + j];
                            yb[(16 * half + i) * 256 + ch] = acc; } }
                    __syncthreads();
                    { float y[4][4], s1[4], s2[4];
#pragma unroll
                        for (int i4 = 0; i4 < 4; ++i4) { s1[i4] = 0.f; s2[i4] = 0.f;
#pragma unroll
                            for (int k = 0; k < 4; ++k) { const float v = yb[(wave * 4 + i4) * 256 + lane + 64 * k]; y[i4][k] = v; s1[i4] += v; s2[i4] += v * v; } }
#pragma unroll
                        for (int o = 1; o < 64; o <<= 1)
#pragma unroll
                            for (int i4 = 0; i4 < 4; ++i4) { s1[i4] += __shfl_xor(s1[i4], o); s2[i4] += __shfl_xor(s2[i4], o); }
#pragma unroll
                        for (int i4 = 0; i4 < 4; ++i4) { const float mean = s1[i4] * (1.f / 256.f); const float var = fmaxf(s2[i4] * (1.f / 256.f) - mean * mean, 0.f); const float rs = rsqrtf(var + EPS);
                            bf16* orow = MIX + ((size_t)b * SEQ + t0 + wave * 4 + i4) * DM + 384;
#pragma unroll
                            for (int k = 0; k < 4; ++k) orow[lane + 64 * k] = f2bf(silu_f((y[i4][k] - mean) * rs * lwv[k] + lbv[k])); } }
                    __syncthreads();
                }
            }
            REP(23) {
                { const float* cwl = ap->in[I_DNCONV] + (size_t)l * 4 * 1152; const float* alog = ap->in[I_DNALOG] + l * 6; const float* dtbp = ap->in[I_DNDT] + l * 6;
                    for (int u = gw; u < BATCH * 6 * 32; u += NGW) { const int n = u & 31, bh = u >> 5, b = bh / 6, h = bh % 6;
                        dn_chunk_wave(lds + RING_OFF + wave * 16384, PROJ, cwl, __expf(alog[h]), dtbp[h], ws + WS_DNF + (size_t)u * DNF_UNIT, (float*)(ws + WS_GT) + u, b, h, n, lane); } }
            }
            GRID_BAR();
        }
        if (IN(3)) REP(3) {
            PH_LOCALS();
            if (blk < 64) {
                pg8::Gemm g{ACMP, Wc1_t + (size_t)l * 256 * CMP_K, CMP_ROWS, 256, CMP_K}; pg8::StaticOrder S; S.init(CMP_ROWS, 256, 64, blk);
                pg8::EpiBf16<1> E{HID, 256, nullptr};
                pg8::gemm_phase<pg8::EpiBf16<1>, pg8::StaticOrder, true, true>(lds + RING_OFF, g, S, E);
                pg8::Unit un; if (S.next(0, un)) { asm volatile("s_waitcnt vmcnt(0)" ::: "memory"); __syncthreads();
                    cmp_mlp2_tiles(HID, (const bf16*)(ws + WS_W2T) + (size_t)l * 2 * 64 * 128, KC, VCT, 16 * un.pm, 16 * un.pm + 16, NWAVES, wave, lane); }
            }
        }
        if (IN(11)) REP(11) {
            PH_LOCALS();
            if (blk >= 64 && blk < 64 + BATCH * 6)
                dn_scan_pair(lds, ws + WS_DNF, (const float*)(ws + WS_GT), PROJ, MIX, ap->in[I_DNNORM] + (size_t)l * 64, blk - 64, lane, wave);
            GRID_BAR();
        }
        if (IN(5)) REP(5) {
            PH_LOCALS();
            NsaPtrs P{PROJ, KC, VCT, KS, VST, KW, VWT, MIX};
            for (int u = blk; u < 1024; u += G) {
                const int hi4 = u >> 8, lo8 = u & 255, b = lo8 >> 3, g = (lo8 >> 2) & 1, q4 = lo8 & 3;
                const int q8 = hi4 == 0 ? q4 : (hi4 == 1 ? 15 - q4 : (hi4 == 2 ? 4 + q4 : 11 - q4));
                __syncthreads();
                nsa_stage_cmp(lds, P, b, g, tid);
                __syncthreads();
                nsa_item(P, lds, wave, b, g, (q8 * 8 + wave) * 16, tid, lane);
            }
            GRID_BAR();
        }
        if (IN(6)) REP(6) {
            PH_LOCALS();
            pg8::Gemm g{MIX, Wout_t + (size_t)l * DM * DM, MTOK, DM, DM}; pg8::StaticOrder S; S.init(MTOK, DM, G, blk);
            pg8::EpiBf16<0> E{MBUF, DM, nullptr};
            pg8::gemm_phase<pg8::EpiBf16<0>, pg8::StaticOrder, true, true>(lds + RING_OFF, g, S, E);
            GRID_BAR();
        }
        if (IN(7)) REP(7) {
            PH_LOCALS();
            const float* wp = ap->in[I_NORMW] + ((size_t)l * 4 + 1) * DM; bf16* const xo = (l == DEPTH - 1) ? XM : XD;
            constexpr int QM = MTOK / 4;
            if (l == 0) { for (int m = gw; m < QM; m += NGW) resid_rows<true, false, 4>(x_in, MBUF, wp, xo, RSTD, (size_t)m, (size_t)QM, lane); }
            else { for (int m = gw; m < QM; m += NGW) resid_rows<false, false, 4>(XD, MBUF, wp, xo, RSTD, (size_t)m, (size_t)QM, lane); }
            GRID_BAR();
        }
        if (IN(8)) REP(8) {
            PH_LOCALS();
            pg8::Gemm g{(l == DEPTH - 1) ? XM : XD, Wgu_t + (size_t)l * NGU * DM, MTOK, NGU, DM}; pg8::StaticOrder S; S.init(MTOK, NGU, G, blk);
            pg8::EpiSwiGLU E{HFF, DFF, RSTD};
            pg8::gemm_phase<pg8::EpiSwiGLU, pg8::StaticOrder, true, true>(lds + RING_OFF, g, S, E);
            GRID_BAR();
        }
        if (IN(9)) REP(9) {
            PH_LOCALS();
            pg8::Gemm g{HFF, Wd_t + (size_t)l * DM * DFF, MTOK, DM, DFF}; pg8::StaticOrder S; S.init(MTOK, DM, G, blk);
            pg8::EpiBf16<0> E{MBUF, DM, nullptr};
            pg8::gemm_phase<pg8::EpiBf16<0>, pg8::StaticOrder, true, true>(lds + RING_OFF, g, S, E);
            GRID_BAR();
        }
        if (IN(10)) REP(10) {
            PH_LOCALS();
            const float* wp = ap->in[I_NORMW] + ((size_t)l * 4 + 3) * DM;
            constexpr int QM = MTOK / 4;
            if (l == DEPTH - 1) { for (int m = gw; m < QM; m += NGW) resid_rows<false, true, 4>(XM, MBUF, wp, xres, RSTD, (size_t)m, (size_t)QM, lane); }
            else { for (int m = gw; m < QM; m += NGW) resid_rows<false, false, 4>(XD, MBUF, wp, XD, RSTD, (size_t)m, (size_t)QM, lane); }
            if (l + 1 < ap->l_hi) GRID_BAR();
        }
    }
#undef IN
}

template <unsigned PHM> static int setup_kernel() {
    if (hipFuncSetAttribute((const void*)fwd<PHM>, hipFuncAttributeMaxDynamicSharedMemorySize, LDS_BYTES) != hipSuccess) { fprintf(stderr, "kernel_launch: hipFuncSetAttribute failed (mask %x)\n", PHM); return -1; }
    int per_cu = 0;
    if (hipOccupancyMaxActiveBlocksPerMultiprocessor(&per_cu, (const void*)fwd<PHM>, NTHR, LDS_BYTES) != hipSuccess || per_cu < 1) fprintf(stderr, "kernel_launch: occupancy query reports %d (mask %x)\n", per_cu, PHM);
    (void)hipGetLastError();
    return 0;
}
template <unsigned PHM> static void launch_ph(int grid, hipStream_t stream, const Args& a) { hipLaunchKernelGGL(fwd<PHM>, dim3(grid), dim3(NTHR), LDS_BYTES, stream, a); }
#ifndef PH_ALL_MASK
#define PH_ALL_MASK 0xfffu
#endif
constexpr unsigned PH_ALL = PH_ALL_MASK;
extern "C" void kernel_launch(void* const* d_in, const int* in_sizes, int n_in, void* d_out, int out_size, void* d_ws, size_t ws_size, hipStream_t stream) {
    static int grid = 0;
    if (grid == 0) {
        if (n_in != 21 || in_sizes[0] != MTOK * DM || out_size != MTOK * DM || ws_size < WS_END) { fprintf(stderr, "kernel_launch: unexpected shapes (n_in %d, in0 %d, out %d, ws %zu); nothing launched\n", n_in, n_in > 0 ? in_sizes[0] : -1, out_size, ws_size); grid = -1; return; }
        int dev = 0, cus = 0;
        if (hipGetDevice(&dev) != hipSuccess || hipDeviceGetAttribute(&cus, hipDeviceAttributeMultiprocessorCount, dev) != hipSuccess) { grid = -1; return; }
        int rc = 0;
#if MK_ONE_LAUNCH
        rc |= setup_kernel<PH_ALL>();
#else
        rc |= setup_kernel<1u << 0>(); rc |= setup_kernel<1u << 1>(); rc |= setup_kernel<1u << 2>(); rc |= setup_kernel<1u << 3>(); rc |= setup_kernel<1u << 4>(); rc |= setup_kernel<1u << 5>();
        rc |= setup_kernel<1u << 6>(); rc |= setup_kernel<1u << 7>(); rc |= setup_kernel<1u << 8>(); rc |= setup_kernel<1u << 9>(); rc |= setup_kernel<1u << 10>(); rc |= setup_kernel<1u << 11>();
#endif
        if (rc) { grid = -1; return; }
        grid = cus;
        if (grid < 128) { fprintf(stderr, "kernel_launch: needs >= 128 CUs\n"); grid = -1; return; }
    }
    if (grid < 0) return;
    if (hipMemsetAsync((char*)d_ws + WS_CTL, 0, CTL_ZERO_BYTES, stream) != hipSuccess) return;
    Args a{};
    for (int i = 0; i < 21; ++i) a.in[i] = (const float*)d_in[i];
    a.out = (float*)d_out; a.ws = (unsigned char*)d_ws;
#if MK_ONE_LAUNCH
    a.pre = 1; a.ph_lo = 1; a.ph_hi = 12; a.l_lo = 0; a.l_hi = DEPTH;
    launch_ph<PH_ALL>(grid, stream, a);
#else
    a.pre = 1; a.ph_lo = 0; a.ph_hi = 0; a.l_lo = 0; a.l_hi = 0;
    launch_ph<1u << 0>(grid, stream, a);
    for (int l = 0; l < DEPTH; ++l) {
        a.pre = 0; a.l_lo = l; a.l_hi = l + 1;
#define LP(p) do { a.ph_lo = (p); a.ph_hi = (p) + 1; launch_ph<1u << (p)>(grid, stream, a); } while (0)
        LP(1); LP(2); LP(3); LP(11); LP(4); LP(5); LP(6); LP(7); LP(8); LP(9); LP(10);
#undef LP
    }
#endif
}
```
